# Optimizing an MI355X kernel written in HIP

```python
import jax, jax.numpy as jnp
from jax import lax
import numpy as np

D_MODEL = 1024
BATCH = 8
SEQ = 2048
DEPTH = 2
DEC_BATCH = 128
DEC_SEQ = 8
PAST_LEN = 16384
PAGE_SIZE = 128

N_META = 16
H_RET = 4
DK_RET = 128
DV_RET = 128
H_HGRN = 4
DK_HGRN = 128
DV_HGRN = 128
D_RET = H_RET * DV_RET
D_HGRN = H_HGRN * DV_HGRN
D_IN_AB = 2 * H_RET * DK_RET + 2 * D_RET + 2 * H_HGRN * DK_HGRN + 2 * D_HGRN
D_MIX_AB = D_RET + D_HGRN
RET_CHUNK = 128
HGRN_CHUNK = 16
ROPE_BASE = 10000.0
D_RNN = 1024
N_LRU_BLOCKS = 8
LRU_BLOCK = D_RNN // N_LRU_BLOCKS
CONV_W_LRU = 4
LRU_C = 8.0
D_FF = 2816
CONV_W_FFN = 3
LN_EPS = 1e-5
DEEPNORM_ALPHA = (2.0 * DEPTH) ** 0.25
DEEPNORM_BETA = (8.0 * DEPTH) ** -0.25

kernel_name = 'hybrid_retention_hgrn2_rglru_convffn_step'


def _layernorm(x, g, b):
    xf = x.astype(jnp.float32)
    mu = xf.mean(-1, keepdims=True)
    var = jnp.mean(jnp.square(xf - mu), -1, keepdims=True)
    return ((xf - mu) * lax.rsqrt(var + LN_EPS) * g.astype(jnp.float32) + b.astype(jnp.float32)).astype(x.dtype)


def _rope(x, pos):
    half = x.shape[-1] // 2
    inv = ROPE_BASE ** (-jnp.arange(half, dtype=jnp.float32) / half)
    ang = pos.astype(jnp.float32)[:, None] * inv[None, :]
    cos, sin = jnp.cos(ang), jnp.sin(ang)
    x1, x2 = x[..., :half], x[..., half:]
    return jnp.concatenate([x1 * cos - x2 * sin, x1 * sin + x2 * cos], axis=-1)


def _chunk_size(length, chunk):
    return chunk if length % chunk == 0 else length


def _to_chunks(t, chunk):
    b, h, length, d = t.shape
    return jnp.moveaxis(t.reshape(b, h, length // chunk, chunk, d), 2, 0)


def _from_chunks(o):
    nc, b, h, c, d = o.shape
    return jnp.moveaxis(o, 0, 2).reshape(b, h, nc * c, d)


def _retention_chunked(q, k, v, log_gamma, s0, chunk):
    idx = jnp.arange(chunk, dtype=jnp.float32)
    rel = idx[:, None] - idx[None, :]
    decay_intra = jnp.where(rel >= 0, jnp.exp(log_gamma[:, None, None] * jnp.maximum(rel, 0.0)), 0.0)
    w_q = jnp.exp(log_gamma[:, None] * (idx + 1.0))[..., None]
    w_k = jnp.exp(log_gamma[:, None] * (chunk - 1.0 - idx))[..., None]
    chunk_decay = jnp.exp(log_gamma * chunk)[:, None, None]

    def step(S, inp):
        qc, kc, vc = inp
        attn = jnp.einsum('bhid,bhjd->bhij', qc, kc) * decay_intra
        o = jnp.einsum('bhij,bhjv->bhiv', attn, vc) + jnp.einsum('bhid,bhdv->bhiv', qc * w_q, S)
        S = chunk_decay * S + jnp.einsum('bhjd,bhjv->bhdv', kc * w_k, vc)
        return S, o

    S, o = lax.scan(step, s0, (_to_chunks(q, chunk), _to_chunks(k, chunk), _to_chunks(v, chunk)))
    return _from_chunks(o), S


def _gla_chunked(q, k, v, log_f, s0, chunk):
    mask = jnp.tril(jnp.ones((chunk, chunk), dtype=bool))

    def step(S, inp):
        qc, kc, vc, gc = inp
        bcum = jnp.cumsum(gc, axis=2)
        diff = bcum[:, :, :, None, :] - bcum[:, :, None, :, :]
        decay = jnp.exp(jnp.where(mask[:, :, None], diff, -jnp.inf))
        attn = jnp.einsum('bhid,bhjd,bhijd->bhij', qc, kc, decay)
        o = jnp.einsum('bhij,bhjv->bhiv', attn, vc) + jnp.einsum('bhid,bhdv->bhiv', qc * jnp.exp(bcum), S)
        last = bcum[:, :, -1:, :]
        S = jnp.exp(last[:, :, 0, :])[..., None] * S + jnp.einsum('bhjd,bhjv->bhdv', kc * jnp.exp(last - bcum), vc)
        return S, o

    S, o = lax.scan(step, s0, tuple(_to_chunks(t, chunk) for t in (q, k, v, log_f)))
    return _from_chunks(o), S


def _segmented(fn, arrays, s0, segments, chunk):
    outs = []
    s = s0
    start = 0
    for length in segments:
        sl = tuple(a[:, :, start:start + length] for a in arrays)
        o, s = fn(*sl, s, _chunk_size(length, chunk))
        outs.append(o)
        start += length
    return jnp.concatenate(outs, axis=2), s


def _causal_dwconv(x, buf, w, b):
    width = w.shape[0]
    length = x.shape[1]
    xp = jnp.concatenate([buf.astype(x.dtype), x], axis=1)
    y = b + xp[:, 0:length] * w[0]
    for j in range(1, width):
        y = y + xp[:, j:j + length] * w[j]
    return y, xp[:, length:]


def _linear_combine(left, right):
    a1, b1 = left
    a2, b2 = right
    return a1 * a2, a2 * b1 + b2


def _mixer_ret_hgrn(x, pos, segments, s_ret, s_hgrn, layer, p):
    bsz, length, _ = x.shape
    f32 = jnp.float32
    sizes = [H_RET * DK_RET, H_RET * DK_RET, D_RET, D_RET, H_HGRN * DK_HGRN, H_HGRN * DK_HGRN, D_HGRN, D_HGRN]
    proj = x @ p['w_in_ab']
    rq, rk, rv, rg, hq, hf, hi, hg = jnp.split(proj, np.cumsum(sizes)[:-1].tolist(), axis=-1)

    def heads(t, h):
        return t.reshape(bsz, length, h, -1).transpose(0, 2, 1, 3).astype(f32)

    q = _rope(heads(rq, H_RET), pos)
    k = _rope(heads(rk, H_RET), pos) * (DK_RET ** -0.5)
    v = heads(rv, H_RET)
    log_gamma = jnp.log1p(-jnp.exp2(-5.0 - jnp.arange(H_RET, dtype=f32)))
    o_ret, s_ret_new = _segmented(
        lambda q_, k_, v_, s_, c_: _retention_chunked(q_, k_, v_, log_gamma, s_, c_),
        (q, k, v), s_ret.astype(f32), segments, RET_CHUNK)
    mu = o_ret.mean(-1, keepdims=True)
    var = jnp.mean(jnp.square(o_ret - mu), -1, keepdims=True)
    o_ret = (o_ret - mu) * lax.rsqrt(var + LN_EPS)
    o_ret = o_ret.transpose(0, 2, 1, 3).reshape(bsz, length, D_RET) * jax.nn.silu(rg.astype(f32))

    lb = jnp.cumsum(jax.nn.softmax(p['hgrn_lb_logits'].astype(f32), axis=0), axis=0)[layer]
    lb = lb.reshape(H_HGRN, 1, DK_HGRN)
    f = lb + (1.0 - lb) * jax.nn.sigmoid(heads(hf, H_HGRN))
    o_h, s_h_new = _segmented(_gla_chunked, (heads(hq, H_HGRN), 1.0 - f, heads(hi, H_HGRN), jnp.log(f)),
                              s_hgrn.astype(f32), segments, HGRN_CHUNK)
    o_h = o_h * lax.rsqrt(jnp.mean(jnp.square(o_h), -1, keepdims=True) + LN_EPS) * p['hgrn_norm_w'].astype(f32)
    o_h = o_h.transpose(0, 2, 1, 3).reshape(bsz, length, D_HGRN) * jax.nn.silu(hg.astype(f32))

    mixed = jnp.concatenate([o_ret, o_h], axis=-1).astype(x.dtype)
    return mixed @ p['w_out_ab'], s_ret_new.astype(s_ret.dtype), s_h_new.astype(s_hgrn.dtype)


def _mixer_rglru(x, h0, conv_buf, p):
    bsz, length, _ = x.shape
    f32 = jnp.float32
    gate_br, rnn_br = jnp.split(x @ p['w_in_c'], 2, axis=-1)
    xc, new_buf = _causal_dwconv(rnn_br, conv_buf, p['conv_w_c'], p['conv_b_c'])
    xb = xc.reshape(bsz, length, N_LRU_BLOCKS, LRU_BLOCK)
    r = jax.nn.sigmoid((jnp.einsum('blnc,ncd->blnd', xb, p['w_gate_a']).reshape(bsz, length, D_RNN) + p['b_gate_a']).astype(f32))
    i = jax.nn.sigmoid((jnp.einsum('blnc,ncd->blnd', xb, p['w_gate_x']).reshape(bsz, length, D_RNN) + p['b_gate_x']).astype(f32))
    log_a = LRU_C * r * jax.nn.log_sigmoid(p['lru_lambda'].astype(f32))
    a = jnp.exp(log_a)
    b = jnp.sqrt(-jnp.expm1(2.0 * log_a)) * (i * xc.astype(f32))
    b = b.at[:, 0].add(a[:, 0] * h0.astype(f32))
    _, h = lax.associative_scan(_linear_combine, (a, b), axis=1)
    y = jax.nn.gelu(gate_br.astype(f32)) * h
    return y.astype(x.dtype) @ p['w_out_c'], h[:, -1].astype(h0.dtype), new_buf.astype(conv_buf.dtype)


def _conv_ffn(x, buf, w_up, conv_w, conv_b, w_down):
    u, v = jnp.split(x @ w_up, 2, axis=-1)
    uc, new_buf = _causal_dwconv(u, buf, conv_w, conv_b)
    h = jax.nn.gelu(uc.astype(jnp.float32)) * v.astype(jnp.float32)
    return h.astype(x.dtype) @ w_down, new_buf.astype(buf.dtype)


def _trunk(x, pos, segments, s_ret, s_hgrn, h_lru, buf_lru, buf_ffn, p):
    new_ffn_bufs = []
    for layer in range(DEPTH):
        if layer % 2 == 0:
            m, s_ret, s_hgrn = _mixer_ret_hgrn(x, pos, segments, s_ret, s_hgrn, layer, p)
        else:
            m, h_lru, buf_lru = _mixer_rglru(x, h_lru, buf_lru, p)
        x = _layernorm(DEEPNORM_ALPHA * x + m, p['ln_mix_g'][layer], p['ln_mix_b'][layer])
        f, nb = _conv_ffn(x, buf_ffn[layer], p['w_ffn_up'][layer], p['ffn_conv_w'][layer],
                          p['ffn_conv_b'][layer], p['w_ffn_down'][layer])
        new_ffn_bufs.append(nb)
        x = _layernorm(DEEPNORM_ALPHA * x + f, p['ln_ffn_g'][layer], p['ln_ffn_b'][layer])
    return x, s_ret, s_hgrn, h_lru, buf_lru, jnp.stack(new_ffn_bufs)


def setup_inputs(seed: int = 0) -> dict:
    key = jax.random.key(seed)
    ks = jax.random.split(key, 32)

    def nrm(k, shape, scale):
        return scale * jax.random.normal(k, shape, jnp.float32)

    lb_base = jnp.where(jnp.arange(DEPTH + 1)[:, None] == 0, -2.0, 0.0)
    a_init = jax.random.uniform(ks[19], (D_RNN,), jnp.float32, 0.9, 0.999)
    a_root = a_init ** (1.0 / LRU_C)
    return {
        'x_prompt': nrm(ks[0], (BATCH, SEQ, D_MODEL), 1.0),
        'x_sample': nrm(ks[1], (DEC_BATCH, DEC_SEQ, D_MODEL), 1.0),
        'state_ret': nrm(ks[2], (DEC_BATCH, H_RET, DK_RET, DV_RET), 0.5),
        'state_hgrn': nrm(ks[3], (DEC_BATCH, H_HGRN, DK_HGRN, DV_HGRN), 0.5),
        'state_rglru_h': nrm(ks[4], (DEC_BATCH, D_RNN), 0.5),
        'state_rglru_conv': nrm(ks[5], (DEC_BATCH, CONV_W_LRU - 1, D_RNN), 1.0),
        'state_ffn_conv': nrm(ks[6], (DEPTH, DEC_BATCH, CONV_W_FFN - 1, D_FF), 1.0),
        'meta_tokens': nrm(ks[7], (N_META, D_MODEL), 1.0),
        'w_in_ab': nrm(ks[8], (D_MODEL, D_IN_AB), D_MODEL ** -0.5),
        'w_out_ab': nrm(ks[9], (D_MIX_AB, D_MODEL), DEEPNORM_BETA * D_MIX_AB ** -0.5),
        'hgrn_lb_logits': lb_base + nrm(ks[10], (DEPTH + 1, H_HGRN * DK_HGRN), 0.1),
        'hgrn_norm_w': 1.0 + nrm(ks[11], (DV_HGRN,), 0.02),
        'w_in_c': nrm(ks[12], (D_MODEL, 2 * D_RNN), D_MODEL ** -0.5),
        'conv_w_c': nrm(ks[13], (CONV_W_LRU, D_RNN), CONV_W_LRU ** -0.5),
        'conv_b_c': nrm(ks[14], (D_RNN,), 0.02),
        'w_gate_a': nrm(ks[15], (N_LRU_BLOCKS, LRU_BLOCK, LRU_BLOCK), LRU_BLOCK ** -0.5),
        'b_gate_a': nrm(ks[16], (D_RNN,), 0.02),
        'w_gate_x': nrm(ks[17], (N_LRU_BLOCKS, LRU_BLOCK, LRU_BLOCK), LRU_BLOCK ** -0.5),
        'b_gate_x': nrm(ks[18], (D_RNN,), 0.02),
        'lru_lambda': jnp.log(a_root) - jnp.log1p(-a_root),
        'w_out_c': nrm(ks[20], (D_RNN, D_MODEL), DEEPNORM_BETA * D_RNN ** -0.5),
        'ln_mix_g': 1.0 + nrm(ks[21], (DEPTH, D_MODEL), 0.02),
        'ln_mix_b': nrm(ks[22], (DEPTH, D_MODEL), 0.02),
        'ln_ffn_g': 1.0 + nrm(ks[23], (DEPTH, D_MODEL), 0.02),
        'ln_ffn_b': nrm(ks[24], (DEPTH, D_MODEL), 0.02),
        'w_ffn_up': nrm(ks[25], (DEPTH, D_MODEL, 2 * D_FF), D_MODEL ** -0.5),
        'ffn_conv_w': nrm(ks[26], (DEPTH, CONV_W_FFN, D_FF), CONV_W_FFN ** -0.5),
        'ffn_conv_b': nrm(ks[27], (DEPTH, D_FF), 0.02),
        'w_ffn_down': nrm(ks[28], (DEPTH, D_FF, D_MODEL), DEEPNORM_BETA * D_FF ** -0.5),
    }


def reference(x_prompt, x_sample, state_ret, state_hgrn, state_rglru_h, state_rglru_conv, state_ffn_conv,
              meta_tokens, w_in_ab, w_out_ab, hgrn_lb_logits, hgrn_norm_w, w_in_c, conv_w_c, conv_b_c,
              w_gate_a, b_gate_a, w_gate_x, b_gate_x, lru_lambda, w_out_c, ln_mix_g, ln_mix_b,
              ln_ffn_g, ln_ffn_b, w_ffn_up, ffn_conv_w, ffn_conv_b, w_ffn_down):
    p = dict(w_in_ab=w_in_ab, w_out_ab=w_out_ab, hgrn_lb_logits=hgrn_lb_logits, hgrn_norm_w=hgrn_norm_w,
             w_in_c=w_in_c, conv_w_c=conv_w_c, conv_b_c=conv_b_c, w_gate_a=w_gate_a, b_gate_a=b_gate_a,
             w_gate_x=w_gate_x, b_gate_x=b_gate_x, lru_lambda=lru_lambda, w_out_c=w_out_c,
             ln_mix_g=ln_mix_g, ln_mix_b=ln_mix_b, ln_ffn_g=ln_ffn_g, ln_ffn_b=ln_ffn_b,
             w_ffn_up=w_ffn_up, ffn_conv_w=ffn_conv_w, ffn_conv_b=ffn_conv_b, w_ffn_down=w_ffn_down)

    bsz, seq_len, _ = x_prompt.shape
    dt = x_prompt.dtype
    meta = jnp.broadcast_to(meta_tokens.astype(dt)[None], (bsz, N_META, D_MODEL))
    xp = jnp.concatenate([meta, x_prompt], axis=1)
    pos_p = jnp.arange(N_META + seq_len, dtype=jnp.int32)
    yp, ret_p, hgrn_p, h_p, cbuf_p, fbuf_p = _trunk(
        xp, pos_p, (N_META, seq_len),
        jnp.zeros((bsz, H_RET, DK_RET, DV_RET), dt),
        jnp.zeros((bsz, H_HGRN, DK_HGRN, DV_HGRN), dt),
        jnp.zeros((bsz, D_RNN), dt),
        jnp.zeros((bsz, CONV_W_LRU - 1, D_RNN), dt),
        jnp.zeros((DEPTH, bsz, CONV_W_FFN - 1, D_FF), dt),
        p)
    y_prompt = yp[:, N_META:]

    n_new = x_sample.shape[1]
    pos_s = PAST_LEN + jnp.arange(n_new, dtype=jnp.int32)
    y_sample, ret_s, hgrn_s, h_s, cbuf_s, fbuf_s = _trunk(
        x_sample, pos_s, (n_new,), state_ret, state_hgrn, state_rglru_h, state_rglru_conv, state_ffn_conv, p)

    return (y_prompt, y_sample, ret_p, ret_s, hgrn_p, hgrn_s, h_p, h_s, cbuf_p, cbuf_s, fbuf_p, fbuf_s)
```

```cpp
#include <hip/hip_runtime.h>
#include <hip/hip_cooperative_groups.h>
#include <cstdio>
#include <cstdint>
namespace cg = cooperative_groups;
#ifndef STOP_AT
#define STOP_AT 0
#endif

#define LAS __attribute__((address_space(3)))
typedef unsigned short bf16_t;
typedef short bf16x8 __attribute__((ext_vector_type(8)));
typedef short bf16x4 __attribute__((ext_vector_type(4)));
typedef float f32x4 __attribute__((ext_vector_type(4)));
typedef float f32x2 __attribute__((ext_vector_type(2)));
typedef unsigned u32x4 __attribute__((ext_vector_type(4)));
typedef unsigned u32x2 __attribute__((ext_vector_type(2)));

constexpr int DM = 1024, LP = 2064, NB = 8, TP = NB * LP, SBAT = 128, TS = SBAT * 8, T = TP + TS, MP = 17664;
constexpr int DFF = 2816;
constexpr int NSUBP = 129, NS_P = NB * NSUBP, NS = NS_P + SBAT;
constexpr int NT_P = NB * NSUBP, NT_S = TS / 16, NTILE = NT_P + NT_S;
constexpr float LN_EPS = 1e-5f;
constexpr float ALPHA = 1.41421356237f;

constexpr size_t O_YP = 0, O_YS = 16777216, O_RETP = 17825792, O_RETS = 18350080, O_HGP = 26738688, O_HGS = 27262976, O_HP = 35651584, O_HS = 35659776,
                 O_CBP = 35790848, O_CBS = 35815424, O_FBP = 36208640, O_FBS = 36298752;

constexpr size_t KiB = 1024, MiB = 1024 * 1024;
constexpr size_t OFF_LBV = 0;
constexpr size_t OFF_C8 = 4 * KiB;
constexpr size_t OFF_W_INC = 1 * MiB;
constexpr size_t OFF_WG = 5 * MiB;
constexpr size_t OFF_W_OUTC = 5 * MiB + 512 * KiB;
constexpr size_t OFF_W_UP1 = 7 * MiB + 512 * KiB;
constexpr size_t OFF_W_DN1 = 18 * MiB + 512 * KiB;
constexpr size_t OFF_XB = 24 * MiB + 4096;
constexpr size_t OFF_BIG = 60 * MiB + 512 * KiB;
constexpr size_t OFF_X32 = OFF_BIG;
constexpr size_t OFF_H = 129 * MiB + 512 * KiB;
constexpr size_t OFF_HL = 198 * MiB + 512 * KiB;
constexpr size_t OFF_G = 198 * MiB + 512 * KiB;
constexpr size_t OFF_U = 204 * MiB;
constexpr size_t OFF_ROPE = 221 * MiB;
constexpr size_t OFF_TA = 233 * MiB, OFF_TH = 238 * MiB, OFF_CARRY = 243 * MiB;
constexpr size_t OFF_W_INAB = 229 * MiB + 512 * KiB;
constexpr size_t OFF_W_OUTAB = 237 * MiB + 512 * KiB;
constexpr size_t OFF_W_UP0 = 239 * MiB + 512 * KiB;
constexpr size_t OFF_W_DN0 = 250 * MiB + 512 * KiB;
constexpr size_t WS_END = 256 * MiB;
static_assert(OFF_XB - 4096 + 36 * MiB + 512 * KiB <= OFF_BIG, "xb");
static_assert((size_t)NS * 8 * 128 * 16 * 2 <= OFF_BIG - OFF_XB, "ktt");
static_assert(OFF_H + (size_t)MP * DFF * 2 <= OFF_W_INAB, "h");
static_assert(OFF_G + (size_t)NS * 8 * 128 * 4 <= OFF_U, "g");
static_assert(OFF_ROPE + 2072 * 64 * 2 * 4 <= OFF_W_INAB, "rope");
static_assert(OFF_HL + (size_t)T * 1024 * 2 <= OFF_TA, "hl");
static_assert(OFF_CARRY + (size_t)NTILE * 1024 * 4 <= WS_END, "carry");

constexpr int LDS_BYTES = 147456;

typedef __bf16 bf16x2_t __attribute__((ext_vector_type(2)));
__device__ __forceinline__ unsigned cvt_pk(float lo, float hi) { f32x2 v = {lo, hi}; bf16x2_t b = __builtin_convertvector(v, bf16x2_t); return __builtin_bit_cast(unsigned, b); }
__device__ __forceinline__ float bflo(unsigned w) { return __uint_as_float(w << 16); }
__device__ __forceinline__ float bfhi(unsigned w) { return __uint_as_float(w & 0xffff0000u); }
__device__ __forceinline__ float sigmoidf_(float x) { return __builtin_amdgcn_rcpf(1.f + __expf(-x)); }
__device__ __forceinline__ float gelu_tanh(float x) { const float z = 0.7978845608f * (x + 0.044715f * x * x * x); return x * __builtin_amdgcn_rcpf(1.f + __expf(-2.f * z)); }
__device__ __forceinline__ float wave_sum(float v) {
#pragma unroll
    for (int o = 1; o < 64; o <<= 1) v += __shfl_xor(v, o);
    return v;
}
__device__ __forceinline__ f32x4 mfma32(bf16x8 a, bf16x8 b, f32x4 c) { return __builtin_amdgcn_mfma_f32_16x16x32_bf16(a, b, c, 0, 0, 0); }
__device__ __forceinline__ f32x4 mfma16(bf16x4 a, bf16x4 b, f32x4 c) { const bf16x8 a8 = (bf16x8){a[0], a[1], a[2], a[3], 0, 0, 0, 0}, b8 = (bf16x8){b[0], b[1], b[2], b[3], 0, 0, 0, 0}; return __builtin_amdgcn_mfma_f32_16x16x32_bf16(a8, b8, c, 0, 0, 0); }
__device__ __forceinline__ bf16x4 pack4(f32x4 v) { u32x2 w; w.x = cvt_pk(v[0], v[1]); w.y = cvt_pk(v[2], v[3]); return __builtin_bit_cast(bf16x4, w); }
__device__ __forceinline__ bf16x8 pack8(f32x4 a, f32x4 b) { u32x4 w; w.x = cvt_pk(a[0], a[1]); w.y = cvt_pk(a[2], a[3]); w.z = cvt_pk(b[0], b[1]); w.w = cvt_pk(b[2], b[3]); return __builtin_bit_cast(bf16x8, w); }

struct Args { const float* in[29]; float* out; unsigned char* ws; };

__device__ __forceinline__ const float* xsrc_row(const Args& a, int row) {
    if (row < TP) { const int b = row / LP, t = row - b * LP; return t < 16 ? a.in[7] + (size_t)t * DM : a.in[0] + ((size_t)b * 2048 + (t - 16)) * DM; }
    return a.in[1] + (size_t)(row - TP) * DM;
}

namespace pg8 {
constexpr int BM = 256, BK = 64, HALF = 128, HTB = HALF * BK * 2, STAGE_BYTES = 8 * HTB, NXCD = 8, WGM = 8;
__device__ __forceinline__ int lds_byte(int r, int c) { const int st = (r >> 4) * 2 + (c >> 5), rr = r & 15, cc = c & 31, ob = rr * 64 + cc * 2; return st * 1024 + (ob ^ (((ob >> 9) & 1) << 5)); }
__device__ __forceinline__ void stage_rc(int b, int& R, int& C) { const int st = b / 1024, sb = b % 1024, swz = sb ^ (((sb >> 9) & 1) << 5); R = (st >> 1) * 16 + swz / 64; C = (st & 1) * 32 + (swz % 64) / 2; }
__device__ __forceinline__ int perm32(int rho) { const int n = rho >> 4, i = rho & 15; return 8 * (i >> 2) + 4 * n + (i & 3); }
struct Unit { int pm, pn; };
struct StaticOrder {
    int nM, nN, nwg, G, c;
    __device__ void init(int nM_, int nN_, int G_, int c_) { nM = nM_; nN = nN_; nwg = nM * nN; G = G_; c = c_; }
    __device__ bool next(int i, Unit& u) const {
        const long L = (long)i * G + c; if (L >= nwg) return false;
        int wgid = (int)L; { const int q = nwg / NXCD, r = nwg % NXCD, xcd = wgid % NXCD, off = wgid / NXCD; wgid = (xcd < r ? xcd * (q + 1) : r * (q + 1) + (xcd - r) * q) + off; }
        const int nig = WGM * nN, gid = wgid / nig, fm = gid * WGM, gsz = (nM - fm) < WGM ? (nM - fm) : WGM;
        u.pm = fm + ((wgid % nig) % gsz); u.pn = (wgid % nig) / gsz; return true;
    }
};

template <class Epi, int AMODE>
__device__ __forceinline__ void gemm_phase(LAS unsigned char* lds, const bf16_t* Abase, const bf16_t* Btbase, const int K, const StaticOrder& S, const Epi& E) {
    int tid = threadIdx.x; asm volatile("" : "+v"(tid));
    const int wid = __builtin_amdgcn_readfirstlane(tid >> 6), lane = tid & 63, wr = wid >> 2, wc = wid & 3, fr = lane & 15, fq = lane >> 4;
    const int nt = K / BK;
    unsigned voffA[2], voffB[2];
#pragma unroll
    for (int i = 0; i < 2; ++i) { int R, C; stage_rc(tid * 16 + i * 8192, R, C); const int Rb = Epi::PERM ? ((R & ~31) + perm32(R & 31)) : R;
        const int Ra = AMODE ? (R < 64 ? R : R - 2) : R;
        voffA[i] = (unsigned)(Ra * K + C) * 2u; voffB[i] = (unsigned)(Rb * K + C) * 2u; }
    const size_t kstep = (size_t)(BK * 2);
    const size_t hstepB = (size_t)HALF * K * 2, tstepB = 2 * hstepB;
    const size_t hstepA = (size_t)(AMODE ? 124 : 128) * K * 2, tstepA = 2 * hstepA;
    const unsigned ldsw = (unsigned)wid * 1024u;
    const int aoff = lds_byte(wr * 64 + fr, fq * 8), boff = lds_byte(wc * 32 + fr, fq * 8);
#define PG8_SA(b, h) (((b) * 2 + (h)) * HTB)
#define PG8_SB(b, h) ((4 + (b) * 2 + (h)) * HTB)
#define PG8_STAGE(bufoff, gbase, voff) do { _Pragma("unroll") for (int _i = 0; _i < 2; ++_i) \
        __builtin_amdgcn_global_load_lds((const unsigned*)((const char*)(gbase) + (voff)[_i]), (LAS unsigned*)(lds + (bufoff) + ldsw + _i * 8192), 16, 0, 0); } while (0)
#define PG8_LDA(dst, b, h) do { _Pragma("unroll") for (int m = 0; m < 4; ++m) _Pragma("unroll") for (int k = 0; k < 2; ++k) dst[m][k] = *(const LAS bf16x8*)(lds + PG8_SA(b, h) + aoff + m * 2048 + k * 1024); } while (0)
#define PG8_LDB(dst, b, h) do { _Pragma("unroll") for (int n = 0; n < 2; ++n) _Pragma("unroll") for (int k = 0; k < 2; ++k) dst[n][k] = *(const LAS bf16x8*)(lds + PG8_SB(b, h) + boff + n * 2048 + k * 1024); } while (0)
#define PG8_MMA(ai, bj, At, Bt) do { __builtin_amdgcn_s_setprio(1); _Pragma("unroll") for (int m = 0; m < 4; ++m) _Pragma("unroll") for (int n = 0; n < 2; ++n) _Pragma("unroll") for (int k = 0; k < 2; ++k) \
        acc[ai][bj][m][n] = __builtin_amdgcn_mfma_f32_16x16x32_bf16(Bt[n][k], At[m][k], acc[ai][bj][m][n], 0, 0, 0); __builtin_amdgcn_s_setprio(0); } while (0)
#define PG8_WAIT_V(n) asm volatile("s_waitcnt vmcnt(" #n ")" ::: "memory")
#define PG8_WAIT_L(n) asm volatile("s_waitcnt lgkmcnt(" #n ")" ::: "memory")
#define PG8_BAR __builtin_amdgcn_s_barrier()
#define PG8_SCHED __builtin_amdgcn_sched_barrier(0)
    Unit cur, nxt; int ui = 0;
    if (!S.next(0, cur)) return;
    f32x4 acc[2][2][4][2];
#pragma unroll
    for (int a = 0; a < 2; ++a)
#pragma unroll
        for (int b = 0; b < 2; ++b)
#pragma unroll
            for (int m = 0; m < 4; ++m)
#pragma unroll
                for (int n = 0; n < 2; ++n) acc[a][b][m][n] = (f32x4){0.f, 0.f, 0.f, 0.f};
    bf16x8 At[4][2], B0[2][2], B1[2][2];
    const char* cA = (const char*)Abase + (size_t)cur.pm * tstepA; const char* cB = (const char*)Btbase + (size_t)cur.pn * tstepB;
    PG8_STAGE(PG8_SB(0, 0), cB, voffB); PG8_STAGE(PG8_SA(0, 0), cA, voffA); PG8_STAGE(PG8_SB(0, 1), cB + hstepB, voffB); PG8_STAGE(PG8_SA(0, 1), cA + hstepA, voffA);
    if (wr == 1) PG8_BAR;
    PG8_WAIT_V(4); PG8_BAR;
    PG8_STAGE(PG8_SB(1, 0), cB + kstep, voffB); PG8_STAGE(PG8_SA(1, 0), cA + kstep, voffA); PG8_STAGE(PG8_SB(1, 1), cB + hstepB + kstep, voffB);
    PG8_WAIT_V(6); PG8_BAR;
    for (;;) {
        const bool has_next = S.next(ui + 1, nxt);
        const char* nA = has_next ? (const char*)Abase + (size_t)nxt.pm * tstepA : cA; const char* nB = has_next ? (const char*)Btbase + (size_t)nxt.pn * tstepB : cB;
        for (int t = 0; t < nt; t += 2) {
            const bool last = (t == nt - 2);
            const char* a1 = cA + (size_t)(t + 1) * kstep;
            const char* a2 = last ? nA : cA + (size_t)(t + 2) * kstep; const char* b2 = last ? nB : cB + (size_t)(t + 2) * kstep;
            const char* a3 = a2 + kstep; const char* b3 = b2 + kstep;
            PG8_LDB(B0, 0, 0); PG8_SCHED; PG8_LDA(At, 0, 0); PG8_STAGE(PG8_SA(1, 1), a1 + hstepA, voffA);
            PG8_WAIT_L(8); PG8_BAR; PG8_WAIT_L(0); PG8_MMA(0, 0, At, B0); PG8_BAR; PG8_SCHED;
            PG8_LDB(B1, 0, 1); PG8_STAGE(PG8_SB(0, 0), b2, voffB);
            PG8_BAR; PG8_WAIT_L(0); PG8_MMA(0, 1, At, B1); PG8_BAR;
            PG8_LDA(At, 0, 1); PG8_STAGE(PG8_SA(0, 0), a2, voffA);
            PG8_BAR; PG8_WAIT_L(0); PG8_MMA(1, 0, At, B0); PG8_BAR; PG8_SCHED;
            PG8_STAGE(PG8_SB(0, 1), b2 + hstepB, voffB);
            PG8_WAIT_V(6); PG8_BAR; PG8_MMA(1, 1, At, B1); PG8_BAR;
            PG8_LDB(B0, 1, 0); PG8_SCHED; PG8_LDA(At, 1, 0); PG8_STAGE(PG8_SA(0, 1), a2 + hstepA, voffA);
            PG8_WAIT_L(8); PG8_BAR; PG8_WAIT_L(0); PG8_MMA(0, 0, At, B0); PG8_BAR; PG8_SCHED;
            PG8_LDB(B1, 1, 1); PG8_STAGE(PG8_SB(1, 0), b3, voffB);
            PG8_BAR; PG8_WAIT_L(0); PG8_MMA(0, 1, At, B1); PG8_BAR;
            PG8_LDA(At, 1, 1); PG8_STAGE(PG8_SA(1, 0), a3, voffA);
            PG8_BAR; PG8_WAIT_L(0); PG8_MMA(1, 0, At, B0); PG8_BAR; PG8_SCHED;
            PG8_STAGE(PG8_SB(1, 1), b3 + hstepB, voffB);
            PG8_WAIT_V(6); PG8_BAR; PG8_MMA(1, 1, At, B1); PG8_BAR;
        }
        E(acc, cur, wr, wc, fr, fq);
        if (!has_next) break;
#pragma unroll
        for (int a = 0; a < 2; ++a)
#pragma unroll
            for (int b = 0; b < 2; ++b)
#pragma unroll
                for (int m = 0; m < 4; ++m)
#pragma unroll
                    for (int n = 0; n < 2; ++n) acc[a][b][m][n] = (f32x4){0.f, 0.f, 0.f, 0.f};
        cur = nxt; cA = nA; cB = nB; ++ui;
    }
    PG8_WAIT_V(0);
    if (wr == 0) PG8_BAR;
    PG8_BAR;
#undef PG8_SA
#undef PG8_SB
#undef PG8_STAGE
#undef PG8_LDA
#undef PG8_LDB
#undef PG8_MMA
#undef PG8_WAIT_V
#undef PG8_WAIT_L
#undef PG8_BAR
#undef PG8_SCHED
}

struct EpiBf16 {
    static constexpr bool PERM = true;
    bf16_t* O; int ldc;
    __device__ __forceinline__ void operator()(const f32x4 (&acc)[2][2][4][2], const Unit& u, int wr, int wc, int fr, int fq) const {
        const int row0 = u.pm * BM + wr * 64 + fr, col0 = u.pn * BM + wc * 32 + 8 * fq;
#pragma unroll
        for (int ai = 0; ai < 2; ++ai)
#pragma unroll
            for (int m = 0; m < 4; ++m) { bf16_t* rowp = O + (size_t)(row0 + ai * HALF + m * 16) * ldc + col0;
#pragma unroll
                for (int bj = 0; bj < 2; ++bj) { const f32x4 v0 = acc[ai][bj][m][0], v1 = acc[ai][bj][m][1];
                    u32x4 w; w.x = cvt_pk(v0[0], v0[1]); w.y = cvt_pk(v0[2], v0[3]); w.z = cvt_pk(v1[0], v1[1]); w.w = cvt_pk(v1[2], v1[3]);
                    *(u32x4*)(rowp + bj * HALF) = w; } }
    }
};
struct EpiRes {
    static constexpr bool PERM = false;
    float* Y; Args a; int mode;
    __device__ __forceinline__ void operator()(const f32x4 (&acc)[2][2][4][2], const Unit& u, int wr, int wc, int fr, int fq) const {
        const int row0 = u.pm * BM + wr * 64 + fr, col0 = u.pn * BM + wc * 32 + 4 * fq;
#pragma unroll
        for (int ai = 0; ai < 2; ++ai)
#pragma unroll
            for (int m = 0; m < 4; ++m) { const int row = row0 + ai * HALF + m * 16;
                if (row < T) { float* yp = Y + (size_t)row * DM + col0; const float* rp = mode == 0 ? xsrc_row(a, row) + col0 : yp;
#pragma unroll
                    for (int bj = 0; bj < 2; ++bj)
#pragma unroll
                        for (int n = 0; n < 2; ++n) { const f32x4 r = *(const f32x4*)(rp + bj * HALF + n * 16); *(f32x4*)(yp + bj * HALF + n * 16) = r * ALPHA + acc[ai][bj][m][n]; } } }
    }
};
struct EpiFFN {
    static constexpr bool PERM = true;
    bf16_t* H; const float* cw; const float* cbias; const float* sbuf; float* out_p; float* out_s;
    __device__ __forceinline__ void operator()(const f32x4 (&acc)[2][2][4][2], const Unit& u, int wr, int wc, int fr, int fq) const {
        const int s1 = fq * 16 + ((fr - 1) & 15), s2 = fq * 16 + ((fr - 2) & 15);
        const int colb = u.pn * 128 + wc * 32 + 8 * fq;
        f32x4 w0[2], w1[2], w2[2], cbv[2];
#pragma unroll
        for (int n = 0; n < 2; ++n) { w0[n] = *(const f32x4*)(cw + colb + 4 * n); w1[n] = *(const f32x4*)(cw + DFF + colb + 4 * n); w2[n] = *(const f32x4*)(cw + 2 * DFF + colb + 4 * n); cbv[n] = *(const f32x4*)(cbias + colb + 4 * n); }
#pragma unroll
        for (int ai = 0; ai < 2; ++ai) {
            const int base = u.pm * 248 + ai * 124 + wr * 62 - 2;
#pragma unroll
            for (int m = 0; m < 4; ++m) {
                const int rb = 16 * m + fr, gr = base + rb;
                f32x4 cur[2], p1[2], p2[2];
#pragma unroll
                for (int n = 0; n < 2; ++n) { cur[n] = acc[ai][0][m][n];
#pragma unroll
                    for (int j = 0; j < 4; ++j) {
                        const float a1 = __shfl(cur[n][j], s1), a2 = __shfl(cur[n][j], s2);
                        float b1 = 0.f, b2 = 0.f;
                        if (m > 0) { b1 = __shfl(acc[ai][0][m > 0 ? m - 1 : 0][n][j], s1); b2 = __shfl(acc[ai][0][m > 0 ? m - 1 : 0][n][j], s2); }
                        p1[n][j] = fr >= 1 ? a1 : b1; p2[n][j] = fr >= 2 ? a2 : b2; } }
                if (rb >= 2 && gr < T) {
                    const bool smp = gr >= TP; int b, t;
                    if (!smp) { b = gr / LP; t = gr - b * LP; } else { b = (gr - TP) >> 3; t = (gr - TP) & 7; }
                    if (t < 2) {
#pragma unroll
                        for (int n = 0; n < 2; ++n) { f32x4 q0 = (f32x4){0.f, 0.f, 0.f, 0.f}, q1 = q0;
                            if (smp) { q0 = *(const f32x4*)(sbuf + ((size_t)b * 2 + 0) * DFF + colb + 4 * n); q1 = *(const f32x4*)(sbuf + ((size_t)b * 2 + 1) * DFF + colb + 4 * n); }
                            if (t == 0) { p2[n] = q0; p1[n] = q1; } else { p2[n] = q1; } }
                    }
                    f32x4 hv[2];
#pragma unroll
                    for (int n = 0; n < 2; ++n) { const f32x4 y = cbv[n] + w0[n] * p2[n] + w1[n] * p1[n] + w2[n] * cur[n]; const f32x4 v = acc[ai][1][m][n];
#pragma unroll
                        for (int j = 0; j < 4; ++j) hv[n][j] = gelu_tanh(y[j]) * v[j]; }
                    u32x4 w; w.x = cvt_pk(hv[0][0], hv[0][1]); w.y = cvt_pk(hv[0][2], hv[0][3]); w.z = cvt_pk(hv[1][0], hv[1][1]); w.w = cvt_pk(hv[1][2], hv[1][3]);
                    *(u32x4*)(H + (size_t)gr * DFF + colb) = w;
                    const int L = smp ? 8 : LP;
                    if (t >= L - 2) { float* o = (smp ? out_s : out_p) + ((size_t)b * 2 + (t - (L - 2))) * DFF + colb; *(f32x4*)o = cur[0]; *(f32x4*)(o + 4) = cur[1]; }
                }
            }
        }
    }
};
}

__device__ __forceinline__ void p0_transpose_item(const float* W, int K, int N, bf16_t* WT, bool upmap, LAS float* scr, int item, int lane) {
    const int nblk = N / 32, kb = item / nblk, nb = item % nblk, k0 = 64 * kb, n0 = 32 * nb;
#pragma unroll 8
    for (int i = 0; i < 32; ++i) { const int kk = 2 * i + (lane >> 5); scr[kk * 33 + (lane & 31)] = W[(size_t)(k0 + kk) * N + n0 + (lane & 31)]; }
    asm volatile("s_waitcnt lgkmcnt(0)" ::: "memory");
    int r0 = n0;
    if (upmap) { r0 = n0 < DFF ? (n0 / 128) * 256 + (n0 % 128) : ((n0 - DFF) / 128) * 256 + 128 + ((n0 - DFF) % 128); }
    const int c = lane & 7;
#pragma unroll
    for (int j = 0; j < 4; ++j) { const int n = (lane >> 3) + 8 * j; const LAS float* s = scr + (8 * c) * 33 + n;
        u32x4 o; o.x = cvt_pk(s[0 * 33], s[1 * 33]); o.y = cvt_pk(s[2 * 33], s[3 * 33]); o.z = cvt_pk(s[4 * 33], s[5 * 33]); o.w = cvt_pk(s[6 * 33], s[7 * 33]);
        *(u32x4*)(WT + (size_t)(r0 + n) * K + k0 + 8 * c) = o; }
    asm volatile("s_waitcnt lgkmcnt(0)" ::: "memory");
}

__device__ __forceinline__ void phase_p0(const Args& a, LAS unsigned char* lds, int gw, int NGW, int wave, int lane) {
    unsigned char* ws = a.ws;
    LAS float* scr = (LAS float*)(lds + wave * 16384);
    constexpr int I0 = 16 * 128, I1 = 16 * 32, I2 = 16 * 64, I3 = 16 * 8, I4 = 16 * 32, I5 = 2 * 16 * 176, I6 = 2 * 44 * 32;
    constexpr int NITEMS = I0 + I1 + I2 + I3 + I4 + I5 + I6;
    for (int it = gw; it < NITEMS; it += NGW) {
        int r = it;
        if (r < I0) { p0_transpose_item(a.in[8], 1024, 4096, (bf16_t*)(ws + OFF_W_INAB), false, scr, r, lane); continue; } r -= I0;
        if (r < I1) { p0_transpose_item(a.in[9], 1024, 1024, (bf16_t*)(ws + OFF_W_OUTAB), false, scr, r, lane); continue; } r -= I1;
        if (r < I2) { p0_transpose_item(a.in[12], 1024, 2048, (bf16_t*)(ws + OFF_W_INC), false, scr, r, lane); continue; } r -= I2;
        if (r < I3) { const int mat = r >> 3, sub = r & 7, n = mat >> 1, gate = mat & 1;
            p0_transpose_item(a.in[gate ? 17 : 15] + (size_t)n * 16384, 128, 128, (bf16_t*)(ws + OFF_WG) + (size_t)(n * 2 + gate) * 16384, false, scr, sub, lane); continue; } r -= I3;
        if (r < I4) { p0_transpose_item(a.in[20], 1024, 1024, (bf16_t*)(ws + OFF_W_OUTC), false, scr, r, lane); continue; } r -= I4;
        if (r < I5) { const int l = r / (16 * 176), sub = r % (16 * 176);
            p0_transpose_item(a.in[25] + (size_t)l * 1024 * 5632, 1024, 5632, (bf16_t*)(ws + (l ? OFF_W_UP1 : OFF_W_UP0)), true, scr, sub, lane); continue; } r -= I5;
        { const int l = r / (44 * 32), sub = r % (44 * 32);
            p0_transpose_item(a.in[28] + (size_t)l * 2816 * 1024, 2816, 1024, (bf16_t*)(ws + (l ? OFF_W_DN1 : OFF_W_DN0)), false, scr, sub, lane); }
    }
    bf16_t* XB = (bf16_t*)(ws + OFF_XB);
    for (int row = gw; row < T; row += NGW) {
        const f32x4* xr = (const f32x4*)xsrc_row(a, row) + lane; u32x2* o = (u32x2*)(XB + (size_t)row * DM) + lane;
#pragma unroll
        for (int j = 0; j < 4; ++j) { const f32x4 v = xr[64 * j]; u32x2 w; w.x = cvt_pk(v[0], v[1]); w.y = cvt_pk(v[2], v[3]); o[64 * j] = w; }
    }
    const int gt = gw * 64 + lane, NGT = NGW * 64;
    float* ROPE = (float*)(ws + OFF_ROPE);
    for (int e = gt; e < 2072 * 64; e += NGT) {
        const int pi = e >> 6, i = e & 63; const int pos = pi < 2064 ? pi : 16384 + (pi - 2064);
        const float inv = (float)exp(-(double)i * (9.210340371976184 / 64.0));
        const float ang = (float)pos * inv;
        double rev = (double)ang * 0.15915494309189535; rev -= rint(rev);
        const float r = (float)(rev * 6.283185307179586);
        ROPE[2 * e] = cosf(r); ROPE[2 * e + 1] = sinf(r);
    }
    if (gt < 512) { const float* lg = a.in[10]; const float l0 = lg[gt], l1 = lg[512 + gt], l2 = lg[1024 + gt]; const float mx = fmaxf(l0, fmaxf(l1, l2));
        const float e0 = expf(l0 - mx), e1 = expf(l1 - mx), e2 = expf(l2 - mx); ((float*)(ws + OFF_LBV))[gt] = e0 / (e0 + e1 + e2); }
    if (gt < 1024) { const float lam = a.in[19][gt]; ((float*)(ws + OFF_C8))[gt] = -8.f * (lam > 0.f ? log1pf(expf(-lam)) : (log1pf(expf(lam)) - lam)); }
}

__device__ __forceinline__ void sub_geom(int s, int& row0, int& ntok, int& pidx0) {
    if (s < NS_P) { const int b = s / NSUBP, j = s - b * NSUBP; row0 = b * LP + 16 * j; ntok = 16; pidx0 = 16 * j; }
    else { const int b = s - NS_P; row0 = TP + 8 * b; ntok = 8; pidx0 = 2064; }
}

__device__ __forceinline__ void phase_T(const Args& a, int gw, int NGW, int lane) {
    unsigned char* ws = a.ws;
    bf16_t* PROJ = (bf16_t*)(ws + OFF_BIG); bf16_t* KTT = (bf16_t*)(ws + OFF_XB); float* G = (float*)(ws + OFF_G);
    const float* ROPE = (const float*)(ws + OFF_ROPE); const float* LBV = (const float*)(ws + OFF_LBV);
    const int c2 = lane & 31, th = lane >> 5, ca = 2 * c2, cb = ca + 64;
    for (int it = gw; it < NS * 8; it += NGW) {
        const int s = it >> 3, h = it & 7; int row0, ntok, pidx0; sub_geom(s, row0, ntok, pidx0);
        const bool ret = h < 4; const int hh = h & 3;
        const int qc = (ret ? 0 : 2048) + 128 * hh, kc = (ret ? 512 : 2560) + 128 * hh, vc = (ret ? 1024 : 3072) + 128 * hh;
        const bool act = 8 * th < ntok;
        unsigned qa[8], qb[8], ka[8], kb[8], va[8], vb[8];
#pragma unroll
        for (int ii = 0; ii < 8; ++ii) { qa[ii] = qb[ii] = ka[ii] = kb[ii] = va[ii] = vb[ii] = 0u;
            if (act) { const bf16_t* p = PROJ + (size_t)(row0 + 8 * th + ii) * 4096;
                qa[ii] = *(const unsigned*)(p + qc + ca); qb[ii] = *(const unsigned*)(p + qc + cb);
                ka[ii] = *(const unsigned*)(p + kc + ca); kb[ii] = *(const unsigned*)(p + kc + cb);
                va[ii] = *(const unsigned*)(p + vc + ca); vb[ii] = *(const unsigned*)(p + vc + cb); } }
        unsigned kta[8], ktb[8];
        float g0, g1, g2, g3;
        if (ret) {
            const float lf = log1pf(-exp2f(-5.f - (float)hh));
            g0 = g1 = g2 = g3 = __expf(lf * (float)ntok);
#pragma unroll
            for (int ii = 0; ii < 8; ++ii) {
                kta[ii] = 0u; ktb[ii] = 0u;
                if (act) {
                    const int i = 8 * th + ii; const f32x4 cs = *(const f32x4*)(ROPE + ((size_t)(pidx0 + i) * 64 + ca) * 2);
                    const float eq = __expf(lf * (float)(i + 1)), ek = __expf(-lf * (float)(i + 1)) * 0.08838834764831845f;
                    const float q1l = bflo(qa[ii]), q1h = bfhi(qa[ii]), q2l = bflo(qb[ii]), q2h = bfhi(qb[ii]);
                    const float k1l = bflo(ka[ii]), k1h = bfhi(ka[ii]), k2l = bflo(kb[ii]), k2h = bfhi(kb[ii]);
                    const unsigned qoa = cvt_pk((q1l * cs[0] - q2l * cs[1]) * eq, (q1h * cs[2] - q2h * cs[3]) * eq);
                    const unsigned qob = cvt_pk((q1l * cs[1] + q2l * cs[0]) * eq, (q1h * cs[3] + q2h * cs[2]) * eq);
                    kta[ii] = cvt_pk((k1l * cs[0] - k2l * cs[1]) * ek, (k1h * cs[2] - k2h * cs[3]) * ek);
                    ktb[ii] = cvt_pk((k1l * cs[1] + k2l * cs[0]) * ek, (k1h * cs[3] + k2h * cs[2]) * ek);
                    bf16_t* p = PROJ + (size_t)(row0 + i) * 4096;
                    *(unsigned*)(p + qc + ca) = qoa; *(unsigned*)(p + qc + cb) = qob; *(unsigned*)(p + kc + ca) = kta[ii]; *(unsigned*)(p + kc + cb) = ktb[ii];
                }
            }
        } else {
            const f32x2 lba = *(const f32x2*)(LBV + 128 * hh + ca), lbb = *(const f32x2*)(LBV + 128 * hh + cb);
            float lfv[8][4], kv[8][4]; float t0 = 0.f, t1 = 0.f, t2 = 0.f, t3 = 0.f;
#pragma unroll
            for (int ii = 0; ii < 8; ++ii) {
                const float f0 = lba.x + (1.f - lba.x) * sigmoidf_(bflo(ka[ii])), f1 = lba.y + (1.f - lba.y) * sigmoidf_(bfhi(ka[ii]));
                const float f2 = lbb.x + (1.f - lbb.x) * sigmoidf_(bflo(kb[ii])), f3 = lbb.y + (1.f - lbb.y) * sigmoidf_(bfhi(kb[ii]));
                lfv[ii][0] = act ? __logf(f0) : 0.f; lfv[ii][1] = act ? __logf(f1) : 0.f; lfv[ii][2] = act ? __logf(f2) : 0.f; lfv[ii][3] = act ? __logf(f3) : 0.f;
                kv[ii][0] = 1.f - f0; kv[ii][1] = 1.f - f1; kv[ii][2] = 1.f - f2; kv[ii][3] = 1.f - f3;
                t0 += lfv[ii][0]; t1 += lfv[ii][1]; t2 += lfv[ii][2]; t3 += lfv[ii][3];
            }
            const float o0 = __shfl_xor(t0, 32), o1 = __shfl_xor(t1, 32), o2 = __shfl_xor(t2, 32), o3 = __shfl_xor(t3, 32);
            float r0 = th ? o0 : 0.f, r1 = th ? o1 : 0.f, r2 = th ? o2 : 0.f, r3 = th ? o3 : 0.f;
            g0 = __expf(t0 + o0); g1 = __expf(t1 + o1); g2 = __expf(t2 + o2); g3 = __expf(t3 + o3);
#pragma unroll
            for (int ii = 0; ii < 8; ++ii) {
                kta[ii] = 0u; ktb[ii] = 0u;
                r0 += lfv[ii][0]; r1 += lfv[ii][1]; r2 += lfv[ii][2]; r3 += lfv[ii][3];
                if (act) {
                    const float e0 = __expf(r0), e1 = __expf(r1), e2 = __expf(r2), e3 = __expf(r3);
                    const unsigned qoa = cvt_pk(bflo(qa[ii]) * e0, bfhi(qa[ii]) * e1), qob = cvt_pk(bflo(qb[ii]) * e2, bfhi(qb[ii]) * e3);
                    kta[ii] = cvt_pk(kv[ii][0] * __builtin_amdgcn_rcpf(e0), kv[ii][1] * __builtin_amdgcn_rcpf(e1));
                    ktb[ii] = cvt_pk(kv[ii][2] * __builtin_amdgcn_rcpf(e2), kv[ii][3] * __builtin_amdgcn_rcpf(e3));
                    bf16_t* p = PROJ + (size_t)(row0 + 8 * th + ii) * 4096;
                    *(unsigned*)(p + qc + ca) = qoa; *(unsigned*)(p + qc + cb) = qob; *(unsigned*)(p + kc + ca) = kta[ii]; *(unsigned*)(p + kc + cb) = ktb[ii];
                }
            }
        }
        u32x4 kA0, kA1, kB0, kB1, vA0, vA1, vB0, vB1;
#pragma unroll
        for (int w = 0; w < 4; ++w) {
            kA0[w] = (kta[2 * w] & 0xffffu) | (kta[2 * w + 1] << 16); kA1[w] = (kta[2 * w] >> 16) | (kta[2 * w + 1] & 0xffff0000u);
            kB0[w] = (ktb[2 * w] & 0xffffu) | (ktb[2 * w + 1] << 16); kB1[w] = (ktb[2 * w] >> 16) | (ktb[2 * w + 1] & 0xffff0000u);
            vA0[w] = (va[2 * w] & 0xffffu) | (va[2 * w + 1] << 16); vA1[w] = (va[2 * w] >> 16) | (va[2 * w + 1] & 0xffff0000u);
            vB0[w] = (vb[2 * w] & 0xffffu) | (vb[2 * w + 1] << 16); vB1[w] = (vb[2 * w] >> 16) | (vb[2 * w + 1] & 0xffff0000u);
        }
        bf16_t* kt = KTT + (size_t)(s * 8 + h) * 2048 + 8 * th;
        *(u32x4*)(kt + ca * 16) = kA0; *(u32x4*)(kt + (ca + 1) * 16) = kA1; *(u32x4*)(kt + cb * 16) = kB0; *(u32x4*)(kt + (cb + 1) * 16) = kB1;
        if (act) {
            int lin;
            lin = ca * ntok + 8 * th;       *(u32x4*)(PROJ + (size_t)(row0 + (lin >> 7)) * 4096 + vc + (lin & 127)) = vA0;
            lin = (ca + 1) * ntok + 8 * th; *(u32x4*)(PROJ + (size_t)(row0 + (lin >> 7)) * 4096 + vc + (lin & 127)) = vA1;
            lin = cb * ntok + 8 * th;       *(u32x4*)(PROJ + (size_t)(row0 + (lin >> 7)) * 4096 + vc + (lin & 127)) = vB0;
            lin = (cb + 1) * ntok + 8 * th; *(u32x4*)(PROJ + (size_t)(row0 + (lin >> 7)) * 4096 + vc + (lin & 127)) = vB1;
        }
        if (th == 0) { float* gp = G + (size_t)(s * 8 + h) * 128; *(f32x2*)(gp + ca) = (f32x2){g0, g1}; *(f32x2*)(gp + cb) = (f32x2){g2, g3}; }
    }
}

template <bool EMIT>
__device__ __forceinline__ void gla_step(bf16_t* PROJ, const bf16_t* KTT, const float* G, int s, int h, int sl, f32x4 (&S)[8][2], int lane) {
    const int c = lane & 15, q4 = lane >> 4;
    int row0, ntok, pidx0; sub_geom(s, row0, ntok, pidx0);
    const bool ret = h < 4; const int hh = h & 3;
    const int qc = (ret ? 0 : 2048) + 128 * hh, kc = (ret ? 512 : 2560) + 128 * hh, vc = (ret ? 1024 : 3072) + 128 * hh;
    bf16x4 vf[2];
#pragma unroll
    for (int n = 0; n < 2; ++n) { const int lin = (32 * sl + 16 * n + c) * ntok + 4 * q4; vf[n] = (bf16x4){0, 0, 0, 0};
        if (4 * q4 < ntok) vf[n] = *(const bf16x4*)(PROJ + (size_t)(row0 + (lin >> 7)) * 4096 + vc + (lin & 127)); }
    if (EMIT) {
        bf16x8 kf[4], qf[4]; const bool tv = c < ntok; const bf16_t* pr = PROJ + (size_t)(row0 + c) * 4096;
#pragma unroll
        for (int kk = 0; kk < 4; ++kk) { kf[kk] = (bf16x8){0, 0, 0, 0, 0, 0, 0, 0}; qf[kk] = kf[kk];
            if (tv) { kf[kk] = *(const bf16x8*)(pr + kc + 32 * kk + 8 * q4); qf[kk] = *(const bf16x8*)(pr + qc + 32 * kk + 8 * q4); } }
        f32x4 at = (f32x4){0.f, 0.f, 0.f, 0.f};
#pragma unroll
        for (int kk = 0; kk < 4; ++kk) at = mfma32(kf[kk], qf[kk], at);
#pragma unroll
        for (int r = 0; r < 4; ++r) if (4 * q4 + r > c) at[r] = 0.f;
        const bf16x4 pf = pack4(at);
        f32x4 o[2];
#pragma unroll
        for (int n = 0; n < 2; ++n) { o[n] = mfma16(pf, vf[n], (f32x4){0.f, 0.f, 0.f, 0.f});
#pragma unroll
            for (int kk = 0; kk < 4; ++kk) o[n] = mfma32(qf[kk], pack8(S[2 * kk][n], S[2 * kk + 1][n]), o[n]); }
#pragma unroll
        for (int n = 0; n < 2; ++n)
#pragma unroll
            for (int r = 0; r < 4; ++r) { const int i = 4 * q4 + r;
                if (i < ntok) { const int lin = 32 * sl * ntok + i * 32 + 16 * n + c; PROJ[(size_t)(row0 + (lin >> 7)) * 4096 + vc + (lin & 127)] = (bf16_t)(cvt_pk(o[n][r], 0.f) & 0xffffu); } }
    }
    const bf16_t* kt = KTT + (size_t)(s * 8 + h) * 2048; const float* g = G + (size_t)(s * 8 + h) * 128;
#pragma unroll
    for (int t = 0; t < 8; ++t) { const int dk = 32 * (t >> 1) + 8 * (c >> 2) + 4 * (t & 1) + (c & 3);
        const bf16x4 ka = *(const bf16x4*)(kt + dk * 16 + 4 * q4);
        const f32x4 gv = *(const f32x4*)(g + 32 * (t >> 1) + 8 * q4 + 4 * (t & 1));
#pragma unroll
        for (int n = 0; n < 2; ++n) { S[t][n] = mfma16(ka, vf[n], S[t][n]); S[t][n] = S[t][n] * gv; } }
}
__device__ __forceinline__ void state_load(const float* p, int sl, f32x4 (&S)[8][2], int lane) {
    const int c = lane & 15, q4 = lane >> 4;
#pragma unroll
    for (int t = 0; t < 8; ++t)
#pragma unroll
        for (int n = 0; n < 2; ++n)
#pragma unroll
            for (int r = 0; r < 4; ++r) S[t][n][r] = p[(32 * (t >> 1) + 8 * q4 + 4 * (t & 1) + r) * 128 + 32 * sl + 16 * n + c];
}
__device__ __forceinline__ void state_store(float* p, int sl, const f32x4 (&S)[8][2], int lane) {
    const int c = lane & 15, q4 = lane >> 4;
#pragma unroll
    for (int t = 0; t < 8; ++t)
#pragma unroll
        for (int n = 0; n < 2; ++n)
#pragma unroll
            for (int r = 0; r < 4; ++r) p[(32 * (t >> 1) + 8 * q4 + 4 * (t & 1) + r) * 128 + 32 * sl + 16 * n + c] = S[t][n][r];
}
__device__ __forceinline__ void phase_A(const Args& a, int gw, int NGW, int lane) {
    unsigned char* ws = a.ws; bf16_t* PROJ = (bf16_t*)(ws + OFF_BIG); const bf16_t* KTT = (const bf16_t*)(ws + OFF_XB); const float* G = (const float*)(ws + OFF_G); float* U = (float*)(ws + OFF_U);
    for (int it = gw; it < 64 * 4 * 4; it += NGW) {
        const int sl = it & 3, g = it >> 2, k = 3 - (g & 3), bh = g >> 2, b = bh >> 3, h = bh & 7;
        const int s0 = b * NSUBP + (k == 0 ? 0 : 32 * (k - 1) + 1), ns = k == 0 ? 1 : 32;
        f32x4 S[8][2];
#pragma unroll
        for (int t = 0; t < 8; ++t) { S[t][0] = (f32x4){0.f, 0.f, 0.f, 0.f}; S[t][1] = S[t][0]; }
        for (int j = 0; j < ns; ++j) gla_step<false>(PROJ, KTT, G, s0 + j, h, sl, S, lane);
        state_store(U + (size_t)(bh * 4 + k) * 16384, sl, S, lane);
    }
}
__device__ __forceinline__ void phase_B(const Args& a, int gt, int NGT) {
    unsigned char* ws = a.ws; const float* G = (const float*)(ws + OFF_G); float* U = (float*)(ws + OFF_U);
    for (int idx = gt; idx < 64 * 16384; idx += NGT) {
        const int bh = idx >> 14, e = idx & 16383, dk = e >> 7, b = bh >> 3, h = bh & 7;
        float Sv = 0.f;
        for (int k = 0; k < 4; ++k) {
            const int s0 = b * NSUBP + (k == 0 ? 0 : 32 * (k - 1) + 1), ns = k == 0 ? 1 : 32;
            float gs = 1.f;
            for (int j = 0; j < ns; ++j) gs *= G[(size_t)((s0 + j) * 8 + h) * 128 + dk];
            float* up = U + (size_t)(bh * 4 + k) * 16384 + e;
            Sv = gs * Sv + *up; *up = Sv;
        }
    }
}
__device__ __forceinline__ void phase_C(const Args& a, int gw, int NGW, int lane) {
    unsigned char* ws = a.ws; bf16_t* PROJ = (bf16_t*)(ws + OFF_BIG); const bf16_t* KTT = (const bf16_t*)(ws + OFF_XB); const float* G = (const float*)(ws + OFF_G); const float* U = (const float*)(ws + OFF_U);
    for (int it = gw; it < 1280 + 4096; it += NGW) {
        const int sl = it & 3; f32x4 S[8][2];
        if (it < 1280) {
            int bh, k; if (it < 1024) { const int g = it >> 2; bh = g >> 2; k = (g & 3) + 1; } else { bh = (it - 1024) >> 2; k = 0; }
            const int b = bh >> 3, h = bh & 7;
            if (k == 0) {
#pragma unroll
                for (int t = 0; t < 8; ++t) { S[t][0] = (f32x4){0.f, 0.f, 0.f, 0.f}; S[t][1] = S[t][0]; }
            } else state_load(U + (size_t)(bh * 4 + (k - 1)) * 16384, sl, S, lane);
            const int s0 = b * NSUBP + (k == 0 ? 0 : 32 * (k - 1) + 1), ns = k == 0 ? 1 : 32;
            for (int j = 0; j < ns; ++j) gla_step<true>(PROJ, KTT, G, s0 + j, h, sl, S, lane);
            if (k == 4) state_store(a.out + (h < 4 ? O_RETP : O_HGP) + (size_t)(b * 4 + (h & 3)) * 16384, sl, S, lane);
        } else {
            const int g = (it - 1280) >> 2, b = g >> 3, h = g & 7;
            state_load(a.in[h < 4 ? 2 : 3] + (size_t)(b * 4 + (h & 3)) * 16384, sl, S, lane);
            gla_step<true>(PROJ, KTT, G, NS_P + b, h, sl, S, lane);
            state_store(a.out + (h < 4 ? O_RETS : O_HGS) + (size_t)(b * 4 + (h & 3)) * 16384, sl, S, lane);
        }
    }
}
__device__ __forceinline__ void phase_D(const Args& a, int gw, int NGW, int lane) {
    unsigned char* ws = a.ws; const bf16_t* PROJ = (const bf16_t*)(ws + OFF_BIG); bf16_t* MIX = (bf16_t*)(ws + OFF_XB); const float* nw = a.in[11];
    const int i = lane & 15, sl = lane >> 4;
    for (int it = gw; it < NS * 8; it += NGW) {
        const int s = it >> 3, h = it & 7; int row0, ntok, pidx0; sub_geom(s, row0, ntok, pidx0);
        const bool ret = h < 4; const int hh = h & 3;
        const int vc = (ret ? 1024 : 3072) + 128 * hh, gc = (ret ? 1536 : 3584) + 128 * hh + 32 * sl;
        const bool valid = i < ntok;
        float o[32];
        const int lin0 = 32 * sl * ntok + 32 * i;
        const bf16_t* op = PROJ + (size_t)(row0 + (lin0 >> 7)) * 4096 + vc + (lin0 & 127);
#pragma unroll
        for (int w = 0; w < 4; ++w) { u32x4 x = (u32x4){0u, 0u, 0u, 0u}; if (valid) x = *(const u32x4*)(op + 8 * w);
#pragma unroll
            for (int e = 0; e < 4; ++e) { o[8 * w + 2 * e] = bflo(x[e]); o[8 * w + 2 * e + 1] = bfhi(x[e]); } }
        float sum = 0.f;
#pragma unroll
        for (int e = 0; e < 32; ++e) sum += o[e];
        sum += __shfl_xor(sum, 16); sum += __shfl_xor(sum, 32);
        const float mu = ret ? sum * (1.f / 128.f) : 0.f;
        float sq = 0.f;
#pragma unroll
        for (int e = 0; e < 32; ++e) { const float d = o[e] - mu; sq += d * d; }
        sq += __shfl_xor(sq, 16); sq += __shfl_xor(sq, 32);
        const float rstd = rsqrtf(sq * (1.f / 128.f) + LN_EPS);
        if (valid) {
            const bf16_t* gp = PROJ + (size_t)(row0 + i) * 4096 + gc; bf16_t* mp = MIX + (size_t)(row0 + i) * DM + 128 * h + 32 * sl;
#pragma unroll
            for (int w = 0; w < 4; ++w) { const u32x4 gx = *(const u32x4*)(gp + 8 * w); float r[8];
#pragma unroll
                for (int e = 0; e < 4; ++e) { const float g0 = bflo(gx[e]), g1 = bfhi(gx[e]);
                    float v0 = (o[8 * w + 2 * e] - mu) * rstd, v1 = (o[8 * w + 2 * e + 1] - mu) * rstd;
                    if (!ret) { v0 *= nw[32 * sl + 8 * w + 2 * e]; v1 *= nw[32 * sl + 8 * w + 2 * e + 1]; }
                    r[2 * e] = v0 * g0 * sigmoidf_(g0); r[2 * e + 1] = v1 * g1 * sigmoidf_(g1); }
                u32x4 ov; ov.x = cvt_pk(r[0], r[1]); ov.y = cvt_pk(r[2], r[3]); ov.z = cvt_pk(r[4], r[5]); ov.w = cvt_pk(r[6], r[7]);
                *(u32x4*)(mp + 8 * w) = ov; }
        }
    }
}

template <bool FINAL>
__device__ __forceinline__ void phase_LN(const Args& a, const float* gam, const float* bet, int gw, int NGW, int lane) {
    unsigned char* ws = a.ws; float* X32 = (float*)(ws + OFF_X32); bf16_t* XB = (bf16_t*)(ws + OFF_XB);
    f32x4 gv[4], bv[4];
#pragma unroll
    for (int j = 0; j < 4; ++j) { gv[j] = ((const f32x4*)gam)[lane + 64 * j]; bv[j] = ((const f32x4*)bet)[lane + 64 * j]; }
    for (int row = gw; row < T; row += NGW) {
        f32x4* xr = (f32x4*)(X32 + (size_t)row * DM) + lane;
        f32x4 v[4]; float s = 0.f;
#pragma unroll
        for (int j = 0; j < 4; ++j) { v[j] = xr[64 * j]; s += (v[j][0] + v[j][1]) + (v[j][2] + v[j][3]); }
        const float mean = wave_sum(s) * (1.f / DM); float s2 = 0.f;
#pragma unroll
        for (int j = 0; j < 4; ++j) { v[j] = v[j] - mean; s2 += (v[j][0] * v[j][0] + v[j][1] * v[j][1]) + (v[j][2] * v[j][2] + v[j][3] * v[j][3]); }
        const float rstd = rsqrtf(wave_sum(s2) * (1.f / DM) + LN_EPS);
#pragma unroll
        for (int j = 0; j < 4; ++j) v[j] = v[j] * rstd * gv[j] + bv[j];
        if (FINAL) {
            float* op = nullptr;
            if (row < TP) { const int b = row / LP, t = row - b * LP; if (t >= 16) op = a.out + O_YP + ((size_t)b * 2048 + (t - 16)) * DM; }
            else op = a.out + O_YS + (size_t)(row - TP) * DM;
            if (op) {
#pragma unroll
                for (int j = 0; j < 4; ++j) ((f32x4*)op)[lane + 64 * j] = v[j]; }
        } else {
            u32x2* ob = (u32x2*)(XB + (size_t)row * DM) + lane;
#pragma unroll
            for (int j = 0; j < 4; ++j) { xr[64 * j] = v[j]; u32x2 w; w.x = cvt_pk(v[j][0], v[j][1]); w.y = cvt_pk(v[j][2], v[j][3]); ob[64 * j] = w; }
        }
    }
}

__device__ __forceinline__ void phase_F1(const Args& a, int gw, int NGW, int lane) {
    unsigned char* ws = a.ws; const bf16_t* GR = (const bf16_t*)(ws + OFF_H); const bf16_t* WG = (const bf16_t*)(ws + OFF_WG);
    bf16_t* HL = (bf16_t*)(ws + OFF_HL); bf16_t* AC = (bf16_t*)(ws + OFF_XB); float* TA = (float*)(ws + OFF_TA); float* TH = (float*)(ws + OFF_TH);
    const float* C8 = (const float*)(ws + OFF_C8);
    const float* convw = a.in[13]; const float* convb = a.in[14]; const float* bga = a.in[16]; const float* bgx = a.in[18];
    const int c = lane & 15, q4 = lane >> 4;
    for (int it = gw; it < NTILE * 8; it += NGW) {
        const int tt = it >> 3, n = it & 7;
        int row, b, t, W; bool smp;
        if (tt < NT_P) { b = tt / NSUBP; const int j = tt - b * NSUBP; row = b * LP + 16 * j + c; t = 16 * j + c; W = 16; smp = false; }
        else { const int k = tt - NT_P; row = TP + 16 * k + c; b = 2 * k + (c >> 3); t = c & 7; W = 8; smp = true; }
        const int chb = 128 * n;
        bf16x8 bfr[4];
#pragma unroll
        for (int q = 0; q < 4; ++q) bfr[q] = (bf16x8){0, 0, 0, 0, 0, 0, 0, 0};
#pragma unroll 1
        for (int kk = 0; kk < 4; ++kk) {
            const int ch0 = chb + 32 * kk + 8 * q4;
            f32x4 s0 = *(const f32x4*)(convb + ch0), s1 = *(const f32x4*)(convb + ch0 + 4);
#pragma unroll
            for (int d = 0; d < 4; ++d) {
                const f32x4 wa = *(const f32x4*)(convw + (3 - d) * 1024 + ch0), wb = *(const f32x4*)(convw + (3 - d) * 1024 + ch0 + 4);
                f32x4 xa = (f32x4){0.f, 0.f, 0.f, 0.f}, xb = xa;
                if (t - d >= 0) { const u32x4 x = *(const u32x4*)(GR + (size_t)(row - d) * 2048 + 1024 + ch0);
                    xa = (f32x4){bflo(x[0]), bfhi(x[0]), bflo(x[1]), bfhi(x[1])}; xb = (f32x4){bflo(x[2]), bfhi(x[2]), bflo(x[3]), bfhi(x[3])}; }
                else if (smp) { const float* sp = a.in[5] + ((size_t)b * 3 + (t - d + 3)) * 1024 + ch0; xa = *(const f32x4*)sp; xb = *(const f32x4*)(sp + 4); }
                s0 += wa * xa; s1 += wb * xb;
            }
            { const bf16x8 pv = pack8(s0, s1);
#pragma unroll
              for (int q = 0; q < 4; ++q) bfr[q] = (kk == q) ? pv : bfr[q]; }
        }
#pragma unroll 1
        for (int kk = 0; kk < 4; ++kk) {
            f32x4 ra[2], ia[2];
#pragma unroll
            for (int hf = 0; hf < 2; ++hf) {
                const int oc = 32 * kk + 8 * (c >> 2) + 4 * hf + (c & 3);
                ra[hf] = (f32x4){0.f, 0.f, 0.f, 0.f}; ia[hf] = ra[hf];
#pragma unroll
                for (int k2 = 0; k2 < 4; ++k2) {
                    const bf16x8 wa = *(const bf16x8*)(WG + ((size_t)(n * 2 + 0) * 128 + oc) * 128 + 32 * k2 + 8 * q4);
                    const bf16x8 wx = *(const bf16x8*)(WG + ((size_t)(n * 2 + 1) * 128 + oc) * 128 + 32 * k2 + 8 * q4);
                    ra[hf] = mfma32(wa, bfr[k2], ra[hf]); ia[hf] = mfma32(wx, bfr[k2], ia[hf]);
                }
            }
            const int ch0 = chb + 32 * kk + 8 * q4;
            float Av[8], Bv[8], xcv[8];
            { const u32x4 x0 = __builtin_bit_cast(u32x4, bfr[0]), x1 = __builtin_bit_cast(u32x4, bfr[1]), x2 = __builtin_bit_cast(u32x4, bfr[2]), x3 = __builtin_bit_cast(u32x4, bfr[3]);
#pragma unroll
              for (int e = 0; e < 4; ++e) { const unsigned w = kk == 0 ? x0[e] : kk == 1 ? x1[e] : kk == 2 ? x2[e] : x3[e]; xcv[2 * e] = bflo(w); xcv[2 * e + 1] = bfhi(w); } }
            const f32x4 ba0 = *(const f32x4*)(bga + ch0), ba1 = *(const f32x4*)(bga + ch0 + 4), bx0 = *(const f32x4*)(bgx + ch0), bx1 = *(const f32x4*)(bgx + ch0 + 4);
            const f32x4 c80 = *(const f32x4*)(C8 + ch0), c81 = *(const f32x4*)(C8 + ch0 + 4);
            f32x4 h00 = (f32x4){0.f, 0.f, 0.f, 0.f}, h01 = h00;
            if (smp && t == 0) { h00 = *(const f32x4*)(a.in[4] + (size_t)b * 1024 + ch0); h01 = *(const f32x4*)(a.in[4] + (size_t)b * 1024 + ch0 + 4); }
#pragma unroll
            for (int jp = 0; jp < 8; ++jp) {
                const int hf = jp >> 2, r = jp & 3;
                const float rr = sigmoidf_(ra[hf][r] + (hf ? ba1[r] : ba0[r])), ii = sigmoidf_(ia[hf][r] + (hf ? bx1[r] : bx0[r]));
                const float la = rr * (hf ? c81[r] : c80[r]); const float av = __expf(la);
                float bv = sqrtf(-expm1f(2.f * la)) * (ii * xcv[jp]);
                bv += av * (hf ? h01[r] : h00[r]);
                Av[jp] = av; Bv[jp] = bv;
            }
            for (int d = 1; d < W; d <<= 1) {
                const int src = (lane - d) & 63; const bool take = (c & (W - 1)) >= d;
#pragma unroll
                for (int jp = 0; jp < 8; ++jp) { const float ap = __shfl(Av[jp], src), bp = __shfl(Bv[jp], src);
                    if (take) { Bv[jp] = Av[jp] * bp + Bv[jp]; Av[jp] = Av[jp] * ap; } }
            }
            u32x4 hw, aw;
#pragma unroll
            for (int e = 0; e < 4; ++e) { hw[e] = cvt_pk(Bv[2 * e], Bv[2 * e + 1]); aw[e] = cvt_pk(Av[2 * e], Av[2 * e + 1]); }
            *(u32x4*)(HL + (size_t)row * 1024 + ch0) = hw; *(u32x4*)(AC + (size_t)row * 1024 + ch0) = aw;
            if (!smp && c == 15) {
                float* ta = TA + (size_t)tt * 1024 + ch0; float* thp = TH + (size_t)tt * 1024 + ch0;
                *(f32x4*)ta = (f32x4){Av[0], Av[1], Av[2], Av[3]}; *(f32x4*)(ta + 4) = (f32x4){Av[4], Av[5], Av[6], Av[7]};
                *(f32x4*)thp = (f32x4){Bv[0], Bv[1], Bv[2], Bv[3]}; *(f32x4*)(thp + 4) = (f32x4){Bv[4], Bv[5], Bv[6], Bv[7]};
            }
        }
    }
}
__device__ __forceinline__ void phase_F2(const Args& a, int gt, int NGT) {
    unsigned char* ws = a.ws; const float* __restrict__ TA = (const float*)(ws + OFF_TA); const float* __restrict__ TH = (const float*)(ws + OFF_TH); float* __restrict__ CARRY = (float*)(ws + OFF_CARRY);
    for (int idx = gt; idx < NB * 1024; idx += NGT) {
        const int b = idx >> 10, ch = idx & 1023; float carry = 0.f;
#pragma unroll 8
        for (int j = 0; j < NSUBP; ++j) { const size_t o = (size_t)(b * NSUBP + j) * 1024 + ch; CARRY[o] = carry; carry = TA[o] * carry + TH[o]; }
        a.out[O_HP + idx] = carry;
    }
}
__device__ __forceinline__ void phase_F3(const Args& a, int gw, int NGW, int lane) {
    unsigned char* ws = a.ws; const bf16_t* GR = (const bf16_t*)(ws + OFF_H); const bf16_t* HL = (const bf16_t*)(ws + OFF_HL); bf16_t* AC = (bf16_t*)(ws + OFF_XB); const float* CARRY = (const float*)(ws + OFF_CARRY);
    for (int row = gw; row < T; row += NGW) {
        int b, t; const bool smp = row >= TP;
        if (!smp) { b = row / LP; t = row - b * LP; } else { b = (row - TP) >> 3; t = (row - TP) & 7; }
        const float* cp = smp ? nullptr : CARRY + (size_t)(b * NSUBP + (t >> 4)) * 1024;
#pragma unroll
        for (int half = 0; half < 2; ++half) {
            const int ch = 512 * half + 8 * lane;
            const u32x4 hl = *(const u32x4*)(HL + (size_t)row * 1024 + ch), ac = *(const u32x4*)(AC + (size_t)row * 1024 + ch);
            const u32x4 gt = *(const u32x4*)(GR + (size_t)row * 2048 + ch);
            f32x4 c0 = (f32x4){0.f, 0.f, 0.f, 0.f}, c1 = c0; if (!smp) { c0 = *(const f32x4*)(cp + ch); c1 = *(const f32x4*)(cp + ch + 4); }
            float hv[8];
#pragma unroll
            for (int e = 0; e < 4; ++e) { const float cl = e < 2 ? c0[2 * e] : c1[2 * e - 4], chh = e < 2 ? c0[2 * e + 1] : c1[2 * e - 3];
                hv[2 * e] = bflo(hl[e]) + bflo(ac[e]) * cl; hv[2 * e + 1] = bfhi(hl[e]) + bfhi(ac[e]) * chh; }
            u32x4 y;
#pragma unroll
            for (int e = 0; e < 4; ++e) y[e] = cvt_pk(gelu_tanh(bflo(gt[e])) * hv[2 * e], gelu_tanh(bfhi(gt[e])) * hv[2 * e + 1]);
            *(u32x4*)(AC + (size_t)row * 1024 + ch) = y;
            if (smp && t == 7) { float* o = a.out + O_HS + (size_t)b * 1024 + ch; *(f32x4*)o = (f32x4){hv[0], hv[1], hv[2], hv[3]}; *(f32x4*)(o + 4) = (f32x4){hv[4], hv[5], hv[6], hv[7]}; }
            const int L = smp ? 8 : LP;
            if (t >= L - 3) { const u32x4 rn = *(const u32x4*)(GR + (size_t)row * 2048 + 1024 + ch);
                float* o = a.out + (smp ? O_CBS : O_CBP) + ((size_t)b * 3 + (t - (L - 3))) * 1024 + ch;
                *(f32x4*)o = (f32x4){bflo(rn[0]), bfhi(rn[0]), bflo(rn[1]), bfhi(rn[1])}; *(f32x4*)(o + 4) = (f32x4){bflo(rn[2]), bfhi(rn[2]), bflo(rn[3]), bfhi(rn[3])}; }
        }
    }
}

constexpr size_t OFF_BAR = 16 * KiB;
__device__ __forceinline__ void gsync(unsigned* bar, unsigned& epoch, unsigned G) {
    asm volatile("s_waitcnt vmcnt(0) lgkmcnt(0)" ::: "memory");
    __syncthreads();
    epoch += G;
    if (threadIdx.x == 0) {
        __builtin_amdgcn_fence(__ATOMIC_RELEASE, "agent");
        asm volatile("s_waitcnt vmcnt(0)" ::: "memory");
        __hip_atomic_fetch_add(bar, 1u, __ATOMIC_RELAXED, __HIP_MEMORY_SCOPE_AGENT);
        unsigned sp = 0;
        while (__hip_atomic_load(bar, __ATOMIC_RELAXED, __HIP_MEMORY_SCOPE_AGENT) < epoch) { __builtin_amdgcn_s_sleep(2); if (++sp > (1u << 22)) break; }
        __builtin_amdgcn_fence(__ATOMIC_ACQUIRE, "agent");
        asm volatile("s_waitcnt vmcnt(0)" ::: "memory");
    }
    __syncthreads();
}

__device__ __forceinline__ void dump_bf16(const Args& a, const bf16_t* src, int ld, int rowstep, int gt, int NGT) {
    for (size_t i = gt; i < (size_t)4096 * 4096; i += NGT) { const int r = (int)(i >> 12), c = (int)(i & 4095); a.out[i] = __uint_as_float(((unsigned)src[(size_t)(r * rowstep) * ld + (c % ld)]) << 16); }
}
__device__ __forceinline__ void dump_f32(const Args& a, const float* src, size_t n, int gt, int NGT) { for (size_t i = gt; i < n; i += NGT) a.out[O_YS + i] = src[i]; }
__global__ void __launch_bounds__(512) fwd_megakernel(Args a) {
    extern __shared__ __attribute__((aligned(16))) unsigned char lds_raw[];
    cg::grid_group grid = cg::this_grid();
    LAS unsigned char* lds = (LAS unsigned char*)lds_raw;
#define FRESH() int tid = threadIdx.x; asm volatile("" : "+v"(tid)); const int lane = tid & 63, wave = __builtin_amdgcn_readfirstlane(tid >> 6); \
    const int gw = blockIdx.x * 8 + wave, NGW = G * 8, gt = blockIdx.x * 512 + tid, NGT = G * 512; (void)gw; (void)NGW; (void)gt; (void)NGT; (void)lane;
    const int G = gridDim.x;
    unsigned char* ws = a.ws;
    bf16_t* XB = (bf16_t*)(ws + OFF_XB); float* X32 = (float*)(ws + OFF_X32);
    bf16_t* PROJ = (bf16_t*)(ws + OFF_BIG); bf16_t* HB = (bf16_t*)(ws + OFF_H);
    pg8::StaticOrder S;
    unsigned* bar = (unsigned*)(ws + OFF_BAR); unsigned epoch = 0;
#define GS() gsync(bar, epoch, (unsigned)G)

    { FRESH() phase_p0(a, lds, gw, NGW, wave, lane); }
    grid.sync(); GS();
    { S.init(MP / 256, 4096 / 256, G, (int)blockIdx.x); pg8::EpiBf16 E{PROJ, 4096};
      pg8::gemm_phase<pg8::EpiBf16, 0>(lds, XB, (const bf16_t*)(ws + OFF_W_INAB), 1024, S, E); }
    GS();
    { FRESH() phase_T(a, gw, NGW, lane); }
    GS();
#if STOP_AT == 11
    { FRESH() for (size_t i = gt; i < (size_t)16384 * 1024; i += NGT) { const size_t r = i >> 10; const int c = (int)(i & 1023); const int col = c < 512 ? 1024 + c : 3072 + (c - 512); a.out[i] = __uint_as_float(((unsigned)PROJ[r * 4096 + col]) << 16); } }
    return;
#endif
    { FRESH() phase_A(a, gw, NGW, lane); }
    GS();
    { FRESH() phase_B(a, gt, NGT); }
    GS();
    { FRESH() phase_C(a, gw, NGW, lane); }
    GS();
#if STOP_AT == 12
    { FRESH() for (size_t i = gt; i < (size_t)16384 * 1024; i += NGT) { const size_t r = i >> 10; const int c = (int)(i & 1023); const int col = c < 512 ? 1024 + c : 3072 + (c - 512); a.out[i] = __uint_as_float(((unsigned)PROJ[r * 4096 + col]) << 16); } }
    return;
#endif
    { FRESH() phase_D(a, gw, NGW, lane); }
    GS();
#if STOP_AT == 13
    { FRESH() for (size_t i = gt; i < (size_t)16384 * 1024; i += NGT) a.out[i] = __uint_as_float(((unsigned)XB[i]) << 16); for (size_t i = gt; i < (size_t)1024 * 1024; i += NGT) a.out[O_YS + i] = __uint_as_float(((unsigned)XB[(size_t)TP * 1024 + i]) << 16); }
    return;
#endif
    { S.init(MP / 256, 1024 / 256, G, (int)blockIdx.x); pg8::EpiRes E{X32, a, 0};
      pg8::gemm_phase<pg8::EpiRes, 0>(lds, XB, (const bf16_t*)(ws + OFF_W_OUTAB), 1024, S, E); }
    GS();
#if STOP_AT == 14
    { FRESH() for (size_t i = gt; i < (size_t)16384 * 1024; i += NGT) a.out[i] = X32[i]; for (size_t i = gt; i < (size_t)1024 * 1024; i += NGT) a.out[O_YS + i] = X32[(size_t)TP * 1024 + i]; }
    return;
#endif
#if STOP_AT == 1
    { FRESH() phase_LN<true>(a, a.in[21], a.in[22], gw, NGW, lane); }
    return;
#endif
    { FRESH() phase_LN<false>(a, a.in[21], a.in[22], gw, NGW, lane); }
    GS();
#define FFN_PHASES(layer) \
    { S.init(71, DFF / 128, G, (int)blockIdx.x); \
      pg8::EpiFFN E{HB, a.in[26] + (size_t)(layer) * 3 * DFF, a.in[27] + (size_t)(layer) * DFF, a.in[6] + (size_t)(layer) * SBAT * 2 * DFF, \
                    a.out + O_FBP + (size_t)(layer) * NB * 2 * DFF, a.out + O_FBS + (size_t)(layer) * SBAT * 2 * DFF}; \
      pg8::gemm_phase<pg8::EpiFFN, 1>(lds, XB - 2 * 1024, (const bf16_t*)(ws + ((layer) ? OFF_W_UP1 : OFF_W_UP0)), 1024, S, E); } \
    GS(); \
    { S.init(MP / 256, 1024 / 256, G, (int)blockIdx.x); pg8::EpiRes E{X32, a, 1}; \
      pg8::gemm_phase<pg8::EpiRes, 0>(lds, HB, (const bf16_t*)(ws + ((layer) ? OFF_W_DN1 : OFF_W_DN0)), DFF, S, E); } \
    GS();
    FFN_PHASES(0)
#if STOP_AT == 2
    { FRESH() phase_LN<true>(a, a.in[23], a.in[24], gw, NGW, lane); }
    return;
#endif
    { FRESH() phase_LN<false>(a, a.in[23], a.in[24], gw, NGW, lane); }
    GS();
    { S.init(MP / 256, 2048 / 256, G, (int)blockIdx.x); pg8::EpiBf16 E{HB, 2048};
      pg8::gemm_phase<pg8::EpiBf16, 0>(lds, XB, (const bf16_t*)(ws + OFF_W_INC), 1024, S, E); }
    GS();
    { FRESH() phase_F1(a, gw, NGW, lane); }
    GS();
    { FRESH() phase_F2(a, gt, NGT); }
    GS();
    { FRESH() phase_F3(a, gw, NGW, lane); }
    GS();
    { S.init(MP / 256, 1024 / 256, G, (int)blockIdx.x); pg8::EpiRes E{X32, a, 1};
      pg8::gemm_phase<pg8::EpiRes, 0>(lds, XB, (const bf16_t*)(ws + OFF_W_OUTC), 1024, S, E); }
    GS();
#if STOP_AT == 3
    { FRESH() phase_LN<true>(a, a.in[21] + 1024, a.in[22] + 1024, gw, NGW, lane); }
    return;
#endif
    { FRESH() phase_LN<false>(a, a.in[21] + 1024, a.in[22] + 1024, gw, NGW, lane); }
    GS();
    FFN_PHASES(1)
    { FRESH() phase_LN<true>(a, a.in[23] + 1024, a.in[24] + 1024, gw, NGW, lane); }
#undef FFN_PHASES
}

extern "C" void kernel_launch(void* const* d_in, const int* in_sizes, int n_in, void* d_out, int out_size, void* d_ws, size_t ws_size, hipStream_t stream) {
    static int grid = 0;
    if (grid == 0) {
        if (n_in != 29 || ws_size < WS_END) { fprintf(stderr, "kernel_launch: unexpected n_in %d / ws %zu\n", n_in, ws_size); grid = -1; return; }
        int dev = 0, cus = 0, per_cu = 0;
        hipGetDevice(&dev); hipDeviceGetAttribute(&cus, hipDeviceAttributeMultiprocessorCount, dev);
        if (hipFuncSetAttribute((const void*)fwd_megakernel, hipFuncAttributeMaxDynamicSharedMemorySize, LDS_BYTES) != hipSuccess) { fprintf(stderr, "kernel_launch: hipFuncSetAttribute failed\n"); grid = -1; return; }
        if (hipOccupancyMaxActiveBlocksPerMultiprocessor(&per_cu, (const void*)fwd_megakernel, 512, LDS_BYTES) != hipSuccess || per_cu < 1) { fprintf(stderr, "kernel_launch: occupancy query says %d\n", per_cu); per_cu = 1; }
        (void)hipGetLastError();
        grid = cus * 1;
    }
    if (grid < 0) return;
    (void)hipMemsetAsync((char*)d_ws + OFF_BAR, 0, 256, stream);
    Args a{};
    for (int i = 0; i < 29; ++i) a.in[i] = (const float*)d_in[i];
    a.out = (float*)d_out; a.ws = (unsigned char*)d_ws;
    void* args[] = {&a};
    hipError_t e = hipLaunchCooperativeKernel((const void*)fwd_megakernel, dim3(grid), dim3(512), args, LDS_BYTES, stream);
    if (e != hipSuccess) fprintf(stderr, "cooperative launch failed: %s (grid %d)\n", hipGetErrorString(e), grid);
}
```

```cpp
#include <hip/hip_runtime.h>
#include <hip/hip_cooperative_groups.h>
#include <cstdio>
#include <cstdint>
namespace cg = cooperative_groups;
#ifndef PROBE_A
#define PROBE_A -1
#define PROBE_B -1
#endif

#define LAS __attribute__((address_space(3)))
typedef unsigned short bf16_t;
typedef short bf16x8 __attribute__((ext_vector_type(8)));
typedef short bf16x4 __attribute__((ext_vector_type(4)));
typedef float f32x4 __attribute__((ext_vector_type(4)));
typedef float f32x2 __attribute__((ext_vector_type(2)));
typedef unsigned u32x4 __attribute__((ext_vector_type(4)));
typedef unsigned u32x2 __attribute__((ext_vector_type(2)));

constexpr int DM = 1024, LP = 2064, NB = 8, TP = NB * LP, SBAT = 128, TS = SBAT * 8, T = TP + TS, MP = 17664;
constexpr int DFF = 2816;
constexpr int NSUBP = 129, NS_P = NB * NSUBP, NS = NS_P + SBAT;
constexpr int NT_P = NB * NSUBP, NT_S = TS / 16, NTILE = NT_P + NT_S;
constexpr float LN_EPS = 1e-5f;
constexpr float ALPHA = 1.41421356237f;

constexpr size_t O_YP = 0, O_YS = 16777216, O_RETP = 17825792, O_RETS = 18350080, O_HGP = 26738688, O_HGS = 27262976, O_HP = 35651584, O_HS = 35659776,
                 O_CBP = 35790848, O_CBS = 35815424, O_FBP = 36208640, O_FBS = 36298752;

constexpr size_t KiB = 1024, MiB = 1024 * 1024;
constexpr size_t OFF_LBV = 0;
constexpr size_t OFF_C8 = 4 * KiB;
constexpr size_t OFF_W_INC = 1 * MiB;
constexpr size_t OFF_WG = 5 * MiB;
constexpr size_t OFF_W_OUTC = 5 * MiB + 512 * KiB;
constexpr size_t OFF_W_UP1 = 7 * MiB + 512 * KiB;
constexpr size_t OFF_W_DN1 = 18 * MiB + 512 * KiB;
constexpr size_t OFF_XB = 24 * MiB + 4096;
constexpr size_t OFF_BIG = 60 * MiB + 512 * KiB;
constexpr size_t OFF_X32 = OFF_BIG;
constexpr size_t OFF_H = 129 * MiB + 512 * KiB;
constexpr size_t OFF_HL = 198 * MiB + 512 * KiB;
constexpr size_t OFF_G = 198 * MiB + 512 * KiB;
constexpr size_t OFF_GS = 203 * MiB + 256 * KiB;
constexpr size_t OFF_U = 204 * MiB;
constexpr size_t OFF_ROPE = 221 * MiB;
constexpr size_t OFF_TA = 233 * MiB, OFF_TH = 238 * MiB, OFF_CARRY = 243 * MiB;
constexpr size_t OFF_W_INAB = 229 * MiB + 512 * KiB;
constexpr size_t OFF_W_OUTAB = 237 * MiB + 512 * KiB;
constexpr size_t OFF_W_UP0 = 239 * MiB + 512 * KiB;
constexpr size_t OFF_W_DN0 = 250 * MiB + 512 * KiB;
constexpr size_t OFF_PART = 224 * MiB + 512 * KiB;
constexpr size_t WS_END = 256 * MiB;
static_assert(OFF_PART + (size_t)11 * 1152 * 1024 * 2 <= OFF_W_DN0, "part");
static_assert(OFF_XB - 4096 + 36 * MiB + 512 * KiB <= OFF_BIG, "xb");
static_assert((size_t)NS * 8 * 128 * 16 * 2 <= OFF_BIG - OFF_XB, "ktt");
static_assert(OFF_H + (size_t)MP * DFF * 2 <= OFF_W_INAB, "h");
static_assert(OFF_G + (size_t)NS * 8 * 128 * 4 <= OFF_GS, "g");
static_assert(OFF_U + 32 * MiB <= OFF_W_OUTAB, "u");
static_assert(OFF_ROPE + 2072 * 64 * 2 * 4 <= OFF_W_INAB, "rope");
static_assert(OFF_HL + (size_t)T * 1024 * 2 <= OFF_TA, "hl");
static_assert(OFF_CARRY + (size_t)NTILE * 1024 * 4 <= WS_END, "carry");

constexpr int LDS_BYTES = 147456;

typedef __bf16 bf16x2_t __attribute__((ext_vector_type(2)));
__device__ __forceinline__ unsigned cvt_pk(float lo, float hi) { f32x2 v = {lo, hi}; bf16x2_t b = __builtin_convertvector(v, bf16x2_t); return __builtin_bit_cast(unsigned, b); }
__device__ __forceinline__ float bflo(unsigned w) { return __uint_as_float(w << 16); }
__device__ __forceinline__ float bfhi(unsigned w) { return __uint_as_float(w & 0xffff0000u); }
__device__ __forceinline__ float sigmoidf_(float x) { return __builtin_amdgcn_rcpf(1.f + __expf(-x)); }
__device__ __forceinline__ float gelu_tanh(float x) { const float t = x * x; const float e = __builtin_amdgcn_exp2f(x * __builtin_fmaf(t, -0.1029432407f, -2.3022081985f)); return x * __builtin_amdgcn_rcpf(1.f + e); }
__device__ __forceinline__ float wave_sum(float v) {
#pragma unroll
    for (int o = 1; o < 64; o <<= 1) v += __shfl_xor(v, o);
    return v;
}
__device__ __forceinline__ float ror1(float v) { return __int_as_float(__builtin_amdgcn_update_dpp(0, __float_as_int(v), 0x121, 0xf, 0xf, false)); }
__device__ __forceinline__ float ror2(float v) { return __int_as_float(__builtin_amdgcn_update_dpp(0, __float_as_int(v), 0x122, 0xf, 0xf, false)); }
__device__ __forceinline__ f32x4 mfma32(bf16x8 a, bf16x8 b, f32x4 c) { return __builtin_amdgcn_mfma_f32_16x16x32_bf16(a, b, c, 0, 0, 0); }
__device__ __forceinline__ f32x4 mfma16(bf16x4 a, bf16x4 b, f32x4 c) { const bf16x8 a8 = (bf16x8){a[0], a[1], a[2], a[3], 0, 0, 0, 0}, b8 = (bf16x8){b[0], b[1], b[2], b[3], 0, 0, 0, 0}; return __builtin_amdgcn_mfma_f32_16x16x32_bf16(a8, b8, c, 0, 0, 0); }
__device__ __forceinline__ bf16x4 pack4(f32x4 v) { u32x2 w; w.x = cvt_pk(v[0], v[1]); w.y = cvt_pk(v[2], v[3]); return __builtin_bit_cast(bf16x4, w); }
__device__ __forceinline__ bf16x8 pack8(f32x4 a, f32x4 b) { u32x4 w; w.x = cvt_pk(a[0], a[1]); w.y = cvt_pk(a[2], a[3]); w.z = cvt_pk(b[0], b[1]); w.w = cvt_pk(b[2], b[3]); return __builtin_bit_cast(bf16x8, w); }

struct Args { const float* in[29]; float* out; unsigned char* ws; };

__device__ __forceinline__ const float* xsrc_row(const Args& a, int row) {
    if (row < TP) { const int b = row / LP, t = row - b * LP; return t < 16 ? a.in[7] + (size_t)t * DM : a.in[0] + ((size_t)b * 2048 + (t - 16)) * DM; }
    return a.in[1] + (size_t)(row - TP) * DM;
}

namespace pg8 {
constexpr int BM = 256, BK = 64, HALF = 128, HTB = HALF * BK * 2, STAGE_BYTES = 8 * HTB, NXCD = 8, WGM = 8;
__device__ __forceinline__ int lds_byte(int r, int c) { const int st = (r >> 4) * 2 + (c >> 5), rr = r & 15, cc = c & 31, ob = rr * 64 + cc * 2; return st * 1024 + (ob ^ (((ob >> 9) & 1) << 5)); }
__device__ __forceinline__ void stage_rc(int b, int& R, int& C) { const int st = b / 1024, sb = b % 1024, swz = sb ^ (((sb >> 9) & 1) << 5); R = (st >> 1) * 16 + swz / 64; C = (st & 1) * 32 + (swz % 64) / 2; }
__device__ __forceinline__ int perm32(int rho) { const int n = rho >> 4, i = rho & 15; return 8 * (i >> 2) + 4 * n + (i & 3); }
struct Unit { int pm, pn, k0, nt, split; };
struct StaticOrder {
    int nM, nN, nwg, G, c, ntf, nfull, nsub, nsplit;
    __device__ __forceinline__ void init(int nM_, int nN_, int G_, int c_, int ntf_, bool SPLIT) { nM = nM_; nN = nN_; nwg = nM * nN; G = G_; c = c_; ntf = ntf_;
        nfull = nwg; nsub = 0; nsplit = 1;
        if (SPLIT && G == 256 && nN == 4 && nM > 64) { nsplit = ntf / 4; nfull = 256; nsub = (nM - 64) * 4 * nsplit; nM = 64; nwg = 256; } }
    __device__ __forceinline__ bool next(int i, Unit& u) const {
        const int L = i * G + c;
        const bool sub = L >= nfull; const int s = L - nfull;
        if (sub && s >= nsub) return false;
        int wgid = sub ? 0 : L;
        { const int q = nwg / NXCD, r = nwg % NXCD, xcd = wgid % NXCD, off = wgid / NXCD; wgid = (xcd < r ? xcd * (q + 1) : r * (q + 1) + (xcd - r) * q) + off; }
        const int nig = WGM * nN, gid = wgid / nig, fm = gid * WGM, gsz = (nM - fm) < WGM ? (nM - fm) : WGM;
        const int pm_f = fm + ((wgid % nig) % gsz), pn_f = (wgid % nig) / gsz;
        const int tl = s / nsplit, ks = s - tl * nsplit;
        u.pm = sub ? 64 + (tl >> 2) : pm_f; u.pn = sub ? (tl & 3) : pn_f; u.k0 = sub ? ks * 4 : 0; u.nt = sub ? 4 : ntf; u.split = sub ? 1 : 0;
        return true;
    }
};

template <class Epi, int AMODE, bool SPLIT = false>
__device__ __forceinline__ void gemm_phase(LAS unsigned char* lds, const bf16_t* Abase, const bf16_t* Btbase, const int K, const StaticOrder& S, const Epi& E) {
    int tid = threadIdx.x; asm volatile("" : "+v"(tid));
    const int wid = __builtin_amdgcn_readfirstlane(tid >> 6), lane = tid & 63, wr = wid >> 2, wc = wid & 3, fr = lane & 15, fq = lane >> 4;
    unsigned voffA[2], voffB[2];
#pragma unroll
    for (int i = 0; i < 2; ++i) { int R, C; stage_rc(tid * 16 + i * 8192, R, C); const int Rb = Epi::PERM ? ((R & ~31) + perm32(R & 31)) : R;
        const int Ra = AMODE ? (R < 64 ? R : R - 2) : R;
        voffA[i] = (unsigned)(Ra * K + C) * 2u; voffB[i] = (unsigned)(Rb * K + C) * 2u; }
    const size_t kstep = (size_t)(BK * 2);
    const size_t hstepB = (size_t)HALF * K * 2, tstepB = 2 * hstepB;
    const size_t hstepA = (size_t)(AMODE ? 124 : 128) * K * 2, tstepA = 2 * hstepA;
    const unsigned ldsw = (unsigned)wid * 1024u;
    const int aoff = lds_byte(wr * 64 + fr, fq * 8), boff = lds_byte(wc * 32 + fr, fq * 8);
#define PG8_SA(b, h) (((b) * 2 + (h)) * HTB)
#define PG8_SB(b, h) ((4 + (b) * 2 + (h)) * HTB)
#define PG8_STAGE(bufoff, gbase, voff) do { _Pragma("unroll") for (int _i = 0; _i < 2; ++_i) \
        __builtin_amdgcn_global_load_lds((const unsigned*)((const char*)(gbase) + (voff)[_i]), (LAS unsigned*)(lds + (bufoff) + ldsw + _i * 8192), 16, 0, 0); } while (0)
#define PG8_LDA(dst, b, h) do { _Pragma("unroll") for (int m = 0; m < 4; ++m) _Pragma("unroll") for (int k = 0; k < 2; ++k) dst[m][k] = *(const LAS bf16x8*)(lds + PG8_SA(b, h) + aoff + m * 2048 + k * 1024); } while (0)
#define PG8_LDB(dst, b, h) do { _Pragma("unroll") for (int n = 0; n < 2; ++n) _Pragma("unroll") for (int k = 0; k < 2; ++k) dst[n][k] = *(const LAS bf16x8*)(lds + PG8_SB(b, h) + boff + n * 2048 + k * 1024); } while (0)
#define PG8_MMA(ai, bj, At, Bt) do { __builtin_amdgcn_s_setprio(1); _Pragma("unroll") for (int m = 0; m < 4; ++m) _Pragma("unroll") for (int n = 0; n < 2; ++n) _Pragma("unroll") for (int k = 0; k < 2; ++k) \
        acc[ai][bj][m][n] = __builtin_amdgcn_mfma_f32_16x16x32_bf16(Bt[n][k], At[m][k], acc[ai][bj][m][n], 0, 0, 0); __builtin_amdgcn_s_setprio(0); } while (0)
#define PG8_WAIT_V(n) asm volatile("s_waitcnt vmcnt(" #n ")" ::: "memory")
#define PG8_WAIT_L(n) asm volatile("s_waitcnt lgkmcnt(" #n ")" ::: "memory")
#define PG8_BAR __builtin_amdgcn_s_barrier()
#define PG8_SCHED __builtin_amdgcn_sched_barrier(0)
    Unit cur, nxt; int ui = 0;
    if (!S.next(0, cur)) return;
    f32x4 acc[2][2][4][2];
#pragma unroll
    for (int a = 0; a < 2; ++a)
#pragma unroll
        for (int b = 0; b < 2; ++b)
#pragma unroll
            for (int m = 0; m < 4; ++m)
#pragma unroll
                for (int n = 0; n < 2; ++n) acc[a][b][m][n] = (f32x4){0.f, 0.f, 0.f, 0.f};
    bf16x8 At[4][2], B0[2][2], B1[2][2];
    const char* cA = (const char*)Abase + (size_t)cur.pm * tstepA + (SPLIT ? (size_t)cur.k0 * kstep : 0); const char* cB = (const char*)Btbase + (size_t)cur.pn * tstepB + (SPLIT ? (size_t)cur.k0 * kstep : 0);
    PG8_STAGE(PG8_SB(0, 0), cB, voffB); PG8_STAGE(PG8_SA(0, 0), cA, voffA); PG8_STAGE(PG8_SB(0, 1), cB + hstepB, voffB); PG8_STAGE(PG8_SA(0, 1), cA + hstepA, voffA);
    if (wr == 1) PG8_BAR;
    PG8_WAIT_V(4); PG8_BAR;
    PG8_STAGE(PG8_SB(1, 0), cB + kstep, voffB); PG8_STAGE(PG8_SA(1, 0), cA + kstep, voffA); PG8_STAGE(PG8_SB(1, 1), cB + hstepB + kstep, voffB);
    PG8_WAIT_V(6); PG8_BAR;
    for (;;) {
        const bool has_next = S.next(ui + 1, nxt);
        const char* nA = has_next ? (const char*)Abase + (size_t)nxt.pm * tstepA + (SPLIT ? (size_t)nxt.k0 * kstep : 0) : cA; const char* nB = has_next ? (const char*)Btbase + (size_t)nxt.pn * tstepB + (SPLIT ? (size_t)nxt.k0 * kstep : 0) : cB;
        const int nt = SPLIT ? cur.nt : K / BK;
        for (int t = 0; t < nt; t += 2) {
            const bool last = (t == nt - 2);
            const char* a1 = cA + (size_t)(t + 1) * kstep;
            const char* a2 = last ? nA : cA + (size_t)(t + 2) * kstep; const char* b2 = last ? nB : cB + (size_t)(t + 2) * kstep;
            const char* a3 = a2 + kstep; const char* b3 = b2 + kstep;
            PG8_LDB(B0, 0, 0); PG8_SCHED; PG8_LDA(At, 0, 0); PG8_STAGE(PG8_SA(1, 1), a1 + hstepA, voffA);
            PG8_WAIT_L(8); PG8_BAR; PG8_WAIT_L(0); PG8_MMA(0, 0, At, B0); PG8_BAR; PG8_SCHED;
            PG8_LDB(B1, 0, 1); PG8_STAGE(PG8_SB(0, 0), b2, voffB);
            PG8_BAR; PG8_WAIT_L(0); PG8_MMA(0, 1, At, B1); PG8_BAR;
            PG8_LDA(At, 0, 1); PG8_STAGE(PG8_SA(0, 0), a2, voffA);
            PG8_BAR; PG8_WAIT_L(0); PG8_MMA(1, 0, At, B0); PG8_BAR; PG8_SCHED;
            PG8_STAGE(PG8_SB(0, 1), b2 + hstepB, voffB);
            PG8_WAIT_V(6); PG8_BAR; PG8_MMA(1, 1, At, B1); PG8_BAR;
            PG8_LDB(B0, 1, 0); PG8_SCHED; PG8_LDA(At, 1, 0); PG8_STAGE(PG8_SA(0, 1), a2 + hstepA, voffA);
            PG8_WAIT_L(8); PG8_BAR; PG8_WAIT_L(0); PG8_MMA(0, 0, At, B0); PG8_BAR; PG8_SCHED;
            PG8_LDB(B1, 1, 1); PG8_STAGE(PG8_SB(1, 0), b3, voffB);
            PG8_BAR; PG8_WAIT_L(0); PG8_MMA(0, 1, At, B1); PG8_BAR;
            PG8_LDA(At, 1, 1); PG8_STAGE(PG8_SA(1, 0), a3, voffA);
            PG8_BAR; PG8_WAIT_L(0); PG8_MMA(1, 0, At, B0); PG8_BAR; PG8_SCHED;
            PG8_STAGE(PG8_SB(1, 1), b3 + hstepB, voffB);
            PG8_WAIT_V(6); PG8_BAR; PG8_MMA(1, 1, At, B1); PG8_BAR;
        }
        E(acc, cur, wr, wc, fr, fq);
        if (!has_next) break;
#pragma unroll
        for (int a = 0; a < 2; ++a)
#pragma unroll
            for (int b = 0; b < 2; ++b)
#pragma unroll
                for (int m = 0; m < 4; ++m)
#pragma unroll
                    for (int n = 0; n < 2; ++n) acc[a][b][m][n] = (f32x4){0.f, 0.f, 0.f, 0.f};
        cur = nxt; cA = nA; cB = nB; ++ui;
    }
    PG8_WAIT_V(0);
    if (wr == 0) PG8_BAR;
    PG8_BAR;
#undef PG8_SA
#undef PG8_SB
#undef PG8_STAGE
#undef PG8_LDA
#undef PG8_LDB
#undef PG8_MMA
#undef PG8_WAIT_V
#undef PG8_WAIT_L
#undef PG8_BAR
#undef PG8_SCHED
}

struct EpiBf16 {
    static constexpr bool PERM = true;
    bf16_t* O; int ldc;
    __device__ __forceinline__ void operator()(const f32x4 (&acc)[2][2][4][2], const Unit& u, int wr, int wc, int fr, int fq) const {
        const int row0 = u.pm * BM + wr * 64 + fr, col0 = u.pn * BM + wc * 32 + 8 * fq;
#pragma unroll
        for (int ai = 0; ai < 2; ++ai)
#pragma unroll
            for (int m = 0; m < 4; ++m) { bf16_t* rowp = O + (size_t)(row0 + ai * HALF + m * 16) * ldc + col0;
#pragma unroll
                for (int bj = 0; bj < 2; ++bj) { const f32x4 v0 = acc[ai][bj][m][0], v1 = acc[ai][bj][m][1];
                    u32x4 w; w.x = cvt_pk(v0[0], v0[1]); w.y = cvt_pk(v0[2], v0[3]); w.z = cvt_pk(v1[0], v1[1]); w.w = cvt_pk(v1[2], v1[3]);
                    *(u32x4*)(rowp + bj * HALF) = w; } }
    }
};
template <int MODE, bool SPLIT> struct EpiRes {
    static constexpr bool PERM = false;
    bf16_t* Y; Args a; bf16_t* PART;
    __device__ __forceinline__ void operator()(const f32x4 (&acc)[2][2][4][2], const Unit& u, int wr, int wc, int fr, int fq) const {
        const int row0 = u.pm * BM + wr * 64 + fr, col0 = u.pn * BM + wc * 32 + 4 * fq;
#pragma unroll
        for (int ai = 0; ai < 2; ++ai)
#pragma unroll
            for (int m = 0; m < 4; ++m) { const int row = row0 + ai * HALF + m * 16;
                if (row < T) { bf16_t* yp = Y + (size_t)row * DM + col0;
                    if (SPLIT && u.split) { bf16_t* pp = PART + ((size_t)(u.k0 >> 2) * 1152 + (row - 16384)) * DM + col0;
#pragma unroll
                        for (int bj = 0; bj < 2; ++bj)
#pragma unroll
                            for (int n = 0; n < 2; ++n) { const f32x4 v = acc[ai][bj][m][n]; u32x2 w; w.x = cvt_pk(v[0], v[1]); w.y = cvt_pk(v[2], v[3]); *(u32x2*)(pp + bj * HALF + n * 16) = w; }
                    } else if (MODE == 0) { const float* rp = xsrc_row(a, row) + col0;
#pragma unroll
                        for (int bj = 0; bj < 2; ++bj)
#pragma unroll
                            for (int n = 0; n < 2; ++n) { const f32x4 v = *(const f32x4*)(rp + bj * HALF + n * 16) * ALPHA + acc[ai][bj][m][n];
                                u32x2 w; w.x = cvt_pk(v[0], v[1]); w.y = cvt_pk(v[2], v[3]); *(u32x2*)(yp + bj * HALF + n * 16) = w; }
                    } else {
#pragma unroll
                        for (int bj = 0; bj < 2; ++bj)
#pragma unroll
                            for (int n = 0; n < 2; ++n) { const u32x2 r = *(const u32x2*)(yp + bj * HALF + n * 16);
                                const f32x4 v = (f32x4){bflo(r.x), bfhi(r.x), bflo(r.y), bfhi(r.y)} * ALPHA + acc[ai][bj][m][n];
                                u32x2 w; w.x = cvt_pk(v[0], v[1]); w.y = cvt_pk(v[2], v[3]); *(u32x2*)(yp + bj * HALF + n * 16) = w; }
                    } } }
    }
};
struct EpiFFN {
    static constexpr bool PERM = true;
    bf16_t* H; const float* cw; const float* cbias; const float* sbuf; float* out_p; float* out_s;
    __device__ __forceinline__ void operator()(const f32x4 (&acc)[2][2][4][2], const Unit& u, int wr, int wc, int fr, int fq) const {
        const int colb = u.pn * 128 + wc * 32 + 8 * fq;
        f32x4 w0[2], w1[2], w2[2], cbv[2];
#pragma unroll
        for (int n = 0; n < 2; ++n) { w0[n] = *(const f32x4*)(cw + colb + 4 * n); w1[n] = *(const f32x4*)(cw + DFF + colb + 4 * n); w2[n] = *(const f32x4*)(cw + 2 * DFF + colb + 4 * n); cbv[n] = *(const f32x4*)(cbias + colb + 4 * n); }
#pragma unroll
        for (int ai = 0; ai < 2; ++ai) {
            const int base = u.pm * 248 + ai * 124 + wr * 62 - 2;
#pragma unroll
            for (int m = 0; m < 4; ++m) {
                const int rb = 16 * m + fr, gr = base + rb;
                f32x4 cur[2], p1[2], p2[2];
#pragma unroll
                for (int n = 0; n < 2; ++n) { cur[n] = acc[ai][0][m][n];
#pragma unroll
                    for (int j = 0; j < 4; ++j) {
                        float b1 = 0.f, b2 = 0.f;
                        if (m > 0) { b1 = ror1(acc[ai][0][m > 0 ? m - 1 : 0][n][j]); b2 = ror2(acc[ai][0][m > 0 ? m - 1 : 0][n][j]); }
                        p1[n][j] = __int_as_float(__builtin_amdgcn_update_dpp(__float_as_int(b1), __float_as_int(cur[n][j]), 0x111, 0xf, 0xf, false));
                        p2[n][j] = __int_as_float(__builtin_amdgcn_update_dpp(__float_as_int(b2), __float_as_int(cur[n][j]), 0x112, 0xf, 0xf, false)); } }
                if (rb >= 2 && gr < T) {
                    const bool smp = gr >= TP; int b, t;
                    if (!smp) { b = gr / LP; t = gr - b * LP; } else { b = (gr - TP) >> 3; t = (gr - TP) & 7; }
                    if (t < 2) {
#pragma unroll
                        for (int n = 0; n < 2; ++n) { f32x4 q0 = (f32x4){0.f, 0.f, 0.f, 0.f}, q1 = q0;
                            if (smp) { q0 = *(const f32x4*)(sbuf + ((size_t)b * 2 + 0) * DFF + colb + 4 * n); q1 = *(const f32x4*)(sbuf + ((size_t)b * 2 + 1) * DFF + colb + 4 * n); }
                            if (t == 0) { p2[n] = q0; p1[n] = q1; } else { p2[n] = q1; } }
                    }
                    f32x4 hv[2];
#pragma unroll
                    for (int n = 0; n < 2; ++n) { const f32x4 y = cbv[n] + w0[n] * p2[n] + w1[n] * p1[n] + w2[n] * cur[n]; const f32x4 v = acc[ai][1][m][n];
#pragma unroll
                        for (int j = 0; j < 4; ++j) hv[n][j] = gelu_tanh(y[j]) * v[j]; }
                    u32x4 w; w.x = cvt_pk(hv[0][0], hv[0][1]); w.y = cvt_pk(hv[0][2], hv[0][3]); w.z = cvt_pk(hv[1][0], hv[1][1]); w.w = cvt_pk(hv[1][2], hv[1][3]);
                    *(u32x4*)(H + (size_t)gr * DFF + colb) = w;
                    const int L = smp ? 8 : LP;
                    if (t >= L - 2) { float* o = (smp ? out_s : out_p) + ((size_t)b * 2 + (t - (L - 2))) * DFF + colb; *(f32x4*)o = cur[0]; *(f32x4*)(o + 4) = cur[1]; }
                }
            }
        }
    }
};
}

__device__ __forceinline__ void p0_transpose_item(const float* W, int K, int N, bf16_t* WT, bool upmap, LAS float* scr, int item, int lane) {
    const int nblk = N / 32, kb = item / nblk, nb = item % nblk, k0 = 64 * kb, n0 = 32 * nb;
#pragma unroll 8
    for (int i = 0; i < 32; ++i) { const int kk = 2 * i + (lane >> 5); scr[kk * 33 + (lane & 31)] = W[(size_t)(k0 + kk) * N + n0 + (lane & 31)]; }
    asm volatile("s_waitcnt lgkmcnt(0)" ::: "memory");
    int r0 = n0;
    if (upmap) { r0 = n0 < DFF ? (n0 / 128) * 256 + (n0 % 128) : ((n0 - DFF) / 128) * 256 + 128 + ((n0 - DFF) % 128); }
    const int c = lane & 7;
#pragma unroll
    for (int j = 0; j < 4; ++j) { const int n = (lane >> 3) + 8 * j; const LAS float* s = scr + (8 * c) * 33 + n;
        u32x4 o; o.x = cvt_pk(s[0 * 33], s[1 * 33]); o.y = cvt_pk(s[2 * 33], s[3 * 33]); o.z = cvt_pk(s[4 * 33], s[5 * 33]); o.w = cvt_pk(s[6 * 33], s[7 * 33]);
        *(u32x4*)(WT + (size_t)(r0 + n) * K + k0 + 8 * c) = o; }
    asm volatile("s_waitcnt lgkmcnt(0)" ::: "memory");
}

__device__ __forceinline__ void phase_p0(const Args& a, LAS unsigned char* lds, int gw, int NGW, int wave, int lane) {
    unsigned char* ws = a.ws;
    LAS float* scr = (LAS float*)(lds + wave * 16384);
    constexpr int I0 = 16 * 128, I1 = 16 * 32, I2 = 16 * 64, I3 = 16 * 8, I4 = 16 * 32, I5 = 2 * 16 * 176, I6 = 2 * 44 * 32;
    constexpr int NITEMS = I0 + I1 + I2 + I3 + I4 + I5 + I6;
    for (int it = gw; it < NITEMS; it += NGW) {
        int r = it;
        if (r < I0) { p0_transpose_item(a.in[8], 1024, 4096, (bf16_t*)(ws + OFF_W_INAB), false, scr, r, lane); continue; } r -= I0;
        if (r < I1) { p0_transpose_item(a.in[9], 1024, 1024, (bf16_t*)(ws + OFF_W_OUTAB), false, scr, r, lane); continue; } r -= I1;
        if (r < I2) { p0_transpose_item(a.in[12], 1024, 2048, (bf16_t*)(ws + OFF_W_INC), false, scr, r, lane); continue; } r -= I2;
        if (r < I3) { const int mat = r >> 3, sub = r & 7, n = mat >> 1, gate = mat & 1;
            p0_transpose_item(a.in[gate ? 17 : 15] + (size_t)n * 16384, 128, 128, (bf16_t*)(ws + OFF_WG) + (size_t)(n * 2 + gate) * 16384, false, scr, sub, lane); continue; } r -= I3;
        if (r < I4) { p0_transpose_item(a.in[20], 1024, 1024, (bf16_t*)(ws + OFF_W_OUTC), false, scr, r, lane); continue; } r -= I4;
        if (r < I5) { const int l = r / (16 * 176), sub = r % (16 * 176);
            p0_transpose_item(a.in[25] + (size_t)l * 1024 * 5632, 1024, 5632, (bf16_t*)(ws + (l ? OFF_W_UP1 : OFF_W_UP0)), true, scr, sub, lane); continue; } r -= I5;
        { const int l = r / (44 * 32), sub = r % (44 * 32);
            p0_transpose_item(a.in[28] + (size_t)l * 2816 * 1024, 2816, 1024, (bf16_t*)(ws + (l ? OFF_W_DN1 : OFF_W_DN0)), false, scr, sub, lane); }
    }
    bf16_t* XB = (bf16_t*)(ws + OFF_XB);
    for (int row0 = gw; row0 < T; row0 += 4 * NGW) {
        f32x4 v[4][4];
#pragma unroll
        for (int q = 0; q < 4; ++q) { const int row = row0 + q * NGW; if (row < T) { const f32x4* xr = (const f32x4*)xsrc_row(a, row) + lane;
#pragma unroll
            for (int j = 0; j < 4; ++j) v[q][j] = xr[64 * j]; } }
#pragma unroll
        for (int q = 0; q < 4; ++q) { const int row = row0 + q * NGW; if (row < T) { u32x2* o = (u32x2*)(XB + (size_t)row * DM) + lane;
#pragma unroll
            for (int j = 0; j < 4; ++j) { u32x2 w; w.x = cvt_pk(v[q][j][0], v[q][j][1]); w.y = cvt_pk(v[q][j][2], v[q][j][3]); o[64 * j] = w; } } }
    }
    const int gt = gw * 64 + lane, NGT = NGW * 64;
    float* ROPE = (float*)(ws + OFF_ROPE);
    for (int e = gt; e < 2072 * 64; e += NGT) {
        const int pi = e >> 6, i = e & 63; const int pos = pi < 2064 ? pi : 16384 + (pi - 2064);
        const float inv = (float)exp(-(double)i * (9.210340371976184 / 64.0));
        const float ang = (float)pos * inv;
        double rev = (double)ang * 0.15915494309189535; rev -= rint(rev);
        const float r = (float)(rev * 6.283185307179586);
        ROPE[2 * e] = cosf(r); ROPE[2 * e + 1] = sinf(r);
    }
    if (gt < 512) { const float* lg = a.in[10]; const float l0 = lg[gt], l1 = lg[512 + gt], l2 = lg[1024 + gt]; const float mx = fmaxf(l0, fmaxf(l1, l2));
        const float e0 = expf(l0 - mx), e1 = expf(l1 - mx), e2 = expf(l2 - mx); ((float*)(ws + OFF_LBV))[gt] = e0 / (e0 + e1 + e2); }
    if (gt < 1024) { const float lam = a.in[19][gt]; ((float*)(ws + OFF_C8))[gt] = -8.f * (lam > 0.f ? log1pf(expf(-lam)) : (log1pf(expf(lam)) - lam)); }
}

__device__ __forceinline__ void sub_geom(int s, int& row0, int& ntok, int& pidx0) {
    if (s < NS_P) { const int b = s / NSUBP, j = s - b * NSUBP; row0 = b * LP + 16 * j; ntok = 16; pidx0 = 16 * j; }
    else { const int b = s - NS_P; row0 = TP + 8 * b; ntok = 8; pidx0 = 2064; }
}

__device__ __forceinline__ void phase_T(const Args& a, int gw, int NGW, int lane) {
    unsigned char* ws = a.ws;
    bf16_t* PROJ = (bf16_t*)(ws + OFF_BIG); bf16_t* KTT = (bf16_t*)(ws + OFF_XB); float* G = (float*)(ws + OFF_G);
    const float* ROPE = (const float*)(ws + OFF_ROPE); const float* LBV = (const float*)(ws + OFF_LBV);
    const int c2 = lane & 31, th = lane >> 5, ca = 2 * c2, cb = ca + 64;
    for (int it = gw; it < NS * 8; it += NGW) {
        const int s = it >> 3, h = it & 7; int row0, ntok, pidx0; sub_geom(s, row0, ntok, pidx0);
        const bool ret = h < 4; const int hh = h & 3;
        const int qc = (ret ? 0 : 2048) + 128 * hh, kc = (ret ? 512 : 2560) + 128 * hh, vc = (ret ? 1024 : 3072) + 128 * hh;
        const bool act = 8 * th < ntok;
        unsigned qa[8], qb[8], ka[8], kb[8], va[8], vb[8];
#pragma unroll
        for (int ii = 0; ii < 8; ++ii) { qa[ii] = qb[ii] = ka[ii] = kb[ii] = va[ii] = vb[ii] = 0u;
            if (act) { const bf16_t* p = PROJ + (size_t)(row0 + 8 * th + ii) * 4096;
                qa[ii] = *(const unsigned*)(p + qc + ca); qb[ii] = *(const unsigned*)(p + qc + cb);
                ka[ii] = *(const unsigned*)(p + kc + ca); kb[ii] = *(const unsigned*)(p + kc + cb);
                va[ii] = *(const unsigned*)(p + vc + ca); vb[ii] = *(const unsigned*)(p + vc + cb); } }
        unsigned kta[8], ktb[8];
        float g0, g1, g2, g3;
        if (ret) {
            const float lf = log1pf(-exp2f(-5.f - (float)hh));
            g0 = g1 = g2 = g3 = __expf(lf * (float)ntok);
#pragma unroll
            for (int ii = 0; ii < 8; ++ii) {
                kta[ii] = 0u; ktb[ii] = 0u;
                if (act) {
                    const int i = 8 * th + ii; const f32x4 cs = *(const f32x4*)(ROPE + ((size_t)(pidx0 + i) * 64 + ca) * 2);
                    const float eq = __expf(lf * (float)(i + 1)), ek = __expf(-lf * (float)(i + 1)) * 0.08838834764831845f;
                    const float q1l = bflo(qa[ii]), q1h = bfhi(qa[ii]), q2l = bflo(qb[ii]), q2h = bfhi(qb[ii]);
                    const float k1l = bflo(ka[ii]), k1h = bfhi(ka[ii]), k2l = bflo(kb[ii]), k2h = bfhi(kb[ii]);
                    const unsigned qoa = cvt_pk((q1l * cs[0] - q2l * cs[1]) * eq, (q1h * cs[2] - q2h * cs[3]) * eq);
                    const unsigned qob = cvt_pk((q1l * cs[1] + q2l * cs[0]) * eq, (q1h * cs[3] + q2h * cs[2]) * eq);
                    kta[ii] = cvt_pk((k1l * cs[0] - k2l * cs[1]) * ek, (k1h * cs[2] - k2h * cs[3]) * ek);
                    ktb[ii] = cvt_pk((k1l * cs[1] + k2l * cs[0]) * ek, (k1h * cs[3] + k2h * cs[2]) * ek);
                    bf16_t* p = PROJ + (size_t)(row0 + i) * 4096;
                    *(unsigned*)(p + qc + ca) = qoa; *(unsigned*)(p + qc + cb) = qob; *(unsigned*)(p + kc + ca) = kta[ii]; *(unsigned*)(p + kc + cb) = ktb[ii];
                }
            }
        } else {
            const f32x2 lba = *(const f32x2*)(LBV + 128 * hh + ca), lbb = *(const f32x2*)(LBV + 128 * hh + cb);
            float lfv[8][4], kv[8][4]; float t0 = 0.f, t1 = 0.f, t2 = 0.f, t3 = 0.f;
#pragma unroll
            for (int ii = 0; ii < 8; ++ii) {
                const float f0 = lba.x + (1.f - lba.x) * sigmoidf_(bflo(ka[ii])), f1 = lba.y + (1.f - lba.y) * sigmoidf_(bfhi(ka[ii]));
                const float f2 = lbb.x + (1.f - lbb.x) * sigmoidf_(bflo(kb[ii])), f3 = lbb.y + (1.f - lbb.y) * sigmoidf_(bfhi(kb[ii]));
                lfv[ii][0] = act ? __logf(f0) : 0.f; lfv[ii][1] = act ? __logf(f1) : 0.f; lfv[ii][2] = act ? __logf(f2) : 0.f; lfv[ii][3] = act ? __logf(f3) : 0.f;
                kv[ii][0] = 1.f - f0; kv[ii][1] = 1.f - f1; kv[ii][2] = 1.f - f2; kv[ii][3] = 1.f - f3;
                t0 += lfv[ii][0]; t1 += lfv[ii][1]; t2 += lfv[ii][2]; t3 += lfv[ii][3];
            }
            const float o0 = __shfl_xor(t0, 32), o1 = __shfl_xor(t1, 32), o2 = __shfl_xor(t2, 32), o3 = __shfl_xor(t3, 32);
            float r0 = th ? o0 : 0.f, r1 = th ? o1 : 0.f, r2 = th ? o2 : 0.f, r3 = th ? o3 : 0.f;
            g0 = __expf(t0 + o0); g1 = __expf(t1 + o1); g2 = __expf(t2 + o2); g3 = __expf(t3 + o3);
#pragma unroll
            for (int ii = 0; ii < 8; ++ii) {
                kta[ii] = 0u; ktb[ii] = 0u;
                r0 += lfv[ii][0]; r1 += lfv[ii][1]; r2 += lfv[ii][2]; r3 += lfv[ii][3];
                if (act) {
                    const float e0 = __expf(r0), e1 = __expf(r1), e2 = __expf(r2), e3 = __expf(r3);
                    const unsigned qoa = cvt_pk(bflo(qa[ii]) * e0, bfhi(qa[ii]) * e1), qob = cvt_pk(bflo(qb[ii]) * e2, bfhi(qb[ii]) * e3);
                    kta[ii] = cvt_pk(kv[ii][0] * __builtin_amdgcn_rcpf(e0), kv[ii][1] * __builtin_amdgcn_rcpf(e1));
                    ktb[ii] = cvt_pk(kv[ii][2] * __builtin_amdgcn_rcpf(e2), kv[ii][3] * __builtin_amdgcn_rcpf(e3));
                    bf16_t* p = PROJ + (size_t)(row0 + 8 * th + ii) * 4096;
                    *(unsigned*)(p + qc + ca) = qoa; *(unsigned*)(p + qc + cb) = qob; *(unsigned*)(p + kc + ca) = kta[ii]; *(unsigned*)(p + kc + cb) = ktb[ii];
                }
            }
        }
        u32x4 kA0, kA1, kB0, kB1, vA0, vA1, vB0, vB1;
#pragma unroll
        for (int w = 0; w < 4; ++w) {
            kA0[w] = (kta[2 * w] & 0xffffu) | (kta[2 * w + 1] << 16); kA1[w] = (kta[2 * w] >> 16) | (kta[2 * w + 1] & 0xffff0000u);
            kB0[w] = (ktb[2 * w] & 0xffffu) | (ktb[2 * w + 1] << 16); kB1[w] = (ktb[2 * w] >> 16) | (ktb[2 * w + 1] & 0xffff0000u);
            vA0[w] = (va[2 * w] & 0xffffu) | (va[2 * w + 1] << 16); vA1[w] = (va[2 * w] >> 16) | (va[2 * w + 1] & 0xffff0000u);
            vB0[w] = (vb[2 * w] & 0xffffu) | (vb[2 * w + 1] << 16); vB1[w] = (vb[2 * w] >> 16) | (vb[2 * w + 1] & 0xffff0000u);
        }
        bf16_t* kt = KTT + (size_t)(s * 8 + h) * 2048 + 8 * th;
        *(u32x4*)(kt + ca * 16) = kA0; *(u32x4*)(kt + (ca + 1) * 16) = kA1; *(u32x4*)(kt + cb * 16) = kB0; *(u32x4*)(kt + (cb + 1) * 16) = kB1;
        if (act) {
            int lin;
            lin = ca * ntok + 8 * th;       *(u32x4*)(PROJ + (size_t)(row0 + (lin >> 7)) * 4096 + vc + (lin & 127)) = vA0;
            lin = (ca + 1) * ntok + 8 * th; *(u32x4*)(PROJ + (size_t)(row0 + (lin >> 7)) * 4096 + vc + (lin & 127)) = vA1;
            lin = cb * ntok + 8 * th;       *(u32x4*)(PROJ + (size_t)(row0 + (lin >> 7)) * 4096 + vc + (lin & 127)) = vB0;
            lin = (cb + 1) * ntok + 8 * th; *(u32x4*)(PROJ + (size_t)(row0 + (lin >> 7)) * 4096 + vc + (lin & 127)) = vB1;
        }
        if (th == 0) { float* gp = G + (size_t)(s * 8 + h) * 128; *(f32x2*)(gp + ca) = (f32x2){g0, g1}; *(f32x2*)(gp + cb) = (f32x2){g2, g3}; }
    }
}

struct GlaOff { int v[2]; int kq; int ost[2][4]; int kt[8]; int g; int qc, kc; };
template <int NTOK>
__device__ __forceinline__ void gla_offsets(GlaOff& o, int h, int sl, int lane) {
    const int c = lane & 15, q4 = lane >> 4; const bool ret = h < 4; const int hh = h & 3;
    o.qc = (ret ? 0 : 2048) + 128 * hh; o.kc = (ret ? 512 : 2560) + 128 * hh; const int vc = (ret ? 1024 : 3072) + 128 * hh;
#pragma unroll
    for (int n = 0; n < 2; ++n) { const int lin = (32 * sl + 16 * n + c) * NTOK + 4 * q4; o.v[n] = (lin >> 7) * 4096 + vc + (lin & 127);
#pragma unroll
        for (int r = 0; r < 4; ++r) { const int l2 = 32 * sl * NTOK + (4 * q4 + r) * 32 + 16 * n + c; o.ost[n][r] = (l2 >> 7) * 4096 + vc + (l2 & 127); } }
    o.kq = c * 4096 + 8 * q4;
#pragma unroll
    for (int t = 0; t < 8; ++t) o.kt[t] = (32 * (t >> 1) + 8 * (c >> 2) + 4 * (t & 1) + (c & 3)) * 16 + 4 * q4;
    o.g = 8 * q4;
}
template <int NTOK>
__device__ __forceinline__ void gla_load_qkv(const bf16_t* pr, const GlaOff& o, int lane, bf16x4 (&vf)[2], bf16x8 (&kf)[4], bf16x8 (&qf)[4]) {
    const int c = lane & 15, q4 = lane >> 4;
#pragma unroll
    for (int n = 0; n < 2; ++n) { vf[n] = (bf16x4){0, 0, 0, 0}; if (NTOK == 16 || 4 * q4 < NTOK) vf[n] = *(const bf16x4*)(pr + o.v[n]); }
#pragma unroll
    for (int kk = 0; kk < 4; ++kk) { kf[kk] = (bf16x8){0, 0, 0, 0, 0, 0, 0, 0}; qf[kk] = kf[kk];
        if (NTOK == 16 || c < NTOK) { kf[kk] = *(const bf16x8*)(pr + o.kq + o.kc + 32 * kk); qf[kk] = *(const bf16x8*)(pr + o.kq + o.qc + 32 * kk); } }
}
template <int NTOK>
__device__ __forceinline__ void gla_step_state(const bf16_t* pr, const bf16_t* kt, const float* g, const GlaOff& o, int lane, f32x4 (&S)[8][2], f32x4 (&P)[8]) {
    const int q4 = lane >> 4;
    bf16x4 vf[2], kaf[8]; f32x4 gvf[8];
#pragma unroll
    for (int n = 0; n < 2; ++n) { vf[n] = (bf16x4){0, 0, 0, 0}; if (NTOK == 16 || 4 * q4 < NTOK) vf[n] = *(const bf16x4*)(pr + o.v[n]); }
#pragma unroll
    for (int t = 0; t < 8; ++t) { kaf[t] = *(const bf16x4*)(kt + o.kt[t]); gvf[t] = *(const f32x4*)(g + o.g + 32 * (t >> 1) + 4 * (t & 1)); }
#pragma unroll
    for (int t = 0; t < 8; ++t)
#pragma unroll
        for (int n = 0; n < 2; ++n) S[t][n] = mfma16(kaf[t], vf[n], S[t][n]);
#pragma unroll
    for (int t = 0; t < 8; ++t) { S[t][0] = S[t][0] * gvf[t]; S[t][1] = S[t][1] * gvf[t]; P[t] = P[t] * gvf[t]; }
}
template <int NTOK>
__device__ __forceinline__ void gla_step_emit(bf16_t* pr, const bf16_t* kt, const float* g, const GlaOff& o, int lane, f32x4 (&S)[8][2], bf16x4 (&vf)[2], bf16x8 (&kf)[4], bf16x8 (&qf)[4], const bf16_t* prn) {
    const int c = lane & 15, q4 = lane >> 4;
    bf16x4 kaf[8]; f32x4 gvf[8];
#pragma unroll
    for (int t = 0; t < 8; ++t) kaf[t] = *(const bf16x4*)(kt + o.kt[t]);
    f32x4 at = (f32x4){0.f, 0.f, 0.f, 0.f};
#pragma unroll
    for (int kk = 0; kk < 4; ++kk) at = mfma32(kf[kk], qf[kk], at);
#pragma unroll
    for (int r = 0; r < 4; ++r) if (4 * q4 + r > c) at[r] = 0.f;
    const bf16x4 pf = pack4(at);
    f32x4 ov[2];
#pragma unroll
    for (int n = 0; n < 2; ++n) { ov[n] = mfma16(pf, vf[n], (f32x4){0.f, 0.f, 0.f, 0.f});
#pragma unroll
        for (int kk = 0; kk < 4; ++kk) ov[n] = mfma32(qf[kk], pack8(S[2 * kk][n], S[2 * kk + 1][n]), ov[n]); }
#pragma unroll
    for (int t = 0; t < 8; ++t) gvf[t] = *(const f32x4*)(g + o.g + 32 * (t >> 1) + 4 * (t & 1));
#pragma unroll
    for (int n = 0; n < 2; ++n)
#pragma unroll
        for (int r = 0; r < 4; ++r) if (NTOK == 16 || 4 * q4 + r < NTOK) pr[o.ost[n][r]] = (bf16_t)(cvt_pk(ov[n][r], 0.f) & 0xffffu);
    bf16x4 vfc[2] = {vf[0], vf[1]};
    if (prn) gla_load_qkv<NTOK>(prn, o, lane, vf, kf, qf);
#pragma unroll
    for (int t = 0; t < 8; ++t)
#pragma unroll
        for (int n = 0; n < 2; ++n) S[t][n] = mfma16(kaf[t], vfc[n], S[t][n]);
#pragma unroll
    for (int t = 0; t < 8; ++t) { S[t][0] = S[t][0] * gvf[t]; S[t][1] = S[t][1] * gvf[t]; }
}
__device__ __forceinline__ void state_load(const float* p, int sl, f32x4 (&S)[8][2], int lane) {
    const int c = lane & 15, q4 = lane >> 4;
#pragma unroll
    for (int t = 0; t < 8; ++t)
#pragma unroll
        for (int n = 0; n < 2; ++n)
#pragma unroll
            for (int r = 0; r < 4; ++r) S[t][n][r] = p[(32 * (t >> 1) + 8 * q4 + 4 * (t & 1) + r) * 128 + 32 * sl + 16 * n + c];
}
__device__ __forceinline__ void state_store(float* p, int sl, const f32x4 (&S)[8][2], int lane) {
    const int c = lane & 15, q4 = lane >> 4;
#pragma unroll
    for (int t = 0; t < 8; ++t)
#pragma unroll
        for (int n = 0; n < 2; ++n)
#pragma unroll
            for (int r = 0; r < 4; ++r) p[(32 * (t >> 1) + 8 * q4 + 4 * (t & 1) + r) * 128 + 32 * sl + 16 * n + c] = S[t][n][r];
}
__device__ __forceinline__ void phase_A(const Args& a, int gw, int NGW, int lane) {
    unsigned char* ws = a.ws; const bf16_t* PROJ = (const bf16_t*)(ws + OFF_BIG); const bf16_t* KTT = (const bf16_t*)(ws + OFF_XB); const float* G = (const float*)(ws + OFF_G); float* U = (float*)(ws + OFF_U);
    float* GSP = (float*)(ws + OFF_GS);
    for (int it = gw; it < 64 * 8 * 4; it += NGW) {
        const int sl = it & 3, g = it >> 2, k = g & 7, bh = g >> 3, b = bh >> 3, h = bh & 7;
        const int j0 = k == 0 ? 0 : 16 * (k - 1) + 1, s0 = b * NSUBP + j0, ns = k == 0 ? 1 : 16;
        GlaOff o; gla_offsets<16>(o, h, sl, lane);
        const bf16_t* pr = PROJ + (size_t)(b * LP + 16 * j0) * 4096; const bf16_t* kt = KTT + (size_t)(s0 * 8 + h) * 2048; const float* gp = G + (size_t)(s0 * 8 + h) * 128;
        f32x4 S[8][2], P[8];
#pragma unroll
        for (int t = 0; t < 8; ++t) { S[t][0] = (f32x4){0.f, 0.f, 0.f, 0.f}; S[t][1] = S[t][0]; P[t] = (f32x4){1.f, 1.f, 1.f, 1.f}; }
        for (int j = 0; j < ns; ++j) { gla_step_state<16>(pr, kt, gp, o, lane, S, P); pr += 16 * 4096; kt += 8 * 2048; gp += 8 * 128; }
        state_store(U + (size_t)(bh * 8 + k) * 16384, sl, S, lane);
        if (sl == 0 && (lane & 15) == 0) { const int q4 = lane >> 4;
#pragma unroll
            for (int t = 0; t < 8; ++t) *(f32x4*)(GSP + (size_t)(bh * 8 + k) * 128 + 32 * (t >> 1) + 8 * q4 + 4 * (t & 1)) = P[t]; }
    }
}
__device__ __forceinline__ void phase_B(const Args& a, int gt, int NGT) {
    unsigned char* ws = a.ws; const float* GSP = (const float*)(ws + OFF_GS); float* U = (float*)(ws + OFF_U);
    for (int idx = gt; idx < 64 * 16384; idx += NGT) {
        const int bh = idx >> 14, e = idx & 16383, dk = e >> 7;
        float uv[8], gv[8];
#pragma unroll
        for (int k = 0; k < 8; ++k) { uv[k] = U[(size_t)(bh * 8 + k) * 16384 + e]; gv[k] = GSP[(size_t)(bh * 8 + k) * 128 + dk]; }
        float Sv = 0.f;
#pragma unroll
        for (int k = 0; k < 8; ++k) { Sv = gv[k] * Sv + uv[k]; U[(size_t)(bh * 8 + k) * 16384 + e] = Sv; }
    }
}
__device__ __forceinline__ void phase_C(const Args& a, int gw, int NGW, int lane) {
    unsigned char* ws = a.ws; bf16_t* PROJ = (bf16_t*)(ws + OFF_BIG); const bf16_t* KTT = (const bf16_t*)(ws + OFF_XB); const float* G = (const float*)(ws + OFF_G); const float* U = (const float*)(ws + OFF_U);
    const int nit = (2304 + 4096 - gw + NGW - 1) / NGW;
    for (int ii = 0; ii < nit; ++ii) {
        const int it = gw + ((gw & 1) ? (nit - 1 - ii) : ii) * NGW;
        const int sl = it & 3; f32x4 S[8][2]; bf16x4 vf[2]; bf16x8 kf[4], qf[4];
        if (it < 2304) {
            int bh, k; if (it < 2048) { const int g = it >> 2; bh = g >> 3; k = (g & 7) + 1; } else { bh = (it - 2048) >> 2; k = 0; }
            const int b = bh >> 3, h = bh & 7;
            if (k == 0) {
#pragma unroll
                for (int t = 0; t < 8; ++t) { S[t][0] = (f32x4){0.f, 0.f, 0.f, 0.f}; S[t][1] = S[t][0]; }
            } else state_load(U + (size_t)(bh * 8 + (k - 1)) * 16384, sl, S, lane);
            const int j0 = k == 0 ? 0 : 16 * (k - 1) + 1, s0 = b * NSUBP + j0, ns = k == 0 ? 1 : 16;
            GlaOff o; gla_offsets<16>(o, h, sl, lane);
            bf16_t* pr = PROJ + (size_t)(b * LP + 16 * j0) * 4096; const bf16_t* kt = KTT + (size_t)(s0 * 8 + h) * 2048; const float* gp = G + (size_t)(s0 * 8 + h) * 128;
            gla_load_qkv<16>(pr, o, lane, vf, kf, qf);
            for (int j = 0; j < ns; ++j) { gla_step_emit<16>(pr, kt, gp, o, lane, S, vf, kf, qf, j + 1 < ns ? pr + 16 * 4096 : nullptr); pr += 16 * 4096; kt += 8 * 2048; gp += 8 * 128; }
            if (k == 8) state_store(a.out + (h < 4 ? O_RETP : O_HGP) + (size_t)(b * 4 + (h & 3)) * 16384, sl, S, lane);
        } else {
            const int g = (it - 2304) >> 2, b = g >> 3, h = g & 7, s = NS_P + b;
            state_load(a.in[h < 4 ? 2 : 3] + (size_t)(b * 4 + (h & 3)) * 16384, sl, S, lane);
            GlaOff o; gla_offsets<8>(o, h, sl, lane);
            bf16_t* pr = PROJ + (size_t)(TP + 8 * b) * 4096;
            gla_load_qkv<8>(pr, o, lane, vf, kf, qf);
            gla_step_emit<8>(pr, KTT + (size_t)(s * 8 + h) * 2048, G + (size_t)(s * 8 + h) * 128, o, lane, S, vf, kf, qf, nullptr);
            state_store(a.out + (h < 4 ? O_RETS : O_HGS) + (size_t)(b * 4 + (h & 3)) * 16384, sl, S, lane);
        }
    }
}
__device__ __forceinline__ void phase_D(const Args& a, int gw, int NGW, int lane) {
    unsigned char* ws = a.ws; const bf16_t* PROJ = (const bf16_t*)(ws + OFF_BIG); bf16_t* MIX = (bf16_t*)(ws + OFF_XB); const float* nw = a.in[11];
    const int i = lane & 15, sl = lane >> 4;
    for (int it = gw; it < NS * 8; it += NGW) {
        const int s = it >> 3, h = it & 7; int row0, ntok, pidx0; sub_geom(s, row0, ntok, pidx0);
        const bool ret = h < 4; const int hh = h & 3;
        const int vc = (ret ? 1024 : 3072) + 128 * hh, gc = (ret ? 1536 : 3584) + 128 * hh + 32 * sl;
        const bool valid = i < ntok;
        float o[32];
        const int lin0 = 32 * sl * ntok + 32 * i;
        const bf16_t* op = PROJ + (size_t)(row0 + (lin0 >> 7)) * 4096 + vc + (lin0 & 127);
#pragma unroll
        for (int w = 0; w < 4; ++w) { u32x4 x = (u32x4){0u, 0u, 0u, 0u}; if (valid) x = *(const u32x4*)(op + 8 * w);
#pragma unroll
            for (int e = 0; e < 4; ++e) { o[8 * w + 2 * e] = bflo(x[e]); o[8 * w + 2 * e + 1] = bfhi(x[e]); } }
        u32x4 gx4[4];
#pragma unroll
        for (int w = 0; w < 4; ++w) { gx4[w] = (u32x4){0u, 0u, 0u, 0u}; if (valid) gx4[w] = *(const u32x4*)(PROJ + (size_t)(row0 + i) * 4096 + gc + 8 * w); }
        float sum = 0.f;
#pragma unroll
        for (int e = 0; e < 32; ++e) sum += o[e];
        sum += __shfl_xor(sum, 16); sum += __shfl_xor(sum, 32);
        const float mu = ret ? sum * (1.f / 128.f) : 0.f;
        float sq = 0.f;
#pragma unroll
        for (int e = 0; e < 32; ++e) { const float d = o[e] - mu; sq += d * d; }
        sq += __shfl_xor(sq, 16); sq += __shfl_xor(sq, 32);
        const float rstd = rsqrtf(sq * (1.f / 128.f) + LN_EPS);
        if (valid) {
            bf16_t* mp = MIX + (size_t)(row0 + i) * DM + 128 * h + 32 * sl;
#pragma unroll
            for (int w = 0; w < 4; ++w) { const u32x4 gx = gx4[w]; float r[8];
#pragma unroll
                for (int e = 0; e < 4; ++e) { const float g0 = bflo(gx[e]), g1 = bfhi(gx[e]);
                    float v0 = (o[8 * w + 2 * e] - mu) * rstd, v1 = (o[8 * w + 2 * e + 1] - mu) * rstd;
                    if (!ret) { v0 *= nw[32 * sl + 8 * w + 2 * e]; v1 *= nw[32 * sl + 8 * w + 2 * e + 1]; }
                    r[2 * e] = v0 * g0 * sigmoidf_(g0); r[2 * e + 1] = v1 * g1 * sigmoidf_(g1); }
                u32x4 ov; ov.x = cvt_pk(r[0], r[1]); ov.y = cvt_pk(r[2], r[3]); ov.z = cvt_pk(r[4], r[5]); ov.w = cvt_pk(r[6], r[7]);
                *(u32x4*)(mp + 8 * w) = ov; }
        }
    }
}

template <bool FINAL, bool FROMX0 = false>
__device__ __forceinline__ void phase_LN(const Args& a, const float* gam, const float* bet, const bf16_t* PART, int nsplit, int gw, int NGW, int lane) {
    unsigned char* ws = a.ws; bf16_t* XR = (bf16_t*)(ws + OFF_X32);
    f32x4 gv[4], bv[4];
#pragma unroll
    for (int j = 0; j < 4; ++j) { gv[j] = ((const f32x4*)gam)[lane + 64 * j]; bv[j] = ((const f32x4*)bet)[lane + 64 * j]; }
    for (int row0 = gw; row0 < T; row0 += 4 * NGW) {
        f32x4 v[4][4];
#pragma unroll
        for (int q = 0; q < 4; ++q) { const int row = row0 + q * NGW;
            if (row < T) { const u32x2* xr = (const u32x2*)(XR + (size_t)row * DM) + lane;
#pragma unroll
                for (int j = 0; j < 4; ++j) { const u32x2 w = xr[64 * j]; v[q][j] = (f32x4){bflo(w.x), bfhi(w.x), bflo(w.y), bfhi(w.y)}; }
                if (FROMX0 && row >= 16384) { const f32x4* x0 = (const f32x4*)xsrc_row(a, row) + lane;
#pragma unroll
                    for (int j = 0; j < 4; ++j) v[q][j] = x0[64 * j]; }
                if (row >= 16384 && nsplit > 0) {
#pragma unroll
                    for (int j = 0; j < 4; ++j) v[q][j] = v[q][j] * ALPHA;
                    for (int s = 0; s < nsplit; ++s) { const u32x2* pr = (const u32x2*)(PART + ((size_t)s * 1152 + (row - 16384)) * DM) + lane;
#pragma unroll
                        for (int j = 0; j < 4; ++j) { const u32x2 w = pr[64 * j]; v[q][j] += (f32x4){bflo(w.x), bfhi(w.x), bflo(w.y), bfhi(w.y)}; } } } } }
#pragma unroll
        for (int q = 0; q < 4; ++q) { const int row = row0 + q * NGW;
            if (row < T) {
                float s = 0.f;
#pragma unroll
                for (int j = 0; j < 4; ++j) s += (v[q][j][0] + v[q][j][1]) + (v[q][j][2] + v[q][j][3]);
                const float mean = wave_sum(s) * (1.f / DM); float s2 = 0.f;
#pragma unroll
                for (int j = 0; j < 4; ++j) { v[q][j] = v[q][j] - mean; s2 += (v[q][j][0] * v[q][j][0] + v[q][j][1] * v[q][j][1]) + (v[q][j][2] * v[q][j][2] + v[q][j][3] * v[q][j][3]); }
                const float rstd = rsqrtf(wave_sum(s2) * (1.f / DM) + LN_EPS);
#pragma unroll
                for (int j = 0; j < 4; ++j) v[q][j] = v[q][j] * rstd * gv[j] + bv[j];
                if (FINAL) {
                    float* op = nullptr;
                    if (row < TP) { const int b = row / LP, t = row - b * LP; if (t >= 16) op = a.out + O_YP + ((size_t)b * 2048 + (t - 16)) * DM; }
                    else op = a.out + O_YS + (size_t)(row - TP) * DM;
                    if (op) {
#pragma unroll
                        for (int j = 0; j < 4; ++j) ((f32x4*)op)[lane + 64 * j] = v[q][j]; }
                } else {
                    u32x2* ob = (u32x2*)(XR + (size_t)row * DM) + lane;
#pragma unroll
                    for (int j = 0; j < 4; ++j) { u32x2 w; w.x = cvt_pk(v[q][j][0], v[q][j][1]); w.y = cvt_pk(v[q][j][2], v[q][j][3]); ob[64 * j] = w; }
                }
            } }
    }
}

__device__ __forceinline__ void phase_F1(const Args& a, LAS unsigned char* lds, int wave, int lane) {
    unsigned char* ws = a.ws; const bf16_t* __restrict__ GR = (const bf16_t*)(ws + OFF_H); const bf16_t* __restrict__ WG = (const bf16_t*)(ws + OFF_WG);
    bf16_t* __restrict__ HL = (bf16_t*)(ws + OFF_HL); bf16_t* __restrict__ AC = (bf16_t*)(ws + OFF_XB); float* __restrict__ TA = (float*)(ws + OFF_TA); float* __restrict__ TH = (float*)(ws + OFF_TH);
    const float* C8 = (const float*)(ws + OFF_C8);
    const float* convw = a.in[13]; const float* convb = a.in[14]; const float* bga = a.in[16]; const float* bgx = a.in[18];
    const int c = lane & 15, q4 = lane >> 4;
    const int n = blockIdx.x & 7;
    { const u32x4* wsrc = (const u32x4*)(WG + (size_t)n * 2 * 16384);
      for (int e = threadIdx.x; e < 4096; e += 512) { const int r = e >> 4, cc = e & 15; *(LAS u32x4*)(lds + r * 272 + cc * 16) = wsrc[e]; } }
    LAS float* cst = (LAS float*)(lds + 69632);
    for (int e = threadIdx.x; e < 1024; e += 512) { const int k = e >> 7, ch = 128 * n + (e & 127);
        cst[e] = k == 0 ? bga[ch] : k == 1 ? bgx[ch] : k == 2 ? C8[ch] : k < 7 ? convw[(k - 3) * 1024 + ch] : convb[ch]; }
    __syncthreads();
    for (int tt = ((int)blockIdx.x >> 3) * 8 + wave; tt < NTILE; tt += (int)(gridDim.x >> 3) * 8) {
        int row, b, t, W; bool smp;
        if (tt < NT_P) { b = tt / NSUBP; const int j = tt - b * NSUBP; row = b * LP + 16 * j + c; t = 16 * j + c; W = 16; smp = false; }
        else { const int k = tt - NT_P; row = TP + 16 * k + c; b = 2 * k + (c >> 3); t = c & 7; W = 8; smp = true; }
        const int chb = 128 * n;
        bf16x8 bfr[4];
#pragma unroll
        for (int q = 0; q < 4; ++q) bfr[q] = (bf16x8){0, 0, 0, 0, 0, 0, 0, 0};
#pragma unroll 2
        for (int kk = 0; kk < 4; ++kk) {
            const int ch0 = chb + 32 * kk + 8 * q4;
            const int cl0 = 32 * kk + 8 * q4;
            f32x4 s0 = *(const LAS f32x4*)(cst + 7 * 128 + cl0), s1 = *(const LAS f32x4*)(cst + 7 * 128 + cl0 + 4);
#pragma unroll
            for (int d = 0; d < 4; ++d) {
                const f32x4 wa = *(const LAS f32x4*)(cst + (3 + 3 - d) * 128 + cl0), wb = *(const LAS f32x4*)(cst + (3 + 3 - d) * 128 + cl0 + 4);
                f32x4 xa = (f32x4){0.f, 0.f, 0.f, 0.f}, xb = xa;
                if (t - d >= 0) { const u32x4 x = *(const u32x4*)(GR + (size_t)(row - d) * 2048 + 1024 + ch0);
                    xa = (f32x4){bflo(x[0]), bfhi(x[0]), bflo(x[1]), bfhi(x[1])}; xb = (f32x4){bflo(x[2]), bfhi(x[2]), bflo(x[3]), bfhi(x[3])}; }
                else if (smp) { const float* sp = a.in[5] + ((size_t)b * 3 + (t - d + 3)) * 1024 + ch0; xa = *(const f32x4*)sp; xb = *(const f32x4*)(sp + 4); }
                s0 += wa * xa; s1 += wb * xb;
            }
            { const bf16x8 pv = pack8(s0, s1);
#pragma unroll
              for (int q = 0; q < 4; ++q) bfr[q] = (kk == q) ? pv : bfr[q]; }
        }
#pragma unroll 2
        for (int kk = 0; kk < 4; ++kk) {
            const int ch0 = chb + 32 * kk + 8 * q4;
            const int cl0 = 32 * kk + 8 * q4;
            const f32x4 ba0 = *(const LAS f32x4*)(cst + cl0), ba1 = *(const LAS f32x4*)(cst + cl0 + 4), bx0 = *(const LAS f32x4*)(cst + 128 + cl0), bx1 = *(const LAS f32x4*)(cst + 128 + cl0 + 4);
            const f32x4 c80 = *(const LAS f32x4*)(cst + 256 + cl0), c81 = *(const LAS f32x4*)(cst + 256 + cl0 + 4);
            f32x4 h00 = (f32x4){0.f, 0.f, 0.f, 0.f}, h01 = h00;
            if (smp && t == 0) { h00 = *(const f32x4*)(a.in[4] + (size_t)b * 1024 + ch0); h01 = *(const f32x4*)(a.in[4] + (size_t)b * 1024 + ch0 + 4); }
            f32x4 ra[2], ia[2];
#pragma unroll
            for (int hf = 0; hf < 2; ++hf) {
                const int oc = 32 * kk + 8 * (c >> 2) + 4 * hf + (c & 3);
                ra[hf] = (f32x4){0.f, 0.f, 0.f, 0.f}; ia[hf] = ra[hf];
#pragma unroll
                for (int k2 = 0; k2 < 4; ++k2) {
                    const bf16x8 wa = *(const LAS bf16x8*)(lds + (0 * 128 + oc) * 272 + (32 * k2 + 8 * q4) * 2);
                    const bf16x8 wx = *(const LAS bf16x8*)(lds + (1 * 128 + oc) * 272 + (32 * k2 + 8 * q4) * 2);
                    ra[hf] = mfma32(wa, bfr[k2], ra[hf]); ia[hf] = mfma32(wx, bfr[k2], ia[hf]);
                }
            }
            float Av[8], Bv[8], xcv[8];
            { const u32x4 x0 = __builtin_bit_cast(u32x4, bfr[0]), x1 = __builtin_bit_cast(u32x4, bfr[1]), x2 = __builtin_bit_cast(u32x4, bfr[2]), x3 = __builtin_bit_cast(u32x4, bfr[3]);
#pragma unroll
              for (int e = 0; e < 4; ++e) { const unsigned w = kk == 0 ? x0[e] : kk == 1 ? x1[e] : kk == 2 ? x2[e] : x3[e]; xcv[2 * e] = bflo(w); xcv[2 * e + 1] = bfhi(w); } }
#pragma unroll
            for (int jp = 0; jp < 8; ++jp) {
                const int hf = jp >> 2, r = jp & 3;
                const float rr = sigmoidf_(ra[hf][r] + (hf ? ba1[r] : ba0[r])), ii = sigmoidf_(ia[hf][r] + (hf ? bx1[r] : bx0[r]));
                const float la = rr * (hf ? c81[r] : c80[r]); const float av = __expf(la);
                float bv = __builtin_amdgcn_sqrtf(fmaxf(1.f - av * av, 0.f)) * (ii * xcv[jp]);
                bv += av * (hf ? h01[r] : h00[r]);
                Av[jp] = av; Bv[jp] = bv;
            }
#define F1_SCAN_STEP(D, CTRL) { const bool take = (c & (W - 1)) >= (D); \
                _Pragma("unroll") for (int jp = 0; jp < 8; ++jp) { \
                    const float ap = __int_as_float(__builtin_amdgcn_update_dpp(0, __float_as_int(Av[jp]), CTRL, 0xf, 0xf, false)); \
                    const float bp = __int_as_float(__builtin_amdgcn_update_dpp(0, __float_as_int(Bv[jp]), CTRL, 0xf, 0xf, false)); \
                    if (take) { Bv[jp] = Av[jp] * bp + Bv[jp]; Av[jp] = Av[jp] * ap; } } }
            F1_SCAN_STEP(1, 0x111) F1_SCAN_STEP(2, 0x112) F1_SCAN_STEP(4, 0x114)
            if (W == 16) F1_SCAN_STEP(8, 0x118)
#undef F1_SCAN_STEP
            u32x4 hw, aw;
#pragma unroll
            for (int e = 0; e < 4; ++e) { hw[e] = cvt_pk(Bv[2 * e], Bv[2 * e + 1]); aw[e] = cvt_pk(Av[2 * e], Av[2 * e + 1]); }
            *(u32x4*)(HL + (size_t)row * 1024 + ch0) = hw; *(u32x4*)(AC + (size_t)row * 1024 + ch0) = aw;
            if (!smp && c == 15) {
                float* ta = TA + (size_t)tt * 1024 + ch0; float* thp = TH + (size_t)tt * 1024 + ch0;
                *(f32x4*)ta = (f32x4){Av[0], Av[1], Av[2], Av[3]}; *(f32x4*)(ta + 4) = (f32x4){Av[4], Av[5], Av[6], Av[7]};
                *(f32x4*)thp = (f32x4){Bv[0], Bv[1], Bv[2], Bv[3]}; *(f32x4*)(thp + 4) = (f32x4){Bv[4], Bv[5], Bv[6], Bv[7]};
            }
        }
    }
}
__device__ __forceinline__ void phase_F2(const Args& a, LAS unsigned char* lds, int wave, int lane) {
    unsigned char* ws = a.ws; const float* __restrict__ TA = (const float*)(ws + OFF_TA); const float* __restrict__ TH = (const float*)(ws + OFF_TH); float* __restrict__ CARRY = (float*)(ws + OFF_CARRY);
    LAS float* sA = (LAS float*)lds; LAS float* sH = sA + 512;
    for (int blk = blockIdx.x; blk < NB * 16; blk += gridDim.x) {
        const int b = blk >> 4, ch = (blk & 15) * 64 + lane;
        const int j0 = wave * 17, j1 = j0 + 17 < NSUBP ? j0 + 17 : NSUBP;
        float av[17], hv[17];
#pragma unroll
        for (int j = 0; j < 17; ++j) { av[j] = 1.f; hv[j] = 0.f; if (j0 + j < j1) { const size_t o = (size_t)(b * NSUBP + j0 + j) * 1024 + ch; av[j] = TA[o]; hv[j] = TH[o]; } }
        float As = 1.f, Hs = 0.f;
#pragma unroll
        for (int j = 0; j < 17; ++j) { Hs = av[j] * Hs + hv[j]; As = As * av[j]; }
        sA[wave * 64 + lane] = As; sH[wave * 64 + lane] = Hs;
        __syncthreads();
        float carry = 0.f;
        for (int w = 0; w < wave; ++w) carry = sA[w * 64 + lane] * carry + sH[w * 64 + lane];
#pragma unroll
        for (int j = 0; j < 17; ++j) if (j0 + j < j1) { CARRY[(size_t)(b * NSUBP + j0 + j) * 1024 + ch] = carry; carry = av[j] * carry + hv[j]; }
        if (wave == 7) a.out[O_HP + (size_t)b * 1024 + ch] = carry;
        __syncthreads();
    }
}
__device__ __forceinline__ void phase_F3(const Args& a, int gw, int NGW, int lane) {
    unsigned char* ws = a.ws; const bf16_t* GR = (const bf16_t*)(ws + OFF_H); const bf16_t* HL = (const bf16_t*)(ws + OFF_HL); bf16_t* AC = (bf16_t*)(ws + OFF_XB); const float* CARRY = (const float*)(ws + OFF_CARRY);
    for (int row = gw; row < T; row += NGW) {
        int b, t; const bool smp = row >= TP;
        if (!smp) { b = row / LP; t = row - b * LP; } else { b = (row - TP) >> 3; t = (row - TP) & 7; }
        const float* cp = smp ? nullptr : CARRY + (size_t)(b * NSUBP + (t >> 4)) * 1024;
        u32x4 hl2[2], ac2[2], gt2[2]; f32x4 c02[2], c12[2];
#pragma unroll
        for (int half = 0; half < 2; ++half) {
            const int ch = 512 * half + 8 * lane;
            hl2[half] = *(const u32x4*)(HL + (size_t)row * 1024 + ch); ac2[half] = *(const u32x4*)(AC + (size_t)row * 1024 + ch);
            gt2[half] = *(const u32x4*)(GR + (size_t)row * 2048 + ch);
            c02[half] = (f32x4){0.f, 0.f, 0.f, 0.f}; c12[half] = c02[half]; if (!smp) { c02[half] = *(const f32x4*)(cp + ch); c12[half] = *(const f32x4*)(cp + ch + 4); }
        }
#pragma unroll
        for (int half = 0; half < 2; ++half) {
            const int ch = 512 * half + 8 * lane;
            const u32x4 hl = hl2[half], ac = ac2[half], gt = gt2[half]; const f32x4 c0 = c02[half], c1 = c12[half];
            float hv[8];
#pragma unroll
            for (int e = 0; e < 4; ++e) { const float cl = e < 2 ? c0[2 * e] : c1[2 * e - 4], chh = e < 2 ? c0[2 * e + 1] : c1[2 * e - 3];
                hv[2 * e] = bflo(hl[e]) + bflo(ac[e]) * cl; hv[2 * e + 1] = bfhi(hl[e]) + bfhi(ac[e]) * chh; }
            u32x4 y;
#pragma unroll
            for (int e = 0; e < 4; ++e) y[e] = cvt_pk(gelu_tanh(bflo(gt[e])) * hv[2 * e], gelu_tanh(bfhi(gt[e])) * hv[2 * e + 1]);
            *(u32x4*)(AC + (size_t)row * 1024 + ch) = y;
            if (smp && t == 7) { float* o = a.out + O_HS + (size_t)b * 1024 + ch; *(f32x4*)o = (f32x4){hv[0], hv[1], hv[2], hv[3]}; *(f32x4*)(o + 4) = (f32x4){hv[4], hv[5], hv[6], hv[7]}; }
            const int L = smp ? 8 : LP;
            if (t >= L - 3) { const u32x4 rn = *(const u32x4*)(GR + (size_t)row * 2048 + 1024 + ch);
                float* o = a.out + (smp ? O_CBS : O_CBP) + ((size_t)b * 3 + (t - (L - 3))) * 1024 + ch;
                *(f32x4*)o = (f32x4){bflo(rn[0]), bfhi(rn[0]), bflo(rn[1]), bfhi(rn[1])}; *(f32x4*)(o + 4) = (f32x4){bflo(rn[2]), bfhi(rn[2]), bflo(rn[3]), bfhi(rn[3])}; }
        }
    }
}

constexpr size_t OFF_BAR = 16 * KiB;
#define XB_TMO      128
#define XB_XCNT(j)  (256  + 64 * (j))
#define XB_XSUB(j)  (1280 + 64 * (j))
#define XB_XGEN(j)  (2304 + 64 * (j))
#define XB_TOP      3328
#define XB_TOPGEN   3392
#define XCD_BAR_WORDS 3456
#define XB_SPIN_CAP (1u << 18)
__device__ __forceinline__ unsigned xb_ld(unsigned* p)              { return __hip_atomic_load(p, __ATOMIC_RELAXED, __HIP_MEMORY_SCOPE_AGENT); }
__device__ __forceinline__ unsigned xb_add(unsigned* p, unsigned v) { return __hip_atomic_fetch_add(p, v, __ATOMIC_RELAXED, __HIP_MEMORY_SCOPE_AGENT); }
__device__ __forceinline__ unsigned xb_xcc_id() { return (unsigned)__builtin_amdgcn_s_getreg((3 << 11) | 20) & 0xFu; }
#define XB_SPIN(cond, bar) do { unsigned _sp = 0; while (cond) { __builtin_amdgcn_s_sleep(1); \
    if ((++_sp & 255u) == 0u) { if (xb_ld(&(bar)[XB_TMO])) break; if (_sp > XB_SPIN_CAP) { atomicAdd(&(bar)[XB_TMO], 1u); break; } } } } while (0)
struct XcdBarrier { unsigned* bar; unsigned x; volatile LAS unsigned* st; };
__device__ __forceinline__ XcdBarrier xcd_barrier_post(unsigned* bar, volatile LAS unsigned* st) {
    XcdBarrier b; b.bar = bar; b.x = xb_xcc_id(); b.st = st;
    if (threadIdx.x == 0) (void)xb_add(&bar[XB_XCNT(b.x)], 1u);
    return b;
}
__device__ __forceinline__ void xcd_barrier_complete(unsigned* bar, unsigned x, unsigned& nloc, unsigned& nx) {
    const unsigned G = gridDim.x * gridDim.y * gridDim.z;
    unsigned sum, cnt, mine, sp = 0u;
    for (;;) {
        sum = 0u; cnt = 0u; mine = 0u;
#pragma unroll
        for (unsigned j = 0; j < 16; ++j) { const unsigned c = xb_ld(&bar[XB_XCNT(j)]); sum += c; cnt += (c > 0u) ? 1u : 0u; mine = (j == x) ? c : mine; }
        if (sum == G) break;
        __builtin_amdgcn_s_sleep(1);
        if ((++sp & 255u) == 0u) { if (xb_ld(&bar[XB_TMO])) break; if (sp > XB_SPIN_CAP) { atomicAdd(&bar[XB_TMO], 1u); break; } }
    }
    nloc = mine > 0u ? mine : 1u; nx = cnt > 0u ? cnt : 1u;
}
__device__ __forceinline__ void xcd_barrier(const XcdBarrier& b) {
    asm volatile("s_waitcnt vmcnt(0) lgkmcnt(0)" ::: "memory");
    __syncthreads();
    if (threadIdx.x == 0) {
        unsigned* bar = b.bar;
        __builtin_amdgcn_s_waitcnt(0);
        unsigned nloc = b.st[0], nx = b.st[1];
        if (nloc == 0u) { xcd_barrier_complete(bar, b.x, nloc, nx); b.st[0] = nloc; b.st[1] = nx; }
        const unsigned old = xb_add(&bar[XB_XSUB(b.x)], 1u);
        const unsigned gen = old / nloc;
        if (old + 1u == (gen + 1u) * nloc) {
            __builtin_amdgcn_fence(__ATOMIC_RELEASE, "agent");
            asm volatile("s_waitcnt vmcnt(0)" ::: "memory");
            const unsigned og = xb_add(&bar[XB_TOP], 1u);
            const unsigned tg = og / nx;
            if (og + 1u == (tg + 1u) * nx) xb_add(&bar[XB_TOPGEN], 1u);
            else XB_SPIN(xb_ld(&bar[XB_TOPGEN]) == tg, bar);
            __builtin_amdgcn_fence(__ATOMIC_ACQUIRE, "agent");
            xb_add(&bar[XB_XGEN(b.x)], 1u);
            asm volatile("s_waitcnt vmcnt(0)" ::: "memory");
        } else {
            XB_SPIN(xb_ld(&bar[XB_XGEN(b.x)]) == gen, bar);
            __builtin_amdgcn_fence(__ATOMIC_ACQUIRE, "agent");
            asm volatile("s_waitcnt vmcnt(0)" ::: "memory");
        }
    }
    __syncthreads();
}

__global__ void __launch_bounds__(512) fwd_megakernel(Args a) {
    extern __shared__ __attribute__((aligned(16))) unsigned char lds_raw[];
    cg::grid_group grid = cg::this_grid();
    LAS unsigned char* lds = (LAS unsigned char*)lds_raw;
#define FRESH() int tid = threadIdx.x; asm volatile("" : "+v"(tid)); const int lane = tid & 63, wave = __builtin_amdgcn_readfirstlane(tid >> 6); \
    const int gw = blockIdx.x * 8 + wave, NGW = G * 8, gt = blockIdx.x * 512 + tid, NGT = G * 512; (void)gw; (void)NGW; (void)gt; (void)NGT; (void)lane;
    const int G = gridDim.x;
    unsigned char* ws = a.ws;
    bf16_t* XB = (bf16_t*)(ws + OFF_XB); bf16_t* XR = (bf16_t*)(ws + OFF_X32);
    bf16_t* PROJ = (bf16_t*)(ws + OFF_BIG); bf16_t* HB = (bf16_t*)(ws + OFF_H);
    pg8::StaticOrder S;
    { volatile LAS unsigned* st0 = (volatile LAS unsigned*)(lds + 131072 + 64); if (threadIdx.x < 2) st0[threadIdx.x] = 0u; }
    __syncthreads();
    const XcdBarrier xbar = xcd_barrier_post((unsigned*)(ws + OFF_BAR), (volatile LAS unsigned*)(lds + 131072 + 64));
#define GS() xcd_barrier(xbar)
    grid.sync();
    unsigned long long tA = 0, tB = 0;
#define STAMP(k) do { if ((k) == PROBE_A) tA = __builtin_amdgcn_s_memrealtime(); if ((k) == PROBE_B) tB = __builtin_amdgcn_s_memrealtime(); } while (0)
    STAMP(0);

    { FRESH() phase_p0(a, lds, gw, NGW, wave, lane); }
    GS(); STAMP(1);
    { S.init(MP / 256, 4096 / 256, G, (int)blockIdx.x, 16, false); pg8::EpiBf16 E{PROJ, 4096};
      pg8::gemm_phase<pg8::EpiBf16, 0>(lds, XB, (const bf16_t*)(ws + OFF_W_INAB), 1024, S, E); }
    GS(); STAMP(2);
    { FRESH() phase_T(a, gw, NGW, lane); }
    GS(); STAMP(3);
    { FRESH() phase_A(a, gw, NGW, lane); }
    GS(); STAMP(4);
    { FRESH() phase_B(a, gt, NGT); }
    GS(); STAMP(5);
    { FRESH() phase_C(a, gw, NGW, lane); }
    GS(); STAMP(6);
    { FRESH() phase_D(a, gw, NGW, lane); }
    GS(); STAMP(7);
    { S.init(MP / 256, 1024 / 256, G, (int)blockIdx.x, 16, true); pg8::EpiRes<0, true> E{XR, a, HB};
      pg8::gemm_phase<pg8::EpiRes<0, true>, 0, true>(lds, XB, (const bf16_t*)(ws + OFF_W_OUTAB), 1024, S, E); }
    GS(); STAMP(8);
    { FRESH() phase_LN<false, true>(a, a.in[21], a.in[22], HB, 4, gw, NGW, lane); }
    GS(); STAMP(9);
#define FFN_PHASES(layer, sid) \
    { S.init(71, DFF / 128, G, (int)blockIdx.x, 16, false); \
      pg8::EpiFFN E{HB, a.in[26] + (size_t)(layer) * 3 * DFF, a.in[27] + (size_t)(layer) * DFF, a.in[6] + (size_t)(layer) * SBAT * 2 * DFF, \
                    a.out + O_FBP + (size_t)(layer) * NB * 2 * DFF, a.out + O_FBS + (size_t)(layer) * SBAT * 2 * DFF}; \
      pg8::gemm_phase<pg8::EpiFFN, 1>(lds, XR - 2 * 1024, (const bf16_t*)(ws + ((layer) ? OFF_W_UP1 : OFF_W_UP0)), 1024, S, E); } \
    GS(); STAMP(sid); \
    { S.init(MP / 256, 1024 / 256, G, (int)blockIdx.x, 44, true); pg8::EpiRes<1, true> E{XR, a, (bf16_t*)(ws + OFF_PART)}; \
      pg8::gemm_phase<pg8::EpiRes<1, true>, 0, true>(lds, HB, (const bf16_t*)(ws + ((layer) ? OFF_W_DN1 : OFF_W_DN0)), DFF, S, E); } \
    GS(); STAMP(sid + 1);
    FFN_PHASES(0, 10)
    { FRESH() phase_LN<false>(a, a.in[23], a.in[24], (const bf16_t*)(ws + OFF_PART), 11, gw, NGW, lane); }
    GS(); STAMP(12);
    { S.init(MP / 256, 2048 / 256, G, (int)blockIdx.x, 16, false); pg8::EpiBf16 E{HB, 2048};
      pg8::gemm_phase<pg8::EpiBf16, 0>(lds, XR, (const bf16_t*)(ws + OFF_W_INC), 1024, S, E); }
    GS(); STAMP(13);
    { FRESH() phase_F1(a, lds, wave, lane); }
    GS(); STAMP(14);
    { FRESH() phase_F2(a, lds, wave, lane); }
    GS(); STAMP(15);
    { FRESH() phase_F3(a, gw, NGW, lane); }
    GS(); STAMP(16);
    { S.init(MP / 256, 1024 / 256, G, (int)blockIdx.x, 16, true); pg8::EpiRes<1, true> E{XR, a, HB};
      pg8::gemm_phase<pg8::EpiRes<1, true>, 0, true>(lds, XB, (const bf16_t*)(ws + OFF_W_OUTC), 1024, S, E); }
    GS(); STAMP(17);
    { FRESH() phase_LN<false>(a, a.in[21] + 1024, a.in[22] + 1024, HB, 4, gw, NGW, lane); }
    GS(); STAMP(18);
    FFN_PHASES(1, 19)
    { FRESH() phase_LN<true>(a, a.in[23] + 1024, a.in[24] + 1024, (const bf16_t*)(ws + OFF_PART), 11, gw, NGW, lane); }
#if PROBE_A >= 0
    GS(); STAMP(21);
    if (blockIdx.x == 0 && threadIdx.x == 0) a.out[O_YS] += (float)(tB - tA) * 1e-5f;
#endif
#undef FFN_PHASES
}

extern "C" void kernel_launch(void* const* d_in, const int* in_sizes, int n_in, void* d_out, int out_size, void* d_ws, size_t ws_size, hipStream_t stream) {
    static int grid = 0;
    if (grid == 0) {
        if (n_in != 29 || ws_size < WS_END) { fprintf(stderr, "kernel_launch: unexpected n_in %d / ws %zu\n", n_in, ws_size); grid = -1; return; }
        int dev = 0, cus = 0, per_cu = 0;
        hipGetDevice(&dev); hipDeviceGetAttribute(&cus, hipDeviceAttributeMultiprocessorCount, dev);
        if (hipFuncSetAttribute((const void*)fwd_megakernel, hipFuncAttributeMaxDynamicSharedMemorySize, LDS_BYTES) != hipSuccess) { fprintf(stderr, "kernel_launch: hipFuncSetAttribute failed\n"); grid = -1; return; }
        if (hipOccupancyMaxActiveBlocksPerMultiprocessor(&per_cu, (const void*)fwd_megakernel, 512, LDS_BYTES) != hipSuccess || per_cu < 1) { fprintf(stderr, "kernel_launch: occupancy query says %d\n", per_cu); per_cu = 1; }
        (void)hipGetLastError();
        grid = cus * 1;
    }
    if (grid < 0) return;
    (void)hipMemsetAsync((char*)d_ws + OFF_BAR, 0, 16384, stream);
    Args a{};
    for (int i = 0; i < 29; ++i) a.in[i] = (const float*)d_in[i];
    a.out = (float*)d_out; a.ws = (unsigned char*)d_ws;
    void* args[] = {&a};
    hipError_t e = hipLaunchCooperativeKernel((const void*)fwd_megakernel, dim3(grid), dim3(512), args, LDS_BYTES, stream);
    if (e != hipSuccess) fprintf(stderr, "cooperative launch failed: %s (grid %d)\n", hipGetErrorString(e), grid);
}
```

```cpp
#include <hip/hip_runtime.h>
#include <hip/hip_cooperative_groups.h>
#include <cstdio>
#include <cstdint>
namespace cg = cooperative_groups;
#ifndef PROBE_A
#define PROBE_A -1
#define PROBE_B -1
#endif

#define LAS __attribute__((address_space(3)))
typedef unsigned short bf16_t;
typedef short bf16x8 __attribute__((ext_vector_type(8)));
typedef short bf16x4 __attribute__((ext_vector_type(4)));
typedef float f32x4 __attribute__((ext_vector_type(4)));
typedef float f32x2 __attribute__((ext_vector_type(2)));
typedef unsigned u32x4 __attribute__((ext_vector_type(4)));
typedef unsigned u32x2 __attribute__((ext_vector_type(2)));

constexpr int DM = 1024, LP = 2064, NB = 8, TP = NB * LP, SBAT = 128, TS = SBAT * 8, T = TP + TS, MP = 17664;
constexpr int DFF = 2816;
constexpr int NSUBP = 129, NS_P = NB * NSUBP, NS = NS_P + SBAT;
constexpr int NT_P = NB * NSUBP, NT_S = TS / 16, NTILE = NT_P + NT_S;
constexpr float LN_EPS = 1e-5f;
constexpr float ALPHA = 1.41421356237f;

constexpr size_t O_YP = 0, O_YS = 16777216, O_RETP = 17825792, O_RETS = 18350080, O_HGP = 26738688, O_HGS = 27262976, O_HP = 35651584, O_HS = 35659776,
                 O_CBP = 35790848, O_CBS = 35815424, O_FBP = 36208640, O_FBS = 36298752;

constexpr size_t KiB = 1024, MiB = 1024 * 1024;
constexpr size_t OFF_LBV = 0;
constexpr size_t OFF_C8 = 4 * KiB;
constexpr size_t OFF_W_INC = 1 * MiB;
constexpr size_t OFF_WG = 5 * MiB;
constexpr size_t OFF_W_OUTC = 5 * MiB + 512 * KiB;
constexpr size_t OFF_W_UP1 = 7 * MiB + 512 * KiB;
constexpr size_t OFF_W_DN1 = 18 * MiB + 512 * KiB;
constexpr size_t OFF_XB = 24 * MiB + 4096;
constexpr size_t OFF_BIG = 60 * MiB + 512 * KiB;
constexpr size_t OFF_X32 = OFF_BIG;
constexpr size_t OFF_H = 129 * MiB + 512 * KiB;
constexpr size_t OFF_HL = 198 * MiB + 512 * KiB;
constexpr size_t OFF_G = 198 * MiB + 512 * KiB;
constexpr size_t OFF_GS = 203 * MiB + 256 * KiB;
constexpr size_t OFF_U = 204 * MiB;
constexpr size_t OFF_ROPE = 221 * MiB;
constexpr size_t OFF_TA = 233 * MiB, OFF_TH = 238 * MiB, OFF_CARRY = 243 * MiB;
constexpr size_t OFF_W_INAB = 229 * MiB + 512 * KiB;
constexpr size_t OFF_W_OUTAB = 237 * MiB + 512 * KiB;
constexpr size_t OFF_W_UP0 = 239 * MiB + 512 * KiB;
constexpr size_t OFF_W_DN0 = 250 * MiB + 512 * KiB;
constexpr size_t OFF_PART = 224 * MiB + 512 * KiB;
constexpr size_t WS_END = 256 * MiB;
static_assert(OFF_PART + (size_t)11 * 1152 * 1024 * 2 <= OFF_W_DN0, "part");
static_assert(OFF_XB - 4096 + 36 * MiB + 512 * KiB <= OFF_BIG, "xb");
static_assert((size_t)NS * 8 * 128 * 16 * 2 <= OFF_BIG - OFF_XB, "ktt");
static_assert(OFF_H + (size_t)MP * DFF * 2 <= OFF_W_INAB, "h");
static_assert(OFF_G + (size_t)NS * 8 * 128 * 4 <= OFF_GS, "g");
static_assert(OFF_U + 32 * MiB <= OFF_W_OUTAB, "u");
static_assert(OFF_ROPE + 2072 * 64 * 2 * 4 <= OFF_W_INAB, "rope");
static_assert(OFF_HL + (size_t)T * 1024 * 2 <= OFF_TA, "hl");
static_assert(OFF_CARRY + (size_t)NTILE * 1024 * 4 <= WS_END, "carry");

constexpr int LDS_BYTES = 147456;

typedef __bf16 bf16x2_t __attribute__((ext_vector_type(2)));
__device__ __forceinline__ unsigned cvt_pk(float lo, float hi) { f32x2 v = {lo, hi}; bf16x2_t b = __builtin_convertvector(v, bf16x2_t); return __builtin_bit_cast(unsigned, b); }
__device__ __forceinline__ float bflo(unsigned w) { return __uint_as_float(w << 16); }
__device__ __forceinline__ float bfhi(unsigned w) { return __uint_as_float(w & 0xffff0000u); }
__device__ __forceinline__ float sigmoidf_(float x) { return __builtin_amdgcn_rcpf(1.f + __expf(-x)); }
__device__ __forceinline__ float gelu_tanh(float x) { const float t = x * x; const float e = __builtin_amdgcn_exp2f(x * __builtin_fmaf(t, -0.1029432407f, -2.3022081985f)); return x * __builtin_amdgcn_rcpf(1.f + e); }
__device__ __forceinline__ float wave_sum(float v) {
#pragma unroll
    for (int o = 1; o < 64; o <<= 1) v += __shfl_xor(v, o);
    return v;
}
__device__ __forceinline__ float ror1(float v) { return __int_as_float(__builtin_amdgcn_update_dpp(0, __float_as_int(v), 0x121, 0xf, 0xf, false)); }
__device__ __forceinline__ float ror2(float v) { return __int_as_float(__builtin_amdgcn_update_dpp(0, __float_as_int(v), 0x122, 0xf, 0xf, false)); }
__device__ __forceinline__ f32x4 mfma32(bf16x8 a, bf16x8 b, f32x4 c) { return __builtin_amdgcn_mfma_f32_16x16x32_bf16(a, b, c, 0, 0, 0); }
__device__ __forceinline__ f32x4 mfma16(bf16x4 a, bf16x4 b, f32x4 c) { const bf16x8 a8 = (bf16x8){a[0], a[1], a[2], a[3], 0, 0, 0, 0}, b8 = (bf16x8){b[0], b[1], b[2], b[3], 0, 0, 0, 0}; return __builtin_amdgcn_mfma_f32_16x16x32_bf16(a8, b8, c, 0, 0, 0); }
__device__ __forceinline__ bf16x4 pack4(f32x4 v) { u32x2 w; w.x = cvt_pk(v[0], v[1]); w.y = cvt_pk(v[2], v[3]); return __builtin_bit_cast(bf16x4, w); }
__device__ __forceinline__ bf16x8 pack8(f32x4 a, f32x4 b) { u32x4 w; w.x = cvt_pk(a[0], a[1]); w.y = cvt_pk(a[2], a[3]); w.z = cvt_pk(b[0], b[1]); w.w = cvt_pk(b[2], b[3]); return __builtin_bit_cast(bf16x8, w); }

struct Args { const float* in[29]; float* out; unsigned char* ws; };

__device__ __forceinline__ const float* xsrc_row(const Args& a, int row) {
    if (row < TP) { const int b = row / LP, t = row - b * LP; return t < 16 ? a.in[7] + (size_t)t * DM : a.in[0] + ((size_t)b * 2048 + (t - 16)) * DM; }
    return a.in[1] + (size_t)(row - TP) * DM;
}

namespace pg8 {
constexpr int BM = 256, BK = 64, HALF = 128, HTB = HALF * BK * 2, STAGE_BYTES = 8 * HTB, NXCD = 8, WGM = 8;
__device__ __forceinline__ int lds_byte(int r, int c) { const int st = (r >> 4) * 2 + (c >> 5), rr = r & 15, cc = c & 31, ob = rr * 64 + cc * 2; return st * 1024 + (ob ^ (((ob >> 9) & 1) << 5)); }
__device__ __forceinline__ void stage_rc(int b, int& R, int& C) { const int st = b / 1024, sb = b % 1024, swz = sb ^ (((sb >> 9) & 1) << 5); R = (st >> 1) * 16 + swz / 64; C = (st & 1) * 32 + (swz % 64) / 2; }
__device__ __forceinline__ int perm32(int rho) { const int n = rho >> 4, i = rho & 15; return 8 * (i >> 2) + 4 * n + (i & 3); }
struct Unit { int pm, pn, k0, nt, split; };
struct StaticOrder {
    int nM, nN, nwg, G, c, ntf, nfull, nsub, nsplit;
    __device__ __forceinline__ void init(int nM_, int nN_, int G_, int c_, int ntf_, bool SPLIT) { nM = nM_; nN = nN_; nwg = nM * nN; G = G_; c = c_; ntf = ntf_;
        nfull = nwg; nsub = 0; nsplit = 1;
        if (SPLIT && G == 256 && nN == 4 && nM > 64) { nsplit = ntf / 4; nfull = 256; nsub = (nM - 64) * 4 * nsplit; nM = 64; nwg = 256; } }
    __device__ __forceinline__ bool next(int i, Unit& u) const {
        const int L = i * G + c;
        const bool sub = L >= nfull; const int s = L - nfull;
        if (sub && s >= nsub) return false;
        int wgid = sub ? 0 : L;
        { const int q = nwg / NXCD, r = nwg % NXCD, xcd = wgid % NXCD, off = wgid / NXCD; wgid = (xcd < r ? xcd * (q + 1) : r * (q + 1) + (xcd - r) * q) + off; }
        const int nig = WGM * nN, gid = wgid / nig, fm = gid * WGM, gsz = (nM - fm) < WGM ? (nM - fm) : WGM;
        const int pm_f = fm + ((wgid % nig) % gsz), pn_f = (wgid % nig) / gsz;
        const int tl = s / nsplit, ks = s - tl * nsplit;
        u.pm = sub ? 64 + (tl >> 2) : pm_f; u.pn = sub ? (tl & 3) : pn_f; u.k0 = sub ? ks * 4 : 0; u.nt = sub ? 4 : ntf; u.split = sub ? 1 : 0;
        return true;
    }
};

template <class Epi, int AMODE, bool SPLIT = false>
__device__ __forceinline__ void gemm_phase(LAS unsigned char* lds, const bf16_t* Abase, const bf16_t* Btbase, const int K, const StaticOrder& S, const Epi& E) {
    int tid = threadIdx.x; asm volatile("" : "+v"(tid));
    const int wid = __builtin_amdgcn_readfirstlane(tid >> 6), lane = tid & 63, wr = wid >> 2, wc = wid & 3, fr = lane & 15, fq = lane >> 4;
    unsigned voffA[2], voffB[2];
#pragma unroll
    for (int i = 0; i < 2; ++i) { int R, C; stage_rc(tid * 16 + i * 8192, R, C); const int Rb = Epi::PERM ? ((R & ~31) + perm32(R & 31)) : R;
        const int Ra = AMODE ? (R < 64 ? R : R - 2) : R;
        voffA[i] = (unsigned)(Ra * K + C) * 2u; voffB[i] = (unsigned)(Rb * K + C) * 2u; }
    const size_t kstep = (size_t)(BK * 2);
    const size_t hstepB = (size_t)HALF * K * 2, tstepB = 2 * hstepB;
    const size_t hstepA = (size_t)(AMODE ? 124 : 128) * K * 2, tstepA = 2 * hstepA;
    const unsigned ldsw = (unsigned)wid * 1024u;
    const int aoff = lds_byte(wr * 64 + fr, fq * 8), boff = lds_byte(wc * 32 + fr, fq * 8);
#define PG8_SA(b, h) (((b) * 2 + (h)) * HTB)
#define PG8_SB(b, h) ((4 + (b) * 2 + (h)) * HTB)
#define PG8_STAGE(bufoff, gbase, voff) do { _Pragma("unroll") for (int _i = 0; _i < 2; ++_i) \
        __builtin_amdgcn_global_load_lds((const unsigned*)((const char*)(gbase) + (voff)[_i]), (LAS unsigned*)(lds + (bufoff) + ldsw + _i * 8192), 16, 0, 0); } while (0)
#define PG8_LDA(dst, b, h) do { _Pragma("unroll") for (int m = 0; m < 4; ++m) _Pragma("unroll") for (int k = 0; k < 2; ++k) dst[m][k] = *(const LAS bf16x8*)(lds + PG8_SA(b, h) + aoff + m * 2048 + k * 1024); } while (0)
#define PG8_LDB(dst, b, h) do { _Pragma("unroll") for (int n = 0; n < 2; ++n) _Pragma("unroll") for (int k = 0; k < 2; ++k) dst[n][k] = *(const LAS bf16x8*)(lds + PG8_SB(b, h) + boff + n * 2048 + k * 1024); } while (0)
#define PG8_MMA(ai, bj, At, Bt) do { __builtin_amdgcn_s_setprio(1); _Pragma("unroll") for (int m = 0; m < 4; ++m) _Pragma("unroll") for (int n = 0; n < 2; ++n) _Pragma("unroll") for (int k = 0; k < 2; ++k) \
        acc[ai][bj][m][n] = __builtin_amdgcn_mfma_f32_16x16x32_bf16(Bt[n][k], At[m][k], acc[ai][bj][m][n], 0, 0, 0); __builtin_amdgcn_s_setprio(0); } while (0)
#define PG8_WAIT_V(n) asm volatile("s_waitcnt vmcnt(" #n ")" ::: "memory")
#define PG8_WAIT_L(n) asm volatile("s_waitcnt lgkmcnt(" #n ")" ::: "memory")
#define PG8_BAR __builtin_amdgcn_s_barrier()
#define PG8_SCHED __builtin_amdgcn_sched_barrier(0)
    Unit cur, nxt; int ui = 0;
    if (!S.next(0, cur)) return;
    f32x4 acc[2][2][4][2];
#pragma unroll
    for (int a = 0; a < 2; ++a)
#pragma unroll
        for (int b = 0; b < 2; ++b)
#pragma unroll
            for (int m = 0; m < 4; ++m)
#pragma unroll
                for (int n = 0; n < 2; ++n) acc[a][b][m][n] = (f32x4){0.f, 0.f, 0.f, 0.f};
    bf16x8 At[4][2], B0[2][2], B1[2][2];
    const char* cA = (const char*)Abase + (size_t)cur.pm * tstepA + (SPLIT ? (size_t)cur.k0 * kstep : 0); const char* cB = (const char*)Btbase + (size_t)cur.pn * tstepB + (SPLIT ? (size_t)cur.k0 * kstep : 0);
    PG8_STAGE(PG8_SB(0, 0), cB, voffB); PG8_STAGE(PG8_SA(0, 0), cA, voffA); PG8_STAGE(PG8_SB(0, 1), cB + hstepB, voffB); PG8_STAGE(PG8_SA(0, 1), cA + hstepA, voffA);
    if (wr == 1) PG8_BAR;
    PG8_WAIT_V(4); PG8_BAR;
    PG8_STAGE(PG8_SB(1, 0), cB + kstep, voffB); PG8_STAGE(PG8_SA(1, 0), cA + kstep, voffA); PG8_STAGE(PG8_SB(1, 1), cB + hstepB + kstep, voffB);
    PG8_WAIT_V(6); PG8_BAR;
    for (;;) {
        const bool has_next = S.next(ui + 1, nxt);
        const char* nA = has_next ? (const char*)Abase + (size_t)nxt.pm * tstepA + (SPLIT ? (size_t)nxt.k0 * kstep : 0) : cA; const char* nB = has_next ? (const char*)Btbase + (size_t)nxt.pn * tstepB + (SPLIT ? (size_t)nxt.k0 * kstep : 0) : cB;
        const int nt = SPLIT ? cur.nt : K / BK;
        for (int t = 0; t < nt; t += 2) {
            const bool last = (t == nt - 2);
            const char* a1 = cA + (size_t)(t + 1) * kstep;
            const char* a2 = last ? nA : cA + (size_t)(t + 2) * kstep; const char* b2 = last ? nB : cB + (size_t)(t + 2) * kstep;
            const char* a3 = a2 + kstep; const char* b3 = b2 + kstep;
            PG8_LDB(B0, 0, 0); PG8_SCHED; PG8_LDA(At, 0, 0); PG8_STAGE(PG8_SA(1, 1), a1 + hstepA, voffA);
            PG8_WAIT_L(8); PG8_BAR; PG8_WAIT_L(0); PG8_MMA(0, 0, At, B0); PG8_BAR; PG8_SCHED;
            PG8_LDB(B1, 0, 1); PG8_STAGE(PG8_SB(0, 0), b2, voffB);
            PG8_BAR; PG8_WAIT_L(0); PG8_MMA(0, 1, At, B1); PG8_BAR;
            PG8_LDA(At, 0, 1); PG8_STAGE(PG8_SA(0, 0), a2, voffA);
            PG8_BAR; PG8_WAIT_L(0); PG8_MMA(1, 0, At, B0); PG8_BAR; PG8_SCHED;
            PG8_STAGE(PG8_SB(0, 1), b2 + hstepB, voffB);
            PG8_WAIT_V(6); PG8_BAR; PG8_MMA(1, 1, At, B1); PG8_BAR;
            PG8_LDB(B0, 1, 0); PG8_SCHED; PG8_LDA(At, 1, 0); PG8_STAGE(PG8_SA(0, 1), a2 + hstepA, voffA);
            PG8_WAIT_L(8); PG8_BAR; PG8_WAIT_L(0); PG8_MMA(0, 0, At, B0); PG8_BAR; PG8_SCHED;
            PG8_LDB(B1, 1, 1); PG8_STAGE(PG8_SB(1, 0), b3, voffB);
            PG8_BAR; PG8_WAIT_L(0); PG8_MMA(0, 1, At, B1); PG8_BAR;
            PG8_LDA(At, 1, 1); PG8_STAGE(PG8_SA(1, 0), a3, voffA);
            PG8_BAR; PG8_WAIT_L(0); PG8_MMA(1, 0, At, B0); PG8_BAR; PG8_SCHED;
            PG8_STAGE(PG8_SB(1, 1), b3 + hstepB, voffB);
            PG8_WAIT_V(6); PG8_BAR; PG8_MMA(1, 1, At, B1); PG8_BAR;
        }
        E(acc, cur, wr, wc, fr, fq);
        if (!has_next) break;
#pragma unroll
        for (int a = 0; a < 2; ++a)
#pragma unroll
            for (int b = 0; b < 2; ++b)
#pragma unroll
                for (int m = 0; m < 4; ++m)
#pragma unroll
                    for (int n = 0; n < 2; ++n) acc[a][b][m][n] = (f32x4){0.f, 0.f, 0.f, 0.f};
        cur = nxt; cA = nA; cB = nB; ++ui;
    }
    PG8_WAIT_V(0);
    if (wr == 0) PG8_BAR;
    PG8_BAR;
#undef PG8_SA
#undef PG8_SB
#undef PG8_STAGE
#undef PG8_LDA
#undef PG8_LDB
#undef PG8_MMA
#undef PG8_WAIT_V
#undef PG8_WAIT_L
#undef PG8_BAR
#undef PG8_SCHED
}

struct EpiBf16 {
    static constexpr bool PERM = true;
    bf16_t* O; int ldc;
    __device__ __forceinline__ void operator()(const f32x4 (&acc)[2][2][4][2], const Unit& u, int wr, int wc, int fr, int fq) const {
        const int row0 = u.pm * BM + wr * 64 + fr, col0 = u.pn * BM + wc * 32 + 8 * fq;
#pragma unroll
        for (int ai = 0; ai < 2; ++ai)
#pragma unroll
            for (int m = 0; m < 4; ++m) { bf16_t* rowp = O + (size_t)(row0 + ai * HALF + m * 16) * ldc + col0;
#pragma unroll
                for (int bj = 0; bj < 2; ++bj) { const f32x4 v0 = acc[ai][bj][m][0], v1 = acc[ai][bj][m][1];
                    u32x4 w; w.x = cvt_pk(v0[0], v0[1]); w.y = cvt_pk(v0[2], v0[3]); w.z = cvt_pk(v1[0], v1[1]); w.w = cvt_pk(v1[2], v1[3]);
                    *(u32x4*)(rowp + bj * HALF) = w; } }
    }
};
template <int MODE, bool SPLIT> struct EpiRes {
    static constexpr bool PERM = false;
    bf16_t* Y; Args a; bf16_t* PART;
    __device__ __forceinline__ void operator()(const f32x4 (&acc)[2][2][4][2], const Unit& u, int wr, int wc, int fr, int fq) const {
        const int row0 = u.pm * BM + wr * 64 + fr, col0 = u.pn * BM + wc * 32 + 4 * fq;
#pragma unroll
        for (int ai = 0; ai < 2; ++ai)
#pragma unroll
            for (int m = 0; m < 4; ++m) { const int row = row0 + ai * HALF + m * 16;
                if (row < T) { bf16_t* yp = Y + (size_t)row * DM + col0;
                    if (SPLIT && u.split) { bf16_t* pp = PART + ((size_t)(u.k0 >> 2) * 1152 + (row - 16384)) * DM + col0;
#pragma unroll
                        for (int bj = 0; bj < 2; ++bj)
#pragma unroll
                            for (int n = 0; n < 2; ++n) { const f32x4 v = acc[ai][bj][m][n]; u32x2 w; w.x = cvt_pk(v[0], v[1]); w.y = cvt_pk(v[2], v[3]); *(u32x2*)(pp + bj * HALF + n * 16) = w; }
                    } else if (MODE == 0) { const float* rp = xsrc_row(a, row) + col0;
#pragma unroll
                        for (int bj = 0; bj < 2; ++bj)
#pragma unroll
                            for (int n = 0; n < 2; ++n) { const f32x4 v = *(const f32x4*)(rp + bj * HALF + n * 16) * ALPHA + acc[ai][bj][m][n];
                                u32x2 w; w.x = cvt_pk(v[0], v[1]); w.y = cvt_pk(v[2], v[3]); *(u32x2*)(yp + bj * HALF + n * 16) = w; }
                    } else {
#pragma unroll
                        for (int bj = 0; bj < 2; ++bj)
#pragma unroll
                            for (int n = 0; n < 2; ++n) { const u32x2 r = *(const u32x2*)(yp + bj * HALF + n * 16);
                                const f32x4 v = (f32x4){bflo(r.x), bfhi(r.x), bflo(r.y), bfhi(r.y)} * ALPHA + acc[ai][bj][m][n];
                                u32x2 w; w.x = cvt_pk(v[0], v[1]); w.y = cvt_pk(v[2], v[3]); *(u32x2*)(yp + bj * HALF + n * 16) = w; }
                    } } }
    }
};
struct EpiFFN {
    static constexpr bool PERM = true;
    bf16_t* H; const float* cw; const float* cbias; const float* sbuf; float* out_p; float* out_s;
    __device__ __forceinline__ void operator()(const f32x4 (&acc)[2][2][4][2], const Unit& u, int wr, int wc, int fr, int fq) const {
        const int colb = u.pn * 128 + wc * 32 + 8 * fq;
        f32x4 w0[2], w1[2], w2[2], cbv[2];
#pragma unroll
        for (int n = 0; n < 2; ++n) { w0[n] = *(const f32x4*)(cw + colb + 4 * n); w1[n] = *(const f32x4*)(cw + DFF + colb + 4 * n); w2[n] = *(const f32x4*)(cw + 2 * DFF + colb + 4 * n); cbv[n] = *(const f32x4*)(cbias + colb + 4 * n); }
#pragma unroll
        for (int ai = 0; ai < 2; ++ai) {
            const int base = u.pm * 248 + ai * 124 + wr * 62 - 2;
#pragma unroll
            for (int m = 0; m < 4; ++m) {
                const int rb = 16 * m + fr, gr = base + rb;
                f32x4 cur[2], p1[2], p2[2];
#pragma unroll
                for (int n = 0; n < 2; ++n) { cur[n] = acc[ai][0][m][n];
#pragma unroll
                    for (int j = 0; j < 4; ++j) {
                        float b1 = 0.f, b2 = 0.f;
                        if (m > 0) { b1 = ror1(acc[ai][0][m > 0 ? m - 1 : 0][n][j]); b2 = ror2(acc[ai][0][m > 0 ? m - 1 : 0][n][j]); }
                        p1[n][j] = __int_as_float(__builtin_amdgcn_update_dpp(__float_as_int(b1), __float_as_int(cur[n][j]), 0x111, 0xf, 0xf, false));
                        p2[n][j] = __int_as_float(__builtin_amdgcn_update_dpp(__float_as_int(b2), __float_as_int(cur[n][j]), 0x112, 0xf, 0xf, false)); } }
                if (rb >= 2 && gr < T) {
                    const bool smp = gr >= TP; int b, t;
                    if (!smp) { b = gr / LP; t = gr - b * LP; } else { b = (gr - TP) >> 3; t = (gr - TP) & 7; }
                    if (t < 2) {
#pragma unroll
                        for (int n = 0; n < 2; ++n) { f32x4 q0 = (f32x4){0.f, 0.f, 0.f, 0.f}, q1 = q0;
                            if (smp) { q0 = *(const f32x4*)(sbuf + ((size_t)b * 2 + 0) * DFF + colb + 4 * n); q1 = *(const f32x4*)(sbuf + ((size_t)b * 2 + 1) * DFF + colb + 4 * n); }
                            if (t == 0) { p2[n] = q0; p1[n] = q1; } else { p2[n] = q1; } }
                    }
                    f32x4 hv[2];
#pragma unroll
                    for (int n = 0; n < 2; ++n) { const f32x4 y = cbv[n] + w0[n] * p2[n] + w1[n] * p1[n] + w2[n] * cur[n]; const f32x4 v = acc[ai][1][m][n];
#pragma unroll
                        for (int j = 0; j < 4; ++j) hv[n][j] = gelu_tanh(y[j]) * v[j]; }
                    u32x4 w; w.x = cvt_pk(hv[0][0], hv[0][1]); w.y = cvt_pk(hv[0][2], hv[0][3]); w.z = cvt_pk(hv[1][0], hv[1][1]); w.w = cvt_pk(hv[1][2], hv[1][3]);
                    *(u32x4*)(H + (size_t)gr * DFF + colb) = w;
                    const int L = smp ? 8 : LP;
                    if (t >= L - 2) { float* o = (smp ? out_s : out_p) + ((size_t)b * 2 + (t - (L - 2))) * DFF + colb; *(f32x4*)o = cur[0]; *(f32x4*)(o + 4) = cur[1]; }
                }
            }
        }
    }
};
}

__device__ __forceinline__ void p0_transpose_item(const float* W, int K, int N, bf16_t* WT, bool upmap, LAS float* scr, int item, int lane) {
    const int nblk = N / 32, kb = item / nblk, nb = item % nblk, k0 = 64 * kb, n0 = 32 * nb;
#pragma unroll 8
    for (int i = 0; i < 32; ++i) { const int kk = 2 * i + (lane >> 5); scr[kk * 33 + (lane & 31)] = W[(size_t)(k0 + kk) * N + n0 + (lane & 31)]; }
    asm volatile("s_waitcnt lgkmcnt(0)" ::: "memory");
    int r0 = n0;
    if (upmap) { r0 = n0 < DFF ? (n0 / 128) * 256 + (n0 % 128) : ((n0 - DFF) / 128) * 256 + 128 + ((n0 - DFF) % 128); }
    const int c = lane & 7;
#pragma unroll
    for (int j = 0; j < 4; ++j) { const int n = (lane >> 3) + 8 * j; const LAS float* s = scr + (8 * c) * 33 + n;
        u32x4 o; o.x = cvt_pk(s[0 * 33], s[1 * 33]); o.y = cvt_pk(s[2 * 33], s[3 * 33]); o.z = cvt_pk(s[4 * 33], s[5 * 33]); o.w = cvt_pk(s[6 * 33], s[7 * 33]);
        *(u32x4*)(WT + (size_t)(r0 + n) * K + k0 + 8 * c) = o; }
    asm volatile("s_waitcnt lgkmcnt(0)" ::: "memory");
}

__device__ __forceinline__ void convert_weights(const Args& a, LAS unsigned char* lds, int set, int widx, int nw, int wave, int lane) {
    unsigned char* ws = a.ws;
    LAS float* scr = (LAS float*)(lds + wave * 16384);
    constexpr int I0 = 16 * 128, I1 = 16 * 32, I2 = 16 * 64, I3 = 16 * 8, I4 = 16 * 32, I5 = 16 * 176, I6 = 44 * 32;
    if (set == 0) {
        for (int r = widx; r < I0; r += nw) p0_transpose_item(a.in[8], 1024, 4096, (bf16_t*)(ws + OFF_W_INAB), false, scr, r, lane);
    } else if (set == 1) {
        for (int it = widx; it < I1 + I5 + I6; it += nw) { int r = it;
            if (r < I1) { p0_transpose_item(a.in[9], 1024, 1024, (bf16_t*)(ws + OFF_W_OUTAB), false, scr, r, lane); continue; } r -= I1;
            if (r < I5) { p0_transpose_item(a.in[25], 1024, 5632, (bf16_t*)(ws + OFF_W_UP0), true, scr, r, lane); continue; } r -= I5;
            p0_transpose_item(a.in[28], 2816, 1024, (bf16_t*)(ws + OFF_W_DN0), false, scr, r, lane); }
    } else {
        for (int it = widx; it < I2 + I3 + I4 + I5 + I6; it += nw) { int r = it;
            if (r < I2) { p0_transpose_item(a.in[12], 1024, 2048, (bf16_t*)(ws + OFF_W_INC), false, scr, r, lane); continue; } r -= I2;
            if (r < I3) { const int mat = r >> 3, sub = r & 7, n = mat >> 1, gate = mat & 1;
                p0_transpose_item(a.in[gate ? 17 : 15] + (size_t)n * 16384, 128, 128, (bf16_t*)(ws + OFF_WG) + (size_t)(n * 2 + gate) * 16384, false, scr, sub, lane); continue; } r -= I3;
            if (r < I4) { p0_transpose_item(a.in[20], 1024, 1024, (bf16_t*)(ws + OFF_W_OUTC), false, scr, r, lane); continue; } r -= I4;
            if (r < I5) { p0_transpose_item(a.in[25] + (size_t)1024 * 5632, 1024, 5632, (bf16_t*)(ws + OFF_W_UP1), true, scr, r, lane); continue; } r -= I5;
            p0_transpose_item(a.in[28] + (size_t)2816 * 1024, 2816, 1024, (bf16_t*)(ws + OFF_W_DN1), false, scr, r, lane); }
    }
}
__device__ __forceinline__ void phase_p0(const Args& a, LAS unsigned char* lds, int gw, int NGW, int wave, int lane) {
    unsigned char* ws = a.ws;
    convert_weights(a, lds, 0, gw, NGW, wave, lane);
    bf16_t* XB = (bf16_t*)(ws + OFF_XB);
    for (int row0 = gw; row0 < T; row0 += 4 * NGW) {
        f32x4 v[4][4];
#pragma unroll
        for (int q = 0; q < 4; ++q) { const int row = row0 + q * NGW; if (row < T) { const f32x4* xr = (const f32x4*)xsrc_row(a, row) + lane;
#pragma unroll
            for (int j = 0; j < 4; ++j) v[q][j] = xr[64 * j]; } }
#pragma unroll
        for (int q = 0; q < 4; ++q) { const int row = row0 + q * NGW; if (row < T) { u32x2* o = (u32x2*)(XB + (size_t)row * DM) + lane;
#pragma unroll
            for (int j = 0; j < 4; ++j) { u32x2 w; w.x = cvt_pk(v[q][j][0], v[q][j][1]); w.y = cvt_pk(v[q][j][2], v[q][j][3]); o[64 * j] = w; } } }
    }
    const int gt = gw * 64 + lane, NGT = NGW * 64;
    float* ROPE = (float*)(ws + OFF_ROPE);
    for (int e = gt; e < 2072 * 64; e += NGT) {
        const int pi = e >> 6, i = e & 63; const int pos = pi < 2064 ? pi : 16384 + (pi - 2064);
        const float inv = (float)exp(-(double)i * (9.210340371976184 / 64.0));
        const float ang = (float)pos * inv;
        double rev = (double)ang * 0.15915494309189535; rev -= rint(rev);
        const float r = (float)(rev * 6.283185307179586);
        ROPE[2 * e] = cosf(r); ROPE[2 * e + 1] = sinf(r);
    }
    if (gt < 512) { const float* lg = a.in[10]; const float l0 = lg[gt], l1 = lg[512 + gt], l2 = lg[1024 + gt]; const float mx = fmaxf(l0, fmaxf(l1, l2));
        const float e0 = expf(l0 - mx), e1 = expf(l1 - mx), e2 = expf(l2 - mx); ((float*)(ws + OFF_LBV))[gt] = e0 / (e0 + e1 + e2); }
    if (gt < 1024) { const float lam = a.in[19][gt]; ((float*)(ws + OFF_C8))[gt] = -8.f * (lam > 0.f ? log1pf(expf(-lam)) : (log1pf(expf(lam)) - lam)); }
}

__device__ __forceinline__ void sub_geom(int s, int& row0, int& ntok, int& pidx0) {
    if (s < NS_P) { const int b = s / NSUBP, j = s - b * NSUBP; row0 = b * LP + 16 * j; ntok = 16; pidx0 = 16 * j; }
    else { const int b = s - NS_P; row0 = TP + 8 * b; ntok = 8; pidx0 = 2064; }
}

__device__ __forceinline__ void phase_T(const Args& a, int gw, int NGW, int lane) {
    unsigned char* ws = a.ws;
    bf16_t* PROJ = (bf16_t*)(ws + OFF_BIG); bf16_t* KTT = (bf16_t*)(ws + OFF_XB); float* G = (float*)(ws + OFF_G);
    const float* ROPE = (const float*)(ws + OFF_ROPE); const float* LBV = (const float*)(ws + OFF_LBV);
    const int c2 = lane & 31, th = lane >> 5, ca = 2 * c2, cb = ca + 64;
    for (int it = gw; it < NS * 8; it += NGW) {
        const int s = it >> 3, h = it & 7; int row0, ntok, pidx0; sub_geom(s, row0, ntok, pidx0);
        const bool ret = h < 4; const int hh = h & 3;
        const int qc = (ret ? 0 : 2048) + 128 * hh, kc = (ret ? 512 : 2560) + 128 * hh, vc = (ret ? 1024 : 3072) + 128 * hh;
        const bool act = 8 * th < ntok;
        unsigned qa[8], qb[8], ka[8], kb[8], va[8], vb[8];
#pragma unroll
        for (int ii = 0; ii < 8; ++ii) { qa[ii] = qb[ii] = ka[ii] = kb[ii] = va[ii] = vb[ii] = 0u;
            if (act) { const bf16_t* p = PROJ + (size_t)(row0 + 8 * th + ii) * 4096;
                qa[ii] = *(const unsigned*)(p + qc + ca); qb[ii] = *(const unsigned*)(p + qc + cb);
                ka[ii] = *(const unsigned*)(p + kc + ca); kb[ii] = *(const unsigned*)(p + kc + cb);
                va[ii] = *(const unsigned*)(p + vc + ca); vb[ii] = *(const unsigned*)(p + vc + cb); } }
        unsigned kta[8], ktb[8];
        float g0, g1, g2, g3;
        if (ret) {
            const float lf = log1pf(-exp2f(-5.f - (float)hh));
            g0 = g1 = g2 = g3 = __expf(lf * (float)ntok);
#pragma unroll
            for (int ii = 0; ii < 8; ++ii) {
                kta[ii] = 0u; ktb[ii] = 0u;
                if (act) {
                    const int i = 8 * th + ii; const f32x4 cs = *(const f32x4*)(ROPE + ((size_t)(pidx0 + i) * 64 + ca) * 2);
                    const float eq = __expf(lf * (float)(i + 1)), ek = __expf(-lf * (float)(i + 1)) * 0.08838834764831845f;
                    const float q1l = bflo(qa[ii]), q1h = bfhi(qa[ii]), q2l = bflo(qb[ii]), q2h = bfhi(qb[ii]);
                    const float k1l = bflo(ka[ii]), k1h = bfhi(ka[ii]), k2l = bflo(kb[ii]), k2h = bfhi(kb[ii]);
                    const unsigned qoa = cvt_pk((q1l * cs[0] - q2l * cs[1]) * eq, (q1h * cs[2] - q2h * cs[3]) * eq);
                    const unsigned qob = cvt_pk((q1l * cs[1] + q2l * cs[0]) * eq, (q1h * cs[3] + q2h * cs[2]) * eq);
                    kta[ii] = cvt_pk((k1l * cs[0] - k2l * cs[1]) * ek, (k1h * cs[2] - k2h * cs[3]) * ek);
                    ktb[ii] = cvt_pk((k1l * cs[1] + k2l * cs[0]) * ek, (k1h * cs[3] + k2h * cs[2]) * ek);
                    bf16_t* p = PROJ + (size_t)(row0 + i) * 4096;
                    *(unsigned*)(p + qc + ca) = qoa; *(unsigned*)(p + qc + cb) = qob; *(unsigned*)(p + kc + ca) = kta[ii]; *(unsigned*)(p + kc + cb) = ktb[ii];
                }
            }
        } else {
            const f32x2 lba = *(const f32x2*)(LBV + 128 * hh + ca), lbb = *(const f32x2*)(LBV + 128 * hh + cb);
            float lfv[8][4], kv[8][4]; float t0 = 0.f, t1 = 0.f, t2 = 0.f, t3 = 0.f;
#pragma unroll
            for (int ii = 0; ii < 8; ++ii) {
                const float f0 = lba.x + (1.f - lba.x) * sigmoidf_(bflo(ka[ii])), f1 = lba.y + (1.f - lba.y) * sigmoidf_(bfhi(ka[ii]));
                const float f2 = lbb.x + (1.f - lbb.x) * sigmoidf_(bflo(kb[ii])), f3 = lbb.y + (1.f - lbb.y) * sigmoidf_(bfhi(kb[ii]));
                lfv[ii][0] = act ? __logf(f0) : 0.f; lfv[ii][1] = act ? __logf(f1) : 0.f; lfv[ii][2] = act ? __logf(f2) : 0.f; lfv[ii][3] = act ? __logf(f3) : 0.f;
                kv[ii][0] = 1.f - f0; kv[ii][1] = 1.f - f1; kv[ii][2] = 1.f - f2; kv[ii][3] = 1.f - f3;
                t0 += lfv[ii][0]; t1 += lfv[ii][1]; t2 += lfv[ii][2]; t3 += lfv[ii][3];
            }
            const float o0 = __shfl_xor(t0, 32), o1 = __shfl_xor(t1, 32), o2 = __shfl_xor(t2, 32), o3 = __shfl_xor(t3, 32);
            float r0 = th ? o0 : 0.f, r1 = th ? o1 : 0.f, r2 = th ? o2 : 0.f, r3 = th ? o3 : 0.f;
            g0 = __expf(t0 + o0); g1 = __expf(t1 + o1); g2 = __expf(t2 + o2); g3 = __expf(t3 + o3);
#pragma unroll
            for (int ii = 0; ii < 8; ++ii) {
                kta[ii] = 0u; ktb[ii] = 0u;
                r0 += lfv[ii][0]; r1 += lfv[ii][1]; r2 += lfv[ii][2]; r3 += lfv[ii][3];
                if (act) {
                    const float e0 = __expf(r0), e1 = __expf(r1), e2 = __expf(r2), e3 = __expf(r3);
                    const unsigned qoa = cvt_pk(bflo(qa[ii]) * e0, bfhi(qa[ii]) * e1), qob = cvt_pk(bflo(qb[ii]) * e2, bfhi(qb[ii]) * e3);
                    kta[ii] = cvt_pk(kv[ii][0] * __builtin_amdgcn_rcpf(e0), kv[ii][1] * __builtin_amdgcn_rcpf(e1));
                    ktb[ii] = cvt_pk(kv[ii][2] * __builtin_amdgcn_rcpf(e2), kv[ii][3] * __builtin_amdgcn_rcpf(e3));
                    bf16_t* p = PROJ + (size_t)(row0 + 8 * th + ii) * 4096;
                    *(unsigned*)(p + qc + ca) = qoa; *(unsigned*)(p + qc + cb) = qob; *(unsigned*)(p + kc + ca) = kta[ii]; *(unsigned*)(p + kc + cb) = ktb[ii];
                }
            }
        }
        u32x4 kA0, kA1, kB0, kB1, vA0, vA1, vB0, vB1;
#pragma unroll
        for (int w = 0; w < 4; ++w) {
            kA0[w] = (kta[2 * w] & 0xffffu) | (kta[2 * w + 1] << 16); kA1[w] = (kta[2 * w] >> 16) | (kta[2 * w + 1] & 0xffff0000u);
            kB0[w] = (ktb[2 * w] & 0xffffu) | (ktb[2 * w + 1] << 16); kB1[w] = (ktb[2 * w] >> 16) | (ktb[2 * w + 1] & 0xffff0000u);
            vA0[w] = (va[2 * w] & 0xffffu) | (va[2 * w + 1] << 16); vA1[w] = (va[2 * w] >> 16) | (va[2 * w + 1] & 0xffff0000u);
            vB0[w] = (vb[2 * w] & 0xffffu) | (vb[2 * w + 1] << 16); vB1[w] = (vb[2 * w] >> 16) | (vb[2 * w + 1] & 0xffff0000u);
        }
        bf16_t* kt = KTT + (size_t)(s * 8 + h) * 2048 + 8 * th;
        *(u32x4*)(kt + ca * 16) = kA0; *(u32x4*)(kt + (ca + 1) * 16) = kA1; *(u32x4*)(kt + cb * 16) = kB0; *(u32x4*)(kt + (cb + 1) * 16) = kB1;
        if (act) {
            int lin;
            lin = ca * ntok + 8 * th;       *(u32x4*)(PROJ + (size_t)(row0 + (lin >> 7)) * 4096 + vc + (lin & 127)) = vA0;
            lin = (ca + 1) * ntok + 8 * th; *(u32x4*)(PROJ + (size_t)(row0 + (lin >> 7)) * 4096 + vc + (lin & 127)) = vA1;
            lin = cb * ntok + 8 * th;       *(u32x4*)(PROJ + (size_t)(row0 + (lin >> 7)) * 4096 + vc + (lin & 127)) = vB0;
            lin = (cb + 1) * ntok + 8 * th; *(u32x4*)(PROJ + (size_t)(row0 + (lin >> 7)) * 4096 + vc + (lin & 127)) = vB1;
        }
        if (th == 0) { float* gp = G + (size_t)(s * 8 + h) * 128; *(f32x2*)(gp + ca) = (f32x2){g0, g1}; *(f32x2*)(gp + cb) = (f32x2){g2, g3}; }
    }
}

struct GlaOff { int v[2]; int kq; int ost[2][4]; int kt[8]; int g; int qc, kc; };
template <int NTOK>
__device__ __forceinline__ void gla_offsets(GlaOff& o, int h, int sl, int lane) {
    const int c = lane & 15, q4 = lane >> 4; const bool ret = h < 4; const int hh = h & 3;
    o.qc = (ret ? 0 : 2048) + 128 * hh; o.kc = (ret ? 512 : 2560) + 128 * hh; const int vc = (ret ? 1024 : 3072) + 128 * hh;
#pragma unroll
    for (int n = 0; n < 2; ++n) { const int lin = (32 * sl + 16 * n + c) * NTOK + 4 * q4; o.v[n] = (lin >> 7) * 4096 + vc + (lin & 127);
#pragma unroll
        for (int r = 0; r < 4; ++r) { const int l2 = 32 * sl * NTOK + (4 * q4 + r) * 32 + 16 * n + c; o.ost[n][r] = (l2 >> 7) * 4096 + vc + (l2 & 127); } }
    o.kq = c * 4096 + 8 * q4;
#pragma unroll
    for (int t = 0; t < 8; ++t) o.kt[t] = (32 * (t >> 1) + 8 * (c >> 2) + 4 * (t & 1) + (c & 3)) * 16 + 4 * q4;
    o.g = 8 * q4;
}
template <int NTOK>
__device__ __forceinline__ void gla_load_qkv(const bf16_t* pr, const GlaOff& o, int lane, bf16x4 (&vf)[2], bf16x8 (&kf)[4], bf16x8 (&qf)[4]) {
    const int c = lane & 15, q4 = lane >> 4;
#pragma unroll
    for (int n = 0; n < 2; ++n) { vf[n] = (bf16x4){0, 0, 0, 0}; if (NTOK == 16 || 4 * q4 < NTOK) vf[n] = *(const bf16x4*)(pr + o.v[n]); }
#pragma unroll
    for (int kk = 0; kk < 4; ++kk) { kf[kk] = (bf16x8){0, 0, 0, 0, 0, 0, 0, 0}; qf[kk] = kf[kk];
        if (NTOK == 16 || c < NTOK) { kf[kk] = *(const bf16x8*)(pr + o.kq + o.kc + 32 * kk); qf[kk] = *(const bf16x8*)(pr + o.kq + o.qc + 32 * kk); } }
}
template <int NTOK>
__device__ __forceinline__ void gla_step_state(const bf16_t* pr, const bf16_t* kt, const float* g, const GlaOff& o, int lane, f32x4 (&S)[8][2], f32x4 (&P)[8]) {
    const int q4 = lane >> 4;
    bf16x4 vf[2], kaf[8]; f32x4 gvf[8];
#pragma unroll
    for (int n = 0; n < 2; ++n) { vf[n] = (bf16x4){0, 0, 0, 0}; if (NTOK == 16 || 4 * q4 < NTOK) vf[n] = *(const bf16x4*)(pr + o.v[n]); }
#pragma unroll
    for (int t = 0; t < 8; ++t) { kaf[t] = *(const bf16x4*)(kt + o.kt[t]); gvf[t] = *(const f32x4*)(g + o.g + 32 * (t >> 1) + 4 * (t & 1)); }
#pragma unroll
    for (int t = 0; t < 8; ++t)
#pragma unroll
        for (int n = 0; n < 2; ++n) S[t][n] = mfma16(kaf[t], vf[n], S[t][n]);
#pragma unroll
    for (int t = 0; t < 8; ++t) { S[t][0] = S[t][0] * gvf[t]; S[t][1] = S[t][1] * gvf[t]; P[t] = P[t] * gvf[t]; }
}
template <int NTOK>
__device__ __forceinline__ void gla_step_emit(bf16_t* pr, const bf16_t* kt, const float* g, const GlaOff& o, int lane, f32x4 (&S)[8][2], bf16x4 (&vf)[2], bf16x8 (&kf)[4], bf16x8 (&qf)[4], const bf16_t* prn) {
    const int c = lane & 15, q4 = lane >> 4;
    bf16x4 kaf[8]; f32x4 gvf[8];
#pragma unroll
    for (int t = 0; t < 8; ++t) kaf[t] = *(const bf16x4*)(kt + o.kt[t]);
    f32x4 at = (f32x4){0.f, 0.f, 0.f, 0.f};
#pragma unroll
    for (int kk = 0; kk < 4; ++kk) at = mfma32(kf[kk], qf[kk], at);
#pragma unroll
    for (int r = 0; r < 4; ++r) if (4 * q4 + r > c) at[r] = 0.f;
    const bf16x4 pf = pack4(at);
    f32x4 ov[2];
#pragma unroll
    for (int n = 0; n < 2; ++n) { ov[n] = mfma16(pf, vf[n], (f32x4){0.f, 0.f, 0.f, 0.f});
#pragma unroll
        for (int kk = 0; kk < 4; ++kk) ov[n] = mfma32(qf[kk], pack8(S[2 * kk][n], S[2 * kk + 1][n]), ov[n]); }
#pragma unroll
    for (int t = 0; t < 8; ++t) gvf[t] = *(const f32x4*)(g + o.g + 32 * (t >> 1) + 4 * (t & 1));
#pragma unroll
    for (int n = 0; n < 2; ++n)
#pragma unroll
        for (int r = 0; r < 4; ++r) if (NTOK == 16 || 4 * q4 + r < NTOK) pr[o.ost[n][r]] = (bf16_t)(cvt_pk(ov[n][r], 0.f) & 0xffffu);
    bf16x4 vfc[2] = {vf[0], vf[1]};
    if (prn) gla_load_qkv<NTOK>(prn, o, lane, vf, kf, qf);
#pragma unroll
    for (int t = 0; t < 8; ++t)
#pragma unroll
        for (int n = 0; n < 2; ++n) S[t][n] = mfma16(kaf[t], vfc[n], S[t][n]);
#pragma unroll
    for (int t = 0; t < 8; ++t) { S[t][0] = S[t][0] * gvf[t]; S[t][1] = S[t][1] * gvf[t]; }
}
__device__ __forceinline__ void state_load(const float* p, int sl, f32x4 (&S)[8][2], int lane) {
    const int c = lane & 15, q4 = lane >> 4;
#pragma unroll
    for (int t = 0; t < 8; ++t)
#pragma unroll
        for (int n = 0; n < 2; ++n)
#pragma unroll
            for (int r = 0; r < 4; ++r) S[t][n][r] = p[(32 * (t >> 1) + 8 * q4 + 4 * (t & 1) + r) * 128 + 32 * sl + 16 * n + c];
}
__device__ __forceinline__ void state_store(float* p, int sl, const f32x4 (&S)[8][2], int lane) {
    const int c = lane & 15, q4 = lane >> 4;
#pragma unroll
    for (int t = 0; t < 8; ++t)
#pragma unroll
        for (int n = 0; n < 2; ++n)
#pragma unroll
            for (int r = 0; r < 4; ++r) p[(32 * (t >> 1) + 8 * q4 + 4 * (t & 1) + r) * 128 + 32 * sl + 16 * n + c] = S[t][n][r];
}
__device__ __forceinline__ void phase_A(const Args& a, int gw, int NGW, int lane) {
    unsigned char* ws = a.ws; const bf16_t* PROJ = (const bf16_t*)(ws + OFF_BIG); const bf16_t* KTT = (const bf16_t*)(ws + OFF_XB); const float* G = (const float*)(ws + OFF_G); float* U = (float*)(ws + OFF_U);
    float* GSP = (float*)(ws + OFF_GS);
    for (int it = gw; it < 64 * 8 * 4; it += NGW) {
        const int sl = it & 3, g = it >> 2, k = g & 7, bh = g >> 3, b = bh >> 3, h = bh & 7;
        const int j0 = k == 0 ? 0 : 16 * (k - 1) + 1, s0 = b * NSUBP + j0, ns = k == 0 ? 1 : 16;
        GlaOff o; gla_offsets<16>(o, h, sl, lane);
        const bf16_t* pr = PROJ + (size_t)(b * LP + 16 * j0) * 4096; const bf16_t* kt = KTT + (size_t)(s0 * 8 + h) * 2048; const float* gp = G + (size_t)(s0 * 8 + h) * 128;
        f32x4 S[8][2], P[8];
#pragma unroll
        for (int t = 0; t < 8; ++t) { S[t][0] = (f32x4){0.f, 0.f, 0.f, 0.f}; S[t][1] = S[t][0]; P[t] = (f32x4){1.f, 1.f, 1.f, 1.f}; }
        for (int j = 0; j < ns; ++j) { gla_step_state<16>(pr, kt, gp, o, lane, S, P); pr += 16 * 4096; kt += 8 * 2048; gp += 8 * 128; }
        state_store(U + (size_t)(bh * 8 + k) * 16384, sl, S, lane);
        if (sl == 0 && (lane & 15) == 0) { const int q4 = lane >> 4;
#pragma unroll
            for (int t = 0; t < 8; ++t) *(f32x4*)(GSP + (size_t)(bh * 8 + k) * 128 + 32 * (t >> 1) + 8 * q4 + 4 * (t & 1)) = P[t]; }
    }
}
__device__ __forceinline__ void phase_B(const Args& a, int gt, int NGT) {
    unsigned char* ws = a.ws; const float* GSP = (const float*)(ws + OFF_GS); float* U = (float*)(ws + OFF_U);
    for (int idx = gt; idx < 64 * 16384; idx += NGT) {
        const int bh = idx >> 14, e = idx & 16383, dk = e >> 7;
        float uv[8], gv[8];
#pragma unroll
        for (int k = 0; k < 8; ++k) { uv[k] = U[(size_t)(bh * 8 + k) * 16384 + e]; gv[k] = GSP[(size_t)(bh * 8 + k) * 128 + dk]; }
        float Sv = 0.f;
#pragma unroll
        for (int k = 0; k < 8; ++k) { Sv = gv[k] * Sv + uv[k]; U[(size_t)(bh * 8 + k) * 16384 + e] = Sv; }
    }
}
__device__ __forceinline__ void phase_C(const Args& a, int gw, int NGW, int lane) {
    unsigned char* ws = a.ws; bf16_t* PROJ = (bf16_t*)(ws + OFF_BIG); const bf16_t* KTT = (const bf16_t*)(ws + OFF_XB); const float* G = (const float*)(ws + OFF_G); const float* U = (const float*)(ws + OFF_U);
    const int nit = (2304 + 4096 - gw + NGW - 1) / NGW;
    for (int ii = 0; ii < nit; ++ii) {
        const int it = gw + ((gw & 1) ? (nit - 1 - ii) : ii) * NGW;
        const int sl = it & 3; f32x4 S[8][2]; bf16x4 vf[2]; bf16x8 kf[4], qf[4];
        if (it < 2304) {
            int bh, k; if (it < 2048) { const int g = it >> 2; bh = g >> 3; k = (g & 7) + 1; } else { bh = (it - 2048) >> 2; k = 0; }
            const int b = bh >> 3, h = bh & 7;
            if (k == 0) {
#pragma unroll
                for (int t = 0; t < 8; ++t) { S[t][0] = (f32x4){0.f, 0.f, 0.f, 0.f}; S[t][1] = S[t][0]; }
            } else state_load(U + (size_t)(bh * 8 + (k - 1)) * 16384, sl, S, lane);
            const int j0 = k == 0 ? 0 : 16 * (k - 1) + 1, s0 = b * NSUBP + j0, ns = k == 0 ? 1 : 16;
            GlaOff o; gla_offsets<16>(o, h, sl, lane);
            bf16_t* pr = PROJ + (size_t)(b * LP + 16 * j0) * 4096; const bf16_t* kt = KTT + (size_t)(s0 * 8 + h) * 2048; const float* gp = G + (size_t)(s0 * 8 + h) * 128;
            gla_load_qkv<16>(pr, o, lane, vf, kf, qf);
            for (int j = 0; j < ns; ++j) { gla_step_emit<16>(pr, kt, gp, o, lane, S, vf, kf, qf, j + 1 < ns ? pr + 16 * 4096 : nullptr); pr += 16 * 4096; kt += 8 * 2048; gp += 8 * 128; }
            if (k == 8) state_store(a.out + (h < 4 ? O_RETP : O_HGP) + (size_t)(b * 4 + (h & 3)) * 16384, sl, S, lane);
        } else {
            const int g = (it - 2304) >> 2, b = g >> 3, h = g & 7, s = NS_P + b;
            state_load(a.in[h < 4 ? 2 : 3] + (size_t)(b * 4 + (h & 3)) * 16384, sl, S, lane);
            GlaOff o; gla_offsets<8>(o, h, sl, lane);
            bf16_t* pr = PROJ + (size_t)(TP + 8 * b) * 4096;
            gla_load_qkv<8>(pr, o, lane, vf, kf, qf);
            gla_step_emit<8>(pr, KTT + (size_t)(s * 8 + h) * 2048, G + (size_t)(s * 8 + h) * 128, o, lane, S, vf, kf, qf, nullptr);
            state_store(a.out + (h < 4 ? O_RETS : O_HGS) + (size_t)(b * 4 + (h & 3)) * 16384, sl, S, lane);
        }
    }
}
__device__ __forceinline__ void phase_D(const Args& a, int gw, int NGW, int lane) {
    unsigned char* ws = a.ws; const bf16_t* PROJ = (const bf16_t*)(ws + OFF_BIG); bf16_t* MIX = (bf16_t*)(ws + OFF_XB); const float* nw = a.in[11];
    const int i = lane & 15, sl = lane >> 4;
    for (int it = gw; it < NS * 8; it += NGW) {
        const int s = it >> 3, h = it & 7; int row0, ntok, pidx0; sub_geom(s, row0, ntok, pidx0);
        const bool ret = h < 4; const int hh = h & 3;
        const int vc = (ret ? 1024 : 3072) + 128 * hh, gc = (ret ? 1536 : 3584) + 128 * hh + 32 * sl;
        const bool valid = i < ntok;
        float o[32];
        const int lin0 = 32 * sl * ntok + 32 * i;
        const bf16_t* op = PROJ + (size_t)(row0 + (lin0 >> 7)) * 4096 + vc + (lin0 & 127);
#pragma unroll
        for (int w = 0; w < 4; ++w) { u32x4 x = (u32x4){0u, 0u, 0u, 0u}; if (valid) x = *(const u32x4*)(op + 8 * w);
#pragma unroll
            for (int e = 0; e < 4; ++e) { o[8 * w + 2 * e] = bflo(x[e]); o[8 * w + 2 * e + 1] = bfhi(x[e]); } }
        u32x4 gx4[4];
#pragma unroll
        for (int w = 0; w < 4; ++w) { gx4[w] = (u32x4){0u, 0u, 0u, 0u}; if (valid) gx4[w] = *(const u32x4*)(PROJ + (size_t)(row0 + i) * 4096 + gc + 8 * w); }
        float sum = 0.f;
#pragma unroll
        for (int e = 0; e < 32; ++e) sum += o[e];
        sum += __shfl_xor(sum, 16); sum += __shfl_xor(sum, 32);
        const float mu = ret ? sum * (1.f / 128.f) : 0.f;
        float sq = 0.f;
#pragma unroll
        for (int e = 0; e < 32; ++e) { const float d = o[e] - mu; sq += d * d; }
        sq += __shfl_xor(sq, 16); sq += __shfl_xor(sq, 32);
        const float rstd = rsqrtf(sq * (1.f / 128.f) + LN_EPS);
        if (valid) {
            bf16_t* mp = MIX + (size_t)(row0 + i) * DM + 128 * h + 32 * sl;
#pragma unroll
            for (int w = 0; w < 4; ++w) { const u32x4 gx = gx4[w]; float r[8];
#pragma unroll
                for (int e = 0; e < 4; ++e) { const float g0 = bflo(gx[e]), g1 = bfhi(gx[e]);
                    float v0 = (o[8 * w + 2 * e] - mu) * rstd, v1 = (o[8 * w + 2 * e + 1] - mu) * rstd;
                    if (!ret) { v0 *= nw[32 * sl + 8 * w + 2 * e]; v1 *= nw[32 * sl + 8 * w + 2 * e + 1]; }
                    r[2 * e] = v0 * g0 * sigmoidf_(g0); r[2 * e + 1] = v1 * g1 * sigmoidf_(g1); }
                u32x4 ov; ov.x = cvt_pk(r[0], r[1]); ov.y = cvt_pk(r[2], r[3]); ov.z = cvt_pk(r[4], r[5]); ov.w = cvt_pk(r[6], r[7]);
                *(u32x4*)(mp + 8 * w) = ov; }
        }
    }
}

template <bool FINAL, bool FROMX0 = false>
__device__ __forceinline__ void phase_LN(const Args& a, const float* gam, const float* bet, const bf16_t* PART, int nsplit, int gw, int NGW, int lane) {
    unsigned char* ws = a.ws; bf16_t* XR = (bf16_t*)(ws + OFF_X32);
    f32x4 gv[4], bv[4];
#pragma unroll
    for (int j = 0; j < 4; ++j) { gv[j] = ((const f32x4*)gam)[lane + 64 * j]; bv[j] = ((const f32x4*)bet)[lane + 64 * j]; }
    for (int row0 = gw; row0 < T; row0 += 4 * NGW) {
        f32x4 v[4][4];
#pragma unroll
        for (int q = 0; q < 4; ++q) { const int row = row0 + q * NGW;
            if (row < T) { const u32x2* xr = (const u32x2*)(XR + (size_t)row * DM) + lane;
#pragma unroll
                for (int j = 0; j < 4; ++j) { const u32x2 w = xr[64 * j]; v[q][j] = (f32x4){bflo(w.x), bfhi(w.x), bflo(w.y), bfhi(w.y)}; }
                if (FROMX0 && row >= 16384) { const f32x4* x0 = (const f32x4*)xsrc_row(a, row) + lane;
#pragma unroll
                    for (int j = 0; j < 4; ++j) v[q][j] = x0[64 * j]; }
                if (row >= 16384 && nsplit > 0) {
#pragma unroll
                    for (int j = 0; j < 4; ++j) v[q][j] = v[q][j] * ALPHA;
                    for (int s = 0; s < nsplit; ++s) { const u32x2* pr = (const u32x2*)(PART + ((size_t)s * 1152 + (row - 16384)) * DM) + lane;
#pragma unroll
                        for (int j = 0; j < 4; ++j) { const u32x2 w = pr[64 * j]; v[q][j] += (f32x4){bflo(w.x), bfhi(w.x), bflo(w.y), bfhi(w.y)}; } } } } }
#pragma unroll
        for (int q = 0; q < 4; ++q) { const int row = row0 + q * NGW;
            if (row < T) {
                float s = 0.f;
#pragma unroll
                for (int j = 0; j < 4; ++j) s += (v[q][j][0] + v[q][j][1]) + (v[q][j][2] + v[q][j][3]);
                const float mean = wave_sum(s) * (1.f / DM); float s2 = 0.f;
#pragma unroll
                for (int j = 0; j < 4; ++j) { v[q][j] = v[q][j] - mean; s2 += (v[q][j][0] * v[q][j][0] + v[q][j][1] * v[q][j][1]) + (v[q][j][2] * v[q][j][2] + v[q][j][3] * v[q][j][3]); }
                const float rstd = rsqrtf(wave_sum(s2) * (1.f / DM) + LN_EPS);
#pragma unroll
                for (int j = 0; j < 4; ++j) v[q][j] = v[q][j] * rstd * gv[j] + bv[j];
                if (FINAL) {
                    float* op = nullptr;
                    if (row < TP) { const int b = row / LP, t = row - b * LP; if (t >= 16) op = a.out + O_YP + ((size_t)b * 2048 + (t - 16)) * DM; }
                    else op = a.out + O_YS + (size_t)(row - TP) * DM;
                    if (op) {
#pragma unroll
                        for (int j = 0; j < 4; ++j) ((f32x4*)op)[lane + 64 * j] = v[q][j]; }
                } else {
                    u32x2* ob = (u32x2*)(XR + (size_t)row * DM) + lane;
#pragma unroll
                    for (int j = 0; j < 4; ++j) { u32x2 w; w.x = cvt_pk(v[q][j][0], v[q][j][1]); w.y = cvt_pk(v[q][j][2], v[q][j][3]); ob[64 * j] = w; }
                }
            } }
    }
}

__device__ __forceinline__ void phase_F1(const Args& a, LAS unsigned char* lds, int wave, int lane) {
    unsigned char* ws = a.ws; const bf16_t* __restrict__ GR = (const bf16_t*)(ws + OFF_H); const bf16_t* __restrict__ WG = (const bf16_t*)(ws + OFF_WG);
    bf16_t* __restrict__ HL = (bf16_t*)(ws + OFF_HL); bf16_t* __restrict__ AC = (bf16_t*)(ws + OFF_XB); float* __restrict__ TA = (float*)(ws + OFF_TA); float* __restrict__ TH = (float*)(ws + OFF_TH);
    const float* C8 = (const float*)(ws + OFF_C8);
    const float* convw = a.in[13]; const float* convb = a.in[14]; const float* bga = a.in[16]; const float* bgx = a.in[18];
    const int c = lane & 15, q4 = lane >> 4;
    const int n = blockIdx.x & 7;
    { const u32x4* wsrc = (const u32x4*)(WG + (size_t)n * 2 * 16384);
      for (int e = threadIdx.x; e < 4096; e += 512) { const int r = e >> 4, cc = e & 15; *(LAS u32x4*)(lds + r * 272 + cc * 16) = wsrc[e]; } }
    LAS float* cst = (LAS float*)(lds + 69632);
    for (int e = threadIdx.x; e < 1024; e += 512) { const int k = e >> 7, ch = 128 * n + (e & 127);
        cst[e] = k == 0 ? bga[ch] : k == 1 ? bgx[ch] : k == 2 ? C8[ch] : k < 7 ? convw[(k - 3) * 1024 + ch] : convb[ch]; }
    __syncthreads();
    for (int tt = ((int)blockIdx.x >> 3) * 8 + wave; tt < NTILE; tt += (int)(gridDim.x >> 3) * 8) {
        int row, b, t, W; bool smp;
        if (tt < NT_P) { b = tt / NSUBP; const int j = tt - b * NSUBP; row = b * LP + 16 * j + c; t = 16 * j + c; W = 16; smp = false; }
        else { const int k = tt - NT_P; row = TP + 16 * k + c; b = 2 * k + (c >> 3); t = c & 7; W = 8; smp = true; }
        const int chb = 128 * n;
        bf16x8 bfr[4];
#pragma unroll
        for (int q = 0; q < 4; ++q) bfr[q] = (bf16x8){0, 0, 0, 0, 0, 0, 0, 0};
#pragma unroll 2
        for (int kk = 0; kk < 4; ++kk) {
            const int ch0 = chb + 32 * kk + 8 * q4;
            const int cl0 = 32 * kk + 8 * q4;
            f32x4 s0 = *(const LAS f32x4*)(cst + 7 * 128 + cl0), s1 = *(const LAS f32x4*)(cst + 7 * 128 + cl0 + 4);
#pragma unroll
            for (int d = 0; d < 4; ++d) {
                const f32x4 wa = *(const LAS f32x4*)(cst + (3 + 3 - d) * 128 + cl0), wb = *(const LAS f32x4*)(cst + (3 + 3 - d) * 128 + cl0 + 4);
                f32x4 xa = (f32x4){0.f, 0.f, 0.f, 0.f}, xb = xa;
                if (t - d >= 0) { const u32x4 x = *(const u32x4*)(GR + (size_t)(row - d) * 2048 + 1024 + ch0);
                    xa = (f32x4){bflo(x[0]), bfhi(x[0]), bflo(x[1]), bfhi(x[1])}; xb = (f32x4){bflo(x[2]), bfhi(x[2]), bflo(x[3]), bfhi(x[3])}; }
                else if (smp) { const float* sp = a.in[5] + ((size_t)b * 3 + (t - d + 3)) * 1024 + ch0; xa = *(const f32x4*)sp; xb = *(const f32x4*)(sp + 4); }
                s0 += wa * xa; s1 += wb * xb;
            }
            { const bf16x8 pv = pack8(s0, s1);
#pragma unroll
              for (int q = 0; q < 4; ++q) bfr[q] = (kk == q) ? pv : bfr[q]; }
        }
#pragma unroll 2
        for (int kk = 0; kk < 4; ++kk) {
            const int ch0 = chb + 32 * kk + 8 * q4;
            const int cl0 = 32 * kk + 8 * q4;
            const f32x4 ba0 = *(const LAS f32x4*)(cst + cl0), ba1 = *(const LAS f32x4*)(cst + cl0 + 4), bx0 = *(const LAS f32x4*)(cst + 128 + cl0), bx1 = *(const LAS f32x4*)(cst + 128 + cl0 + 4);
            const f32x4 c80 = *(const LAS f32x4*)(cst + 256 + cl0), c81 = *(const LAS f32x4*)(cst + 256 + cl0 + 4);
            f32x4 h00 = (f32x4){0.f, 0.f, 0.f, 0.f}, h01 = h00;
            if (smp && t == 0) { h00 = *(const f32x4*)(a.in[4] + (size_t)b * 1024 + ch0); h01 = *(const f32x4*)(a.in[4] + (size_t)b * 1024 + ch0 + 4); }
            f32x4 ra[2], ia[2];
#pragma unroll
            for (int hf = 0; hf < 2; ++hf) {
                const int oc = 32 * kk + 8 * (c >> 2) + 4 * hf + (c & 3);
                ra[hf] = (f32x4){0.f, 0.f, 0.f, 0.f}; ia[hf] = ra[hf];
#pragma unroll
                for (int k2 = 0; k2 < 4; ++k2) {
                    const bf16x8 wa = *(const LAS bf16x8*)(lds + (0 * 128 + oc) * 272 + (32 * k2 + 8 * q4) * 2);
                    const bf16x8 wx = *(const LAS bf16x8*)(lds + (1 * 128 + oc) * 272 + (32 * k2 + 8 * q4) * 2);
                    ra[hf] = mfma32(wa, bfr[k2], ra[hf]); ia[hf] = mfma32(wx, bfr[k2], ia[hf]);
                }
            }
            float Av[8], Bv[8], xcv[8];
            { const u32x4 x0 = __builtin_bit_cast(u32x4, bfr[0]), x1 = __builtin_bit_cast(u32x4, bfr[1]), x2 = __builtin_bit_cast(u32x4, bfr[2]), x3 = __builtin_bit_cast(u32x4, bfr[3]);
#pragma unroll
              for (int e = 0; e < 4; ++e) { const unsigned w = kk == 0 ? x0[e] : kk == 1 ? x1[e] : kk == 2 ? x2[e] : x3[e]; xcv[2 * e] = bflo(w); xcv[2 * e + 1] = bfhi(w); } }
#pragma unroll
            for (int jp = 0; jp < 8; ++jp) {
                const int hf = jp >> 2, r = jp & 3;
                const float rr = sigmoidf_(ra[hf][r] + (hf ? ba1[r] : ba0[r])), ii = sigmoidf_(ia[hf][r] + (hf ? bx1[r] : bx0[r]));
                const float la = rr * (hf ? c81[r] : c80[r]); const float av = __expf(la);
                float bv = __builtin_amdgcn_sqrtf(fmaxf(1.f - av * av, 0.f)) * (ii * xcv[jp]);
                bv += av * (hf ? h01[r] : h00[r]);
                Av[jp] = av; Bv[jp] = bv;
            }
#define F1_SCAN_STEP(D, CTRL) { const bool take = (c & (W - 1)) >= (D); \
                _Pragma("unroll") for (int jp = 0; jp < 8; ++jp) { \
                    const float ap = __int_as_float(__builtin_amdgcn_update_dpp(0, __float_as_int(Av[jp]), CTRL, 0xf, 0xf, false)); \
                    const float bp = __int_as_float(__builtin_amdgcn_update_dpp(0, __float_as_int(Bv[jp]), CTRL, 0xf, 0xf, false)); \
                    if (take) { Bv[jp] = Av[jp] * bp + Bv[jp]; Av[jp] = Av[jp] * ap; } } }
            F1_SCAN_STEP(1, 0x111) F1_SCAN_STEP(2, 0x112) F1_SCAN_STEP(4, 0x114)
            if (W == 16) F1_SCAN_STEP(8, 0x118)
#undef F1_SCAN_STEP
            u32x4 hw, aw;
#pragma unroll
            for (int e = 0; e < 4; ++e) { hw[e] = cvt_pk(Bv[2 * e], Bv[2 * e + 1]); aw[e] = cvt_pk(Av[2 * e], Av[2 * e + 1]); }
            *(u32x4*)(HL + (size_t)row * 1024 + ch0) = hw; *(u32x4*)(AC + (size_t)row * 1024 + ch0) = aw;
            if (!smp && c == 15) {
                float* ta = TA + (size_t)tt * 1024 + ch0; float* thp = TH + (size_t)tt * 1024 + ch0;
                *(f32x4*)ta = (f32x4){Av[0], Av[1], Av[2], Av[3]}; *(f32x4*)(ta + 4) = (f32x4){Av[4], Av[5], Av[6], Av[7]};
                *(f32x4*)thp = (f32x4){Bv[0], Bv[1], Bv[2], Bv[3]}; *(f32x4*)(thp + 4) = (f32x4){Bv[4], Bv[5], Bv[6], Bv[7]};
            }
        }
    }
}
__device__ __forceinline__ void phase_F2(const Args& a, LAS unsigned char* lds, int wave, int lane) {
    unsigned char* ws = a.ws; const float* __restrict__ TA = (const float*)(ws + OFF_TA); const float* __restrict__ TH = (const float*)(ws + OFF_TH); float* __restrict__ CARRY = (float*)(ws + OFF_CARRY);
    LAS float* sA = (LAS float*)lds; LAS float* sH = sA + 512;
    for (int blk = blockIdx.x; blk < NB * 16; blk += gridDim.x) {
        const int b = blk >> 4, ch = (blk & 15) * 64 + lane;
        const int j0 = wave * 17, j1 = j0 + 17 < NSUBP ? j0 + 17 : NSUBP;
        float av[17], hv[17];
#pragma unroll
        for (int j = 0; j < 17; ++j) { av[j] = 1.f; hv[j] = 0.f; if (j0 + j < j1) { const size_t o = (size_t)(b * NSUBP + j0 + j) * 1024 + ch; av[j] = TA[o]; hv[j] = TH[o]; } }
        float As = 1.f, Hs = 0.f;
#pragma unroll
        for (int j = 0; j < 17; ++j) { Hs = av[j] * Hs + hv[j]; As = As * av[j]; }
        sA[wave * 64 + lane] = As; sH[wave * 64 + lane] = Hs;
        __syncthreads();
        float carry = 0.f;
        for (int w = 0; w < wave; ++w) carry = sA[w * 64 + lane] * carry + sH[w * 64 + lane];
#pragma unroll
        for (int j = 0; j < 17; ++j) if (j0 + j < j1) { CARRY[(size_t)(b * NSUBP + j0 + j) * 1024 + ch] = carry; carry = av[j] * carry + hv[j]; }
        if (wave == 7) a.out[O_HP + (size_t)b * 1024 + ch] = carry;
        __syncthreads();
    }
}
__device__ __forceinline__ void phase_F3(const Args& a, int gw, int NGW, int lane) {
    unsigned char* ws = a.ws; const bf16_t* GR = (const bf16_t*)(ws + OFF_H); const bf16_t* HL = (const bf16_t*)(ws + OFF_HL); bf16_t* AC = (bf16_t*)(ws + OFF_XB); const float* CARRY = (const float*)(ws + OFF_CARRY);
    for (int row = gw; row < T; row += NGW) {
        int b, t; const bool smp = row >= TP;
        if (!smp) { b = row / LP; t = row - b * LP; } else { b = (row - TP) >> 3; t = (row - TP) & 7; }
        const float* cp = smp ? nullptr : CARRY + (size_t)(b * NSUBP + (t >> 4)) * 1024;
        u32x4 hl2[2], ac2[2], gt2[2]; f32x4 c02[2], c12[2];
#pragma unroll
        for (int half = 0; half < 2; ++half) {
            const int ch = 512 * half + 8 * lane;
            hl2[half] = *(const u32x4*)(HL + (size_t)row * 1024 + ch); ac2[half] = *(const u32x4*)(AC + (size_t)row * 1024 + ch);
            gt2[half] = *(const u32x4*)(GR + (size_t)row * 2048 + ch);
            c02[half] = (f32x4){0.f, 0.f, 0.f, 0.f}; c12[half] = c02[half]; if (!smp) { c02[half] = *(const f32x4*)(cp + ch); c12[half] = *(const f32x4*)(cp + ch + 4); }
        }
#pragma unroll
        for (int half = 0; half < 2; ++half) {
            const int ch = 512 * half + 8 * lane;
            const u32x4 hl = hl2[half], ac = ac2[half], gt = gt2[half]; const f32x4 c0 = c02[half], c1 = c12[half];
            float hv[8];
#pragma unroll
            for (int e = 0; e < 4; ++e) { const float cl = e < 2 ? c0[2 * e] : c1[2 * e - 4], chh = e < 2 ? c0[2 * e + 1] : c1[2 * e - 3];
                hv[2 * e] = bflo(hl[e]) + bflo(ac[e]) * cl; hv[2 * e + 1] = bfhi(hl[e]) + bfhi(ac[e]) * chh; }
            u32x4 y;
#pragma unroll
            for (int e = 0; e < 4; ++e) y[e] = cvt_pk(gelu_tanh(bflo(gt[e])) * hv[2 * e], gelu_tanh(bfhi(gt[e])) * hv[2 * e + 1]);
            *(u32x4*)(AC + (size_t)row * 1024 + ch) = y;
            if (smp && t == 7) { float* o = a.out + O_HS + (size_t)b * 1024 + ch; *(f32x4*)o = (f32x4){hv[0], hv[1], hv[2], hv[3]}; *(f32x4*)(o + 4) = (f32x4){hv[4], hv[5], hv[6], hv[7]}; }
            const int L = smp ? 8 : LP;
            if (t >= L - 3) { const u32x4 rn = *(const u32x4*)(GR + (size_t)row * 2048 + 1024 + ch);
                float* o = a.out + (smp ? O_CBS : O_CBP) + ((size_t)b * 3 + (t - (L - 3))) * 1024 + ch;
                *(f32x4*)o = (f32x4){bflo(rn[0]), bfhi(rn[0]), bflo(rn[1]), bfhi(rn[1])}; *(f32x4*)(o + 4) = (f32x4){bflo(rn[2]), bfhi(rn[2]), bflo(rn[3]), bfhi(rn[3])}; }
        }
    }
}

constexpr size_t OFF_BAR = 16 * KiB;
#define XB_TMO      128
#define XB_XCNT(j)  (256  + 64 * (j))
#define XB_XSUB(j)  (1280 + 64 * (j))
#define XB_XGEN(j)  (2304 + 64 * (j))
#define XB_TOP      3328
#define XB_TOPGEN   3392
#define XCD_BAR_WORDS 3456
#define XB_SPIN_CAP (1u << 18)
__device__ __forceinline__ unsigned xb_ld(unsigned* p)              { return __hip_atomic_load(p, __ATOMIC_RELAXED, __HIP_MEMORY_SCOPE_AGENT); }
__device__ __forceinline__ unsigned xb_add(unsigned* p, unsigned v) { return __hip_atomic_fetch_add(p, v, __ATOMIC_RELAXED, __HIP_MEMORY_SCOPE_AGENT); }
__device__ __forceinline__ unsigned xb_xcc_id() { return (unsigned)__builtin_amdgcn_s_getreg((3 << 11) | 20) & 0xFu; }
#define XB_SPIN(cond, bar) do { unsigned _sp = 0; while (cond) { __builtin_amdgcn_s_sleep(1); \
    if ((++_sp & 255u) == 0u) { if (xb_ld(&(bar)[XB_TMO])) break; if (_sp > XB_SPIN_CAP) { atomicAdd(&(bar)[XB_TMO], 1u); break; } } } } while (0)
struct XcdBarrier { unsigned* bar; unsigned x; volatile LAS unsigned* st; };
__device__ __forceinline__ XcdBarrier xcd_barrier_post(unsigned* bar, volatile LAS unsigned* st) {
    XcdBarrier b; b.bar = bar; b.x = xb_xcc_id(); b.st = st;
    if (threadIdx.x == 0) (void)xb_add(&bar[XB_XCNT(b.x)], 1u);
    return b;
}
__device__ __forceinline__ void xcd_barrier_complete(unsigned* bar, unsigned x, unsigned& nloc, unsigned& nx) {
    const unsigned G = gridDim.x * gridDim.y * gridDim.z;
    unsigned sum, cnt, mine, sp = 0u;
    for (;;) {
        sum = 0u; cnt = 0u; mine = 0u;
#pragma unroll
        for (unsigned j = 0; j < 16; ++j) { const unsigned c = xb_ld(&bar[XB_XCNT(j)]); sum += c; cnt += (c > 0u) ? 1u : 0u; mine = (j == x) ? c : mine; }
        if (sum == G) break;
        __builtin_amdgcn_s_sleep(1);
        if ((++sp & 255u) == 0u) { if (xb_ld(&bar[XB_TMO])) break; if (sp > XB_SPIN_CAP) { atomicAdd(&bar[XB_TMO], 1u); break; } }
    }
    nloc = mine > 0u ? mine : 1u; nx = cnt > 0u ? cnt : 1u;
}
__device__ __forceinline__ void xcd_barrier(const XcdBarrier& b) {
    asm volatile("s_waitcnt vmcnt(0) lgkmcnt(0)" ::: "memory");
    __syncthreads();
    if (threadIdx.x == 0) {
        unsigned* bar = b.bar;
        __builtin_amdgcn_s_waitcnt(0);
        unsigned nloc = b.st[0], nx = b.st[1];
        if (nloc == 0u) { xcd_barrier_complete(bar, b.x, nloc, nx); b.st[0] = nloc; b.st[1] = nx; }
        const unsigned old = xb_add(&bar[XB_XSUB(b.x)], 1u);
        const unsigned gen = old / nloc;
        if (old + 1u == (gen + 1u) * nloc) {
            __builtin_amdgcn_fence(__ATOMIC_RELEASE, "agent");
            asm volatile("s_waitcnt vmcnt(0)" ::: "memory");
            const unsigned og = xb_add(&bar[XB_TOP], 1u);
            const unsigned tg = og / nx;
            if (og + 1u == (tg + 1u) * nx) xb_add(&bar[XB_TOPGEN], 1u);
            else XB_SPIN(xb_ld(&bar[XB_TOPGEN]) == tg, bar);
            __builtin_amdgcn_fence(__ATOMIC_ACQUIRE, "agent");
            xb_add(&bar[XB_XGEN(b.x)], 1u);
            asm volatile("s_waitcnt vmcnt(0)" ::: "memory");
        } else {
            XB_SPIN(xb_ld(&bar[XB_XGEN(b.x)]) == gen, bar);
            __builtin_amdgcn_fence(__ATOMIC_ACQUIRE, "agent");
            asm volatile("s_waitcnt vmcnt(0)" ::: "memory");
        }
    }
    __syncthreads();
}

__global__ void __launch_bounds__(512) fwd_megakernel(Args a) {
    extern __shared__ __attribute__((aligned(16))) unsigned char lds_raw[];
    cg::grid_group grid = cg::this_grid();
    LAS unsigned char* lds = (LAS unsigned char*)lds_raw;
#define FRESH() int tid = threadIdx.x; asm volatile("" : "+v"(tid)); const int lane = tid & 63, wave = __builtin_amdgcn_readfirstlane(tid >> 6); \
    const int gw = blockIdx.x * 8 + wave, NGW = G * 8, gt = blockIdx.x * 512 + tid, NGT = G * 512; (void)gw; (void)NGW; (void)gt; (void)NGT; (void)lane;
    const int G = gridDim.x;
    unsigned char* ws = a.ws;
    bf16_t* XB = (bf16_t*)(ws + OFF_XB); bf16_t* XR = (bf16_t*)(ws + OFF_X32);
    bf16_t* PROJ = (bf16_t*)(ws + OFF_BIG); bf16_t* HB = (bf16_t*)(ws + OFF_H);
    pg8::StaticOrder S;
    { volatile LAS unsigned* st0 = (volatile LAS unsigned*)(lds + 131072 + 64); if (threadIdx.x < 2) st0[threadIdx.x] = 0u; }
    __syncthreads();
    const XcdBarrier xbar = xcd_barrier_post((unsigned*)(ws + OFF_BAR), (volatile LAS unsigned*)(lds + 131072 + 64));
#define GS() xcd_barrier(xbar)
    grid.sync();
    unsigned long long tA = 0, tB = 0;
#define STAMP(k) do { if ((k) == PROBE_A) tA = __builtin_amdgcn_s_memrealtime(); if ((k) == PROBE_B) tB = __builtin_amdgcn_s_memrealtime(); } while (0)
    STAMP(0);

    { FRESH() phase_p0(a, lds, gw, NGW, wave, lane); }
    GS(); STAMP(1);
    { S.init(MP / 256, 4096 / 256, G, (int)blockIdx.x, 16, false); pg8::EpiBf16 E{PROJ, 4096};
      pg8::gemm_phase<pg8::EpiBf16, 0>(lds, XB, (const bf16_t*)(ws + OFF_W_INAB), 1024, S, E); }
    if (G == 256 && blockIdx.x >= 80) { FRESH() convert_weights(a, lds, 1, ((int)blockIdx.x - 80) * 8 + wave, 176 * 8, wave, lane); }
    else if (G != 256) { FRESH() convert_weights(a, lds, 1, gw, NGW, wave, lane); }
    GS(); STAMP(2);
    { FRESH() phase_T(a, gw, NGW, lane); }
    GS(); STAMP(3);
    { FRESH() phase_A(a, gw, NGW, lane); }
    GS(); STAMP(4);
    { FRESH() phase_B(a, gt, NGT); }
    GS(); STAMP(5);
    { FRESH() phase_C(a, gw, NGW, lane); }
    GS(); STAMP(6);
    { FRESH() phase_D(a, gw, NGW, lane); }
    GS(); STAMP(7);
    { S.init(MP / 256, 1024 / 256, G, (int)blockIdx.x, 16, true); pg8::EpiRes<0, true> E{XR, a, HB};
      pg8::gemm_phase<pg8::EpiRes<0, true>, 0, true>(lds, XB, (const bf16_t*)(ws + OFF_W_OUTAB), 1024, S, E); }
    GS(); STAMP(8);
    { FRESH() phase_LN<false, true>(a, a.in[21], a.in[22], HB, 4, gw, NGW, lane); }
    GS(); STAMP(9);
#define FFN_PHASES(layer, sid, EXTRA) \
    { S.init(71, DFF / 128, G, (int)blockIdx.x, 16, false); \
      pg8::EpiFFN E{HB, a.in[26] + (size_t)(layer) * 3 * DFF, a.in[27] + (size_t)(layer) * DFF, a.in[6] + (size_t)(layer) * SBAT * 2 * DFF, \
                    a.out + O_FBP + (size_t)(layer) * NB * 2 * DFF, a.out + O_FBS + (size_t)(layer) * SBAT * 2 * DFF}; \
      pg8::gemm_phase<pg8::EpiFFN, 1>(lds, XR - 2 * 1024, (const bf16_t*)(ws + ((layer) ? OFF_W_UP1 : OFF_W_UP0)), 1024, S, E); } \
    EXTRA \
    GS(); STAMP(sid); \
    { S.init(MP / 256, 1024 / 256, G, (int)blockIdx.x, 44, true); pg8::EpiRes<1, true> E{XR, a, (bf16_t*)(ws + OFF_PART)}; \
      pg8::gemm_phase<pg8::EpiRes<1, true>, 0, true>(lds, HB, (const bf16_t*)(ws + ((layer) ? OFF_W_DN1 : OFF_W_DN0)), DFF, S, E); } \
    GS(); STAMP(sid + 1);
#define FFN0_EXTRA if (G == 256 && blockIdx.x >= 26) { FRESH() convert_weights(a, lds, 2, ((int)blockIdx.x - 26) * 8 + wave, 230 * 8, wave, lane); } else if (G != 256) { FRESH() convert_weights(a, lds, 2, gw, NGW, wave, lane); }
    FFN_PHASES(0, 10, FFN0_EXTRA)
    { FRESH() phase_LN<false>(a, a.in[23], a.in[24], (const bf16_t*)(ws + OFF_PART), 11, gw, NGW, lane); }
    GS(); STAMP(12);
    { S.init(MP / 256, 2048 / 256, G, (int)blockIdx.x, 16, false); pg8::EpiBf16 E{HB, 2048};
      pg8::gemm_phase<pg8::EpiBf16, 0>(lds, XR, (const bf16_t*)(ws + OFF_W_INC), 1024, S, E); }
    GS(); STAMP(13);
    { FRESH() phase_F1(a, lds, wave, lane); }
    GS(); STAMP(14);
    { FRESH() phase_F2(a, lds, wave, lane); }
    GS(); STAMP(15);
    { FRESH() phase_F3(a, gw, NGW, lane); }
    GS(); STAMP(16);
    { S.init(MP / 256, 1024 / 256, G, (int)blockIdx.x, 16, true); pg8::EpiRes<1, true> E{XR, a, HB};
      pg8::gemm_phase<pg8::EpiRes<1, true>, 0, true>(lds, XB, (const bf16_t*)(ws + OFF_W_OUTC), 1024, S, E); }
    GS(); STAMP(17);
    { FRESH() phase_LN<false>(a, a.in[21] + 1024, a.in[22] + 1024, HB, 4, gw, NGW, lane); }
    GS(); STAMP(18);
    FFN_PHASES(1, 19, )
    { FRESH() phase_LN<true>(a, a.in[23] + 1024, a.in[24] + 1024, (const bf16_t*)(ws + OFF_PART), 11, gw, NGW, lane); }
#if PROBE_A >= 0
    GS(); STAMP(21);
    if (blockIdx.x == 0 && threadIdx.x == 0) a.out[O_YS] += (float)(tB - tA) * 1e-5f;
#endif
#undef FFN_PHASES
}

extern "C" void kernel_launch(void* const* d_in, const int* in_sizes, int n_in, void* d_out, int out_size, void* d_ws, size_t ws_size, hipStream_t stream) {
    static int grid = 0;
    if (grid == 0) {
        if (n_in != 29 || ws_size < WS_END) { fprintf(stderr, "kernel_launch: unexpected n_in %d / ws %zu\n", n_in, ws_size); grid = -1; return; }
        int dev = 0, cus = 0, per_cu = 0;
        hipGetDevice(&dev); hipDeviceGetAttribute(&cus, hipDeviceAttributeMultiprocessorCount, dev);
        if (hipFuncSetAttribute((const void*)fwd_megakernel, hipFuncAttributeMaxDynamicSharedMemorySize, LDS_BYTES) != hipSuccess) { fprintf(stderr, "kernel_launch: hipFuncSetAttribute failed\n"); grid = -1; return; }
        if (hipOccupancyMaxActiveBlocksPerMultiprocessor(&per_cu, (const void*)fwd_megakernel, 512, LDS_BYTES) != hipSuccess || per_cu < 1) { fprintf(stderr, "kernel_launch: occupancy query says %d\n", per_cu); per_cu = 1; }
        (void)hipGetLastError();
        grid = cus * 1;
    }
    if (grid < 0) return;
    (void)hipMemsetAsync((char*)d_ws + OFF_BAR, 0, 16384, stream);
    Args a{};
    for (int i = 0; i < 29; ++i) a.in[i] = (const float*)d_in[i];
    a.out = (float*)d_out; a.ws = (unsigned char*)d_ws;
    void* args[] = {&a};
    hipError_t e = hipLaunchCooperativeKernel((const void*)fwd_megakernel, dim3(grid), dim3(512), args, LDS_BYTES, stream);
    if (e != hipSuccess) fprintf(stderr, "cooperative launch failed: %s (grid %d)\n", hipGetErrorString(e), grid);
}
```

```cpp
#include <hip/hip_runtime.h>
#include <hip/hip_cooperative_groups.h>
#include <cstdio>
#include <cstdint>
namespace cg = cooperative_groups;
#ifndef PROBE_A
#define PROBE_A -1
#define PROBE_B -1
#endif

#define LAS __attribute__((address_space(3)))
typedef unsigned short bf16_t;
typedef short bf16x8 __attribute__((ext_vector_type(8)));
typedef short bf16x4 __attribute__((ext_vector_type(4)));
typedef float f32x4 __attribute__((ext_vector_type(4)));
typedef float f32x2 __attribute__((ext_vector_type(2)));
typedef unsigned u32x4 __attribute__((ext_vector_type(4)));
typedef unsigned u32x2 __attribute__((ext_vector_type(2)));

constexpr int DM = 1024, LP = 2064, NB = 8, TP = NB * LP, SBAT = 128, TS = SBAT * 8, T = TP + TS, MP = 17664;
constexpr int DFF = 2816;
constexpr int NSUBP = 129, NS_P = NB * NSUBP, NS = NS_P + SBAT;
constexpr int NT_P = NB * NSUBP, NT_S = TS / 16, NTILE = NT_P + NT_S;
constexpr float LN_EPS = 1e-5f;
constexpr float ALPHA = 1.41421356237f;

constexpr size_t O_YP = 0, O_YS = 16777216, O_RETP = 17825792, O_RETS = 18350080, O_HGP = 26738688, O_HGS = 27262976, O_HP = 35651584, O_HS = 35659776,
                 O_CBP = 35790848, O_CBS = 35815424, O_FBP = 36208640, O_FBS = 36298752;

constexpr size_t KiB = 1024, MiB = 1024 * 1024;
constexpr size_t OFF_LBV = 0;
constexpr size_t OFF_C8 = 4 * KiB;
constexpr size_t OFF_W_INC = 1 * MiB;
constexpr size_t OFF_WG = 5 * MiB;
constexpr size_t OFF_W_OUTC = 5 * MiB + 512 * KiB;
constexpr size_t OFF_W_UP1 = 7 * MiB + 512 * KiB;
constexpr size_t OFF_W_DN1 = 18 * MiB + 512 * KiB;
constexpr size_t OFF_XB = 24 * MiB + 4096;
constexpr size_t OFF_BIG = 60 * MiB + 512 * KiB;
constexpr size_t OFF_X32 = OFF_BIG;
constexpr size_t OFF_H = 129 * MiB + 512 * KiB;
constexpr size_t OFF_HL = 198 * MiB + 512 * KiB;
constexpr size_t OFF_G = 198 * MiB + 512 * KiB;
constexpr size_t OFF_GS = 203 * MiB + 256 * KiB;
constexpr size_t OFF_U = 204 * MiB;
constexpr size_t OFF_ROPE = 221 * MiB;
constexpr size_t OFF_TA = 233 * MiB, OFF_TH = 238 * MiB, OFF_CARRY = 243 * MiB;
constexpr size_t OFF_W_INAB = 229 * MiB + 512 * KiB;
constexpr size_t OFF_W_OUTAB = 237 * MiB + 512 * KiB;
constexpr size_t OFF_W_UP0 = 239 * MiB + 512 * KiB;
constexpr size_t OFF_W_DN0 = 250 * MiB + 512 * KiB;
constexpr size_t OFF_PART = 224 * MiB + 512 * KiB;
constexpr size_t WS_END = 256 * MiB;
static_assert(OFF_PART + (size_t)11 * 1152 * 1024 * 2 <= OFF_W_DN0, "part");
static_assert(OFF_XB - 4096 + 36 * MiB + 512 * KiB <= OFF_BIG, "xb");
static_assert((size_t)NS * 8 * 128 * 16 * 2 <= OFF_BIG - OFF_XB, "ktt");
static_assert(OFF_H + (size_t)MP * DFF * 2 <= OFF_W_INAB, "h");
static_assert(OFF_G + (size_t)NS * 8 * 128 * 4 <= OFF_GS, "g");
static_assert(OFF_U + 32 * MiB <= OFF_W_OUTAB, "u");
static_assert(OFF_ROPE + 2072 * 64 * 2 * 4 <= OFF_W_INAB, "rope");
static_assert(OFF_HL + (size_t)T * 1024 * 2 <= OFF_TA, "hl");
static_assert(OFF_CARRY + (size_t)NTILE * 1024 * 4 <= WS_END, "carry");

constexpr int LDS_BYTES = 147456;

typedef __bf16 bf16x2_t __attribute__((ext_vector_type(2)));
__device__ __forceinline__ unsigned cvt_pk(float lo, float hi) { f32x2 v = {lo, hi}; bf16x2_t b = __builtin_convertvector(v, bf16x2_t); return __builtin_bit_cast(unsigned, b); }
__device__ __forceinline__ float bflo(unsigned w) { return __uint_as_float(w << 16); }
__device__ __forceinline__ float bfhi(unsigned w) { return __uint_as_float(w & 0xffff0000u); }
__device__ __forceinline__ float sigmoidf_(float x) { return __builtin_amdgcn_rcpf(1.f + __expf(-x)); }
__device__ __forceinline__ float gelu_tanh(float x) { const float t = x * x; const float e = __builtin_amdgcn_exp2f(x * __builtin_fmaf(t, -0.1029432407f, -2.3022081985f)); return x * __builtin_amdgcn_rcpf(1.f + e); }
__device__ __forceinline__ float wave_sum(float v) {
#pragma unroll
    for (int o = 1; o < 64; o <<= 1) v += __shfl_xor(v, o);
    return v;
}
__device__ __forceinline__ float ror1(float v) { return __int_as_float(__builtin_amdgcn_update_dpp(0, __float_as_int(v), 0x121, 0xf, 0xf, false)); }
__device__ __forceinline__ float ror2(float v) { return __int_as_float(__builtin_amdgcn_update_dpp(0, __float_as_int(v), 0x122, 0xf, 0xf, false)); }
__device__ __forceinline__ f32x4 mfma32(bf16x8 a, bf16x8 b, f32x4 c) { return __builtin_amdgcn_mfma_f32_16x16x32_bf16(a, b, c, 0, 0, 0); }
__device__ __forceinline__ f32x4 mfma16(bf16x4 a, bf16x4 b, f32x4 c) { const bf16x8 a8 = (bf16x8){a[0], a[1], a[2], a[3], 0, 0, 0, 0}, b8 = (bf16x8){b[0], b[1], b[2], b[3], 0, 0, 0, 0}; return __builtin_amdgcn_mfma_f32_16x16x32_bf16(a8, b8, c, 0, 0, 0); }
__device__ __forceinline__ bf16x4 pack4(f32x4 v) { u32x2 w; w.x = cvt_pk(v[0], v[1]); w.y = cvt_pk(v[2], v[3]); return __builtin_bit_cast(bf16x4, w); }
__device__ __forceinline__ bf16x8 pack8(f32x4 a, f32x4 b) { u32x4 w; w.x = cvt_pk(a[0], a[1]); w.y = cvt_pk(a[2], a[3]); w.z = cvt_pk(b[0], b[1]); w.w = cvt_pk(b[2], b[3]); return __builtin_bit_cast(bf16x8, w); }

struct Args { const float* in[29]; float* out; unsigned char* ws; };

__device__ __forceinline__ const float* xsrc_row(const Args& a, int row) {
    if (row < TP) { const int b = row / LP, t = row - b * LP; return t < 16 ? a.in[7] + (size_t)t * DM : a.in[0] + ((size_t)b * 2048 + (t - 16)) * DM; }
    return a.in[1] + (size_t)(row - TP) * DM;
}

namespace pg8 {
constexpr int BM = 256, BK = 64, HALF = 128, HTB = HALF * BK * 2, STAGE_BYTES = 8 * HTB, NXCD = 8, WGM = 8;
__device__ __forceinline__ int lds_byte(int r, int c) { const int st = (r >> 4) * 2 + (c >> 5), rr = r & 15, cc = c & 31, ob = rr * 64 + cc * 2; return st * 1024 + (ob ^ (((ob >> 9) & 1) << 5)); }
__device__ __forceinline__ void stage_rc(int b, int& R, int& C) { const int st = b / 1024, sb = b % 1024, swz = sb ^ (((sb >> 9) & 1) << 5); R = (st >> 1) * 16 + swz / 64; C = (st & 1) * 32 + (swz % 64) / 2; }
__device__ __forceinline__ int perm32(int rho) { const int n = rho >> 4, i = rho & 15; return 8 * (i >> 2) + 4 * n + (i & 3); }
struct Unit { int pm, pn, k0, nt, split; };
struct StaticOrder {
    int nM, nN, nwg, G, c, ntf, nfull, nsub, nsplit;
    __device__ __forceinline__ void init(int nM_, int nN_, int G_, int c_, int ntf_, bool SPLIT) { nM = nM_; nN = nN_; nwg = nM * nN; G = G_; c = c_; ntf = ntf_;
        nfull = nwg; nsub = 0; nsplit = 1;
        if (SPLIT && G == 256 && nN == 4 && nM > 64) { nsplit = ntf / 4; nfull = 256; nsub = (nM - 64) * 4 * nsplit; nM = 64; nwg = 256; } }
    __device__ __forceinline__ bool next(int i, Unit& u) const {
        const int L = i * G + c;
        const bool sub = L >= nfull; const int s = L - nfull;
        if (sub && s >= nsub) return false;
        int wgid = sub ? 0 : L;
        { const int q = nwg / NXCD, r = nwg % NXCD, xcd = wgid % NXCD, off = wgid / NXCD; wgid = (xcd < r ? xcd * (q + 1) : r * (q + 1) + (xcd - r) * q) + off; }
        const int nig = WGM * nN, gid = wgid / nig, fm = gid * WGM, gsz = (nM - fm) < WGM ? (nM - fm) : WGM;
        const int pm_f = fm + ((wgid % nig) % gsz), pn_f = (wgid % nig) / gsz;
        const int tl = s / nsplit, ks = s - tl * nsplit;
        u.pm = sub ? 64 + (tl >> 2) : pm_f; u.pn = sub ? (tl & 3) : pn_f; u.k0 = sub ? ks * 4 : 0; u.nt = sub ? 4 : ntf; u.split = sub ? 1 : 0;
        return true;
    }
};

template <class Epi, int AMODE, bool SPLIT = false>
__device__ __forceinline__ void gemm_phase(LAS unsigned char* lds, const bf16_t* Abase, const bf16_t* Btbase, const int K, const StaticOrder& S, const Epi& E) {
    int tid = threadIdx.x; asm volatile("" : "+v"(tid));
    const int wid = __builtin_amdgcn_readfirstlane(tid >> 6), lane = tid & 63, wr = wid >> 2, wc = wid & 3, fr = lane & 15, fq = lane >> 4;
    unsigned voffA[2], voffB[2];
#pragma unroll
    for (int i = 0; i < 2; ++i) { int R, C; stage_rc(tid * 16 + i * 8192, R, C); const int Rb = Epi::PERM ? ((R & ~31) + perm32(R & 31)) : R;
        const int Ra = AMODE ? (R < 64 ? R : R - 2) : R;
        voffA[i] = (unsigned)(Ra * K + C) * 2u; voffB[i] = (unsigned)(Rb * K + C) * 2u; }
    const size_t kstep = (size_t)(BK * 2);
    const size_t hstepB = (size_t)HALF * K * 2, tstepB = 2 * hstepB;
    const size_t hstepA = (size_t)(AMODE ? 124 : 128) * K * 2, tstepA = 2 * hstepA;
    const unsigned ldsw = (unsigned)wid * 1024u;
    const int aoff = lds_byte(wr * 64 + fr, fq * 8), boff = lds_byte(wc * 32 + fr, fq * 8);
#define PG8_SA(b, h) (((b) * 2 + (h)) * HTB)
#define PG8_SB(b, h) ((4 + (b) * 2 + (h)) * HTB)
#define PG8_STAGE(bufoff, gbase, voff) do { _Pragma("unroll") for (int _i = 0; _i < 2; ++_i) \
        __builtin_amdgcn_global_load_lds((const unsigned*)((const char*)(gbase) + (voff)[_i]), (LAS unsigned*)(lds + (bufoff) + ldsw + _i * 8192), 16, 0, 0); } while (0)
#define PG8_LDA(dst, b, h) do { _Pragma("unroll") for (int m = 0; m < 4; ++m) _Pragma("unroll") for (int k = 0; k < 2; ++k) dst[m][k] = *(const LAS bf16x8*)(lds + PG8_SA(b, h) + aoff + m * 2048 + k * 1024); } while (0)
#define PG8_LDB(dst, b, h) do { _Pragma("unroll") for (int n = 0; n < 2; ++n) _Pragma("unroll") for (int k = 0; k < 2; ++k) dst[n][k] = *(const LAS bf16x8*)(lds + PG8_SB(b, h) + boff + n * 2048 + k * 1024); } while (0)
#define PG8_MMA(ai, bj, At, Bt) do { __builtin_amdgcn_s_setprio(1); _Pragma("unroll") for (int m = 0; m < 4; ++m) _Pragma("unroll") for (int n = 0; n < 2; ++n) _Pragma("unroll") for (int k = 0; k < 2; ++k) \
        acc[ai][bj][m][n] = __builtin_amdgcn_mfma_f32_16x16x32_bf16(Bt[n][k], At[m][k], acc[ai][bj][m][n], 0, 0, 0); __builtin_amdgcn_s_setprio(0); } while (0)
#define PG8_WAIT_V(n) asm volatile("s_waitcnt vmcnt(" #n ")" ::: "memory")
#define PG8_WAIT_L(n) asm volatile("s_waitcnt lgkmcnt(" #n ")" ::: "memory")
#define PG8_BAR __builtin_amdgcn_s_barrier()
#define PG8_SCHED __builtin_amdgcn_sched_barrier(0)
    Unit cur, nxt; int ui = 0;
    if (!S.next(0, cur)) return;
    f32x4 acc[2][2][4][2];
#pragma unroll
    for (int a = 0; a < 2; ++a)
#pragma unroll
        for (int b = 0; b < 2; ++b)
#pragma unroll
            for (int m = 0; m < 4; ++m)
#pragma unroll
                for (int n = 0; n < 2; ++n) acc[a][b][m][n] = (f32x4){0.f, 0.f, 0.f, 0.f};
    bf16x8 At[4][2], B0[2][2], B1[2][2];
    const char* cA = (const char*)Abase + (size_t)cur.pm * tstepA + (SPLIT ? (size_t)cur.k0 * kstep : 0); const char* cB = (const char*)Btbase + (size_t)cur.pn * tstepB + (SPLIT ? (size_t)cur.k0 * kstep : 0);
    PG8_STAGE(PG8_SB(0, 0), cB, voffB); PG8_STAGE(PG8_SA(0, 0), cA, voffA); PG8_STAGE(PG8_SB(0, 1), cB + hstepB, voffB); PG8_STAGE(PG8_SA(0, 1), cA + hstepA, voffA);
    if (wr == 1) PG8_BAR;
    PG8_WAIT_V(4); PG8_BAR;
    PG8_STAGE(PG8_SB(1, 0), cB + kstep, voffB); PG8_STAGE(PG8_SA(1, 0), cA + kstep, voffA); PG8_STAGE(PG8_SB(1, 1), cB + hstepB + kstep, voffB);
    PG8_WAIT_V(6); PG8_BAR;
    for (;;) {
        const bool has_next = S.next(ui + 1, nxt);
        const char* nA = has_next ? (const char*)Abase + (size_t)nxt.pm * tstepA + (SPLIT ? (size_t)nxt.k0 * kstep : 0) : cA; const char* nB = has_next ? (const char*)Btbase + (size_t)nxt.pn * tstepB + (SPLIT ? (size_t)nxt.k0 * kstep : 0) : cB;
        const int nt = SPLIT ? cur.nt : K / BK;
        for (int t = 0; t < nt; t += 2) {
            const bool last = (t == nt - 2);
            const char* a1 = cA + (size_t)(t + 1) * kstep;
            const char* a2 = last ? nA : cA + (size_t)(t + 2) * kstep; const char* b2 = last ? nB : cB + (size_t)(t + 2) * kstep;
            const char* a3 = a2 + kstep; const char* b3 = b2 + kstep;
            PG8_LDB(B0, 0, 0); PG8_SCHED; PG8_LDA(At, 0, 0); PG8_STAGE(PG8_SA(1, 1), a1 + hstepA, voffA);
            PG8_WAIT_L(8); PG8_BAR; PG8_WAIT_L(0); PG8_MMA(0, 0, At, B0); PG8_BAR; PG8_SCHED;
            PG8_LDB(B1, 0, 1); PG8_STAGE(PG8_SB(0, 0), b2, voffB);
            PG8_BAR; PG8_WAIT_L(0); PG8_MMA(0, 1, At, B1); PG8_BAR;
            PG8_LDA(At, 0, 1); PG8_STAGE(PG8_SA(0, 0), a2, voffA);
            PG8_BAR; PG8_WAIT_L(0); PG8_MMA(1, 0, At, B0); PG8_BAR; PG8_SCHED;
            PG8_STAGE(PG8_SB(0, 1), b2 + hstepB, voffB);
            PG8_WAIT_V(6); PG8_BAR; PG8_MMA(1, 1, At, B1); PG8_BAR;
            PG8_LDB(B0, 1, 0); PG8_SCHED; PG8_LDA(At, 1, 0); PG8_STAGE(PG8_SA(0, 1), a2 + hstepA, voffA);
            PG8_WAIT_L(8); PG8_BAR; PG8_WAIT_L(0); PG8_MMA(0, 0, At, B0); PG8_BAR; PG8_SCHED;
            PG8_LDB(B1, 1, 1); PG8_STAGE(PG8_SB(1, 0), b3, voffB);
            PG8_BAR; PG8_WAIT_L(0); PG8_MMA(0, 1, At, B1); PG8_BAR;
            PG8_LDA(At, 1, 1); PG8_STAGE(PG8_SA(1, 0), a3, voffA);
            PG8_BAR; PG8_WAIT_L(0); PG8_MMA(1, 0, At, B0); PG8_BAR; PG8_SCHED;
            PG8_STAGE(PG8_SB(1, 1), b3 + hstepB, voffB);
            PG8_WAIT_V(6); PG8_BAR; PG8_MMA(1, 1, At, B1); PG8_BAR;
        }
        E(acc, cur, wr, wc, fr, fq);
        if (!has_next) break;
#pragma unroll
        for (int a = 0; a < 2; ++a)
#pragma unroll
            for (int b = 0; b < 2; ++b)
#pragma unroll
                for (int m = 0; m < 4; ++m)
#pragma unroll
                    for (int n = 0; n < 2; ++n) acc[a][b][m][n] = (f32x4){0.f, 0.f, 0.f, 0.f};
        cur = nxt; cA = nA; cB = nB; ++ui;
    }
    PG8_WAIT_V(0);
    if (wr == 0) PG8_BAR;
    PG8_BAR;
#undef PG8_SA
#undef PG8_SB
#undef PG8_STAGE
#undef PG8_LDA
#undef PG8_LDB
#undef PG8_MMA
#undef PG8_WAIT_V
#undef PG8_WAIT_L
#undef PG8_BAR
#undef PG8_SCHED
}

struct EpiBf16 {
    static constexpr bool PERM = true;
    bf16_t* O; int ldc;
    __device__ __forceinline__ void operator()(const f32x4 (&acc)[2][2][4][2], const Unit& u, int wr, int wc, int fr, int fq) const {
        const int row0 = u.pm * BM + wr * 64 + fr, col0 = u.pn * BM + wc * 32 + 8 * fq;
#pragma unroll
        for (int ai = 0; ai < 2; ++ai)
#pragma unroll
            for (int m = 0; m < 4; ++m) { bf16_t* rowp = O + (size_t)(row0 + ai * HALF + m * 16) * ldc + col0;
#pragma unroll
                for (int bj = 0; bj < 2; ++bj) { const f32x4 v0 = acc[ai][bj][m][0], v1 = acc[ai][bj][m][1];
                    u32x4 w; w.x = cvt_pk(v0[0], v0[1]); w.y = cvt_pk(v0[2], v0[3]); w.z = cvt_pk(v1[0], v1[1]); w.w = cvt_pk(v1[2], v1[3]);
                    *(u32x4*)(rowp + bj * HALF) = w; } }
    }
};
template <int MODE, bool SPLIT> struct EpiRes {
    static constexpr bool PERM = false;
    bf16_t* Y; Args a; bf16_t* PART;
    __device__ __forceinline__ void operator()(const f32x4 (&acc)[2][2][4][2], const Unit& u, int wr, int wc, int fr, int fq) const {
        const int row0 = u.pm * BM + wr * 64 + fr, col0 = u.pn * BM + wc * 32 + 4 * fq;
#pragma unroll
        for (int ai = 0; ai < 2; ++ai)
#pragma unroll
            for (int m = 0; m < 4; ++m) { const int row = row0 + ai * HALF + m * 16;
                if (row < T) { bf16_t* yp = Y + (size_t)row * DM + col0;
                    if (SPLIT && u.split) { bf16_t* pp = PART + ((size_t)(u.k0 >> 2) * 1152 + (row - 16384)) * DM + col0;
#pragma unroll
                        for (int bj = 0; bj < 2; ++bj)
#pragma unroll
                            for (int n = 0; n < 2; ++n) { const f32x4 v = acc[ai][bj][m][n]; u32x2 w; w.x = cvt_pk(v[0], v[1]); w.y = cvt_pk(v[2], v[3]); *(u32x2*)(pp + bj * HALF + n * 16) = w; }
                    } else if (MODE == 0) { const float* rp = xsrc_row(a, row) + col0;
#pragma unroll
                        for (int bj = 0; bj < 2; ++bj)
#pragma unroll
                            for (int n = 0; n < 2; ++n) { const f32x4 v = *(const f32x4*)(rp + bj * HALF + n * 16) * ALPHA + acc[ai][bj][m][n];
                                u32x2 w; w.x = cvt_pk(v[0], v[1]); w.y = cvt_pk(v[2], v[3]); *(u32x2*)(yp + bj * HALF + n * 16) = w; }
                    } else {
#pragma unroll
                        for (int bj = 0; bj < 2; ++bj)
#pragma unroll
                            for (int n = 0; n < 2; ++n) { const u32x2 r = *(const u32x2*)(yp + bj * HALF + n * 16);
                                const f32x4 v = (f32x4){bflo(r.x), bfhi(r.x), bflo(r.y), bfhi(r.y)} * ALPHA + acc[ai][bj][m][n];
                                u32x2 w; w.x = cvt_pk(v[0], v[1]); w.y = cvt_pk(v[2], v[3]); *(u32x2*)(yp + bj * HALF + n * 16) = w; }
                    } } }
    }
};
struct EpiFFN {
    static constexpr bool PERM = true;
    bf16_t* H; const float* cw; const float* cbias; const float* sbuf; float* out_p; float* out_s;
    __device__ __forceinline__ void operator()(const f32x4 (&acc)[2][2][4][2], const Unit& u, int wr, int wc, int fr, int fq) const {
        const int colb = u.pn * 128 + wc * 32 + 8 * fq;
        f32x4 w0[2], w1[2], w2[2], cbv[2];
#pragma unroll
        for (int n = 0; n < 2; ++n) { w0[n] = *(const f32x4*)(cw + colb + 4 * n); w1[n] = *(const f32x4*)(cw + DFF + colb + 4 * n); w2[n] = *(const f32x4*)(cw + 2 * DFF + colb + 4 * n); cbv[n] = *(const f32x4*)(cbias + colb + 4 * n); }
#pragma unroll
        for (int ai = 0; ai < 2; ++ai) {
            const int base = u.pm * 248 + ai * 124 + wr * 62 - 2;
#pragma unroll
            for (int m = 0; m < 4; ++m) {
                const int rb = 16 * m + fr, gr = base + rb;
                f32x4 cur[2], p1[2], p2[2];
#pragma unroll
                for (int n = 0; n < 2; ++n) { cur[n] = acc[ai][0][m][n];
#pragma unroll
                    for (int j = 0; j < 4; ++j) {
                        float b1 = 0.f, b2 = 0.f;
                        if (m > 0) { b1 = ror1(acc[ai][0][m > 0 ? m - 1 : 0][n][j]); b2 = ror2(acc[ai][0][m > 0 ? m - 1 : 0][n][j]); }
                        p1[n][j] = __int_as_float(__builtin_amdgcn_update_dpp(__float_as_int(b1), __float_as_int(cur[n][j]), 0x111, 0xf, 0xf, false));
                        p2[n][j] = __int_as_float(__builtin_amdgcn_update_dpp(__float_as_int(b2), __float_as_int(cur[n][j]), 0x112, 0xf, 0xf, false)); } }
                if (rb >= 2 && gr < T) {
                    const bool smp = gr >= TP; int b, t;
                    if (!smp) { b = gr / LP; t = gr - b * LP; } else { b = (gr - TP) >> 3; t = (gr - TP) & 7; }
                    if (t < 2) {
#pragma unroll
                        for (int n = 0; n < 2; ++n) { f32x4 q0 = (f32x4){0.f, 0.f, 0.f, 0.f}, q1 = q0;
                            if (smp) { q0 = *(const f32x4*)(sbuf + ((size_t)b * 2 + 0) * DFF + colb + 4 * n); q1 = *(const f32x4*)(sbuf + ((size_t)b * 2 + 1) * DFF + colb + 4 * n); }
                            if (t == 0) { p2[n] = q0; p1[n] = q1; } else { p2[n] = q1; } }
                    }
                    f32x4 hv[2];
#pragma unroll
                    for (int n = 0; n < 2; ++n) { const f32x4 y = cbv[n] + w0[n] * p2[n] + w1[n] * p1[n] + w2[n] * cur[n]; const f32x4 v = acc[ai][1][m][n];
#pragma unroll
                        for (int j = 0; j < 4; ++j) hv[n][j] = gelu_tanh(y[j]) * v[j]; }
                    u32x4 w; w.x = cvt_pk(hv[0][0], hv[0][1]); w.y = cvt_pk(hv[0][2], hv[0][3]); w.z = cvt_pk(hv[1][0], hv[1][1]); w.w = cvt_pk(hv[1][2], hv[1][3]);
                    *(u32x4*)(H + (size_t)gr * DFF + colb) = w;
                    const int L = smp ? 8 : LP;
                    if (t >= L - 2) { float* o = (smp ? out_s : out_p) + ((size_t)b * 2 + (t - (L - 2))) * DFF + colb; *(f32x4*)o = cur[0]; *(f32x4*)(o + 4) = cur[1]; }
                }
            }
        }
    }
};
}

__device__ __forceinline__ void p0_transpose_item(const float* W, int K, int N, bf16_t* WT, bool upmap, LAS float* scr, int item, int lane) {
    const int nblk = N / 32, kb = item / nblk, nb = item % nblk, k0 = 64 * kb, n0 = 32 * nb;
#pragma unroll 8
    for (int i = 0; i < 32; ++i) { const int kk = 2 * i + (lane >> 5); scr[kk * 33 + (lane & 31)] = W[(size_t)(k0 + kk) * N + n0 + (lane & 31)]; }
    asm volatile("s_waitcnt lgkmcnt(0)" ::: "memory");
    int r0 = n0;
    if (upmap) { r0 = n0 < DFF ? (n0 / 128) * 256 + (n0 % 128) : ((n0 - DFF) / 128) * 256 + 128 + ((n0 - DFF) % 128); }
    const int c = lane & 7;
#pragma unroll
    for (int j = 0; j < 4; ++j) { const int n = (lane >> 3) + 8 * j; const LAS float* s = scr + (8 * c) * 33 + n;
        u32x4 o; o.x = cvt_pk(s[0 * 33], s[1 * 33]); o.y = cvt_pk(s[2 * 33], s[3 * 33]); o.z = cvt_pk(s[4 * 33], s[5 * 33]); o.w = cvt_pk(s[6 * 33], s[7 * 33]);
        *(u32x4*)(WT + (size_t)(r0 + n) * K + k0 + 8 * c) = o; }
    asm volatile("s_waitcnt lgkmcnt(0)" ::: "memory");
}

__device__ __forceinline__ void convert_weights(const Args& a, LAS unsigned char* lds, int set, int widx, int nw, int wave, int lane) {
    unsigned char* ws = a.ws;
    LAS float* scr = (LAS float*)(lds + wave * 16384);
    constexpr int I0 = 16 * 128, I1 = 16 * 32, I2 = 16 * 64, I3 = 16 * 8, I4 = 16 * 32, I5 = 16 * 176, I6 = 44 * 32;
    if (set == 0) {
        for (int r = widx; r < I0; r += nw) p0_transpose_item(a.in[8], 1024, 4096, (bf16_t*)(ws + OFF_W_INAB), false, scr, r, lane);
    } else if (set == 1) {
        for (int it = widx; it < I1 + I5 + I6; it += nw) { int r = it;
            if (r < I1) { p0_transpose_item(a.in[9], 1024, 1024, (bf16_t*)(ws + OFF_W_OUTAB), false, scr, r, lane); continue; } r -= I1;
            if (r < I5) { p0_transpose_item(a.in[25], 1024, 5632, (bf16_t*)(ws + OFF_W_UP0), true, scr, r, lane); continue; } r -= I5;
            p0_transpose_item(a.in[28], 2816, 1024, (bf16_t*)(ws + OFF_W_DN0), false, scr, r, lane); }
    } else {
        for (int it = widx; it < I2 + I3 + I4 + I5 + I6; it += nw) { int r = it;
            if (r < I2) { p0_transpose_item(a.in[12], 1024, 2048, (bf16_t*)(ws + OFF_W_INC), false, scr, r, lane); continue; } r -= I2;
            if (r < I3) { const int mat = r >> 3, sub = r & 7, n = mat >> 1, gate = mat & 1;
                p0_transpose_item(a.in[gate ? 17 : 15] + (size_t)n * 16384, 128, 128, (bf16_t*)(ws + OFF_WG) + (size_t)(n * 2 + gate) * 16384, false, scr, sub, lane); continue; } r -= I3;
            if (r < I4) { p0_transpose_item(a.in[20], 1024, 1024, (bf16_t*)(ws + OFF_W_OUTC), false, scr, r, lane); continue; } r -= I4;
            if (r < I5) { p0_transpose_item(a.in[25] + (size_t)1024 * 5632, 1024, 5632, (bf16_t*)(ws + OFF_W_UP1), true, scr, r, lane); continue; } r -= I5;
            p0_transpose_item(a.in[28] + (size_t)2816 * 1024, 2816, 1024, (bf16_t*)(ws + OFF_W_DN1), false, scr, r, lane); }
    }
}
__device__ __forceinline__ void phase_p0(const Args& a, LAS unsigned char* lds, int gw, int NGW, int wave, int lane) {
    unsigned char* ws = a.ws;
    convert_weights(a, lds, 0, gw, NGW, wave, lane);
    bf16_t* XB = (bf16_t*)(ws + OFF_XB);
    for (int row0 = gw; row0 < T; row0 += 4 * NGW) {
        f32x4 v[4][4];
#pragma unroll
        for (int q = 0; q < 4; ++q) { const int row = row0 + q * NGW; if (row < T) { const f32x4* xr = (const f32x4*)xsrc_row(a, row) + lane;
#pragma unroll
            for (int j = 0; j < 4; ++j) v[q][j] = xr[64 * j]; } }
#pragma unroll
        for (int q = 0; q < 4; ++q) { const int row = row0 + q * NGW; if (row < T) { u32x2* o = (u32x2*)(XB + (size_t)row * DM) + lane;
#pragma unroll
            for (int j = 0; j < 4; ++j) { u32x2 w; w.x = cvt_pk(v[q][j][0], v[q][j][1]); w.y = cvt_pk(v[q][j][2], v[q][j][3]); o[64 * j] = w; } } }
    }
    const int gt = gw * 64 + lane, NGT = NGW * 64;
    float* ROPE = (float*)(ws + OFF_ROPE);
    for (int e = gt; e < 2072 * 64; e += NGT) {
        const int pi = e >> 6, i = e & 63; const int pos = pi < 2064 ? pi : 16384 + (pi - 2064);
        const float inv = (float)exp(-(double)i * (9.210340371976184 / 64.0));
        const float ang = (float)pos * inv;
        double rev = (double)ang * 0.15915494309189535; rev -= rint(rev);
        const float r = (float)(rev * 6.283185307179586);
        ROPE[2 * e] = cosf(r); ROPE[2 * e + 1] = sinf(r);
    }
    if (gt < 512) { const float* lg = a.in[10]; const float l0 = lg[gt], l1 = lg[512 + gt], l2 = lg[1024 + gt]; const float mx = fmaxf(l0, fmaxf(l1, l2));
        const float e0 = expf(l0 - mx), e1 = expf(l1 - mx), e2 = expf(l2 - mx); ((float*)(ws + OFF_LBV))[gt] = e0 / (e0 + e1 + e2); }
    if (gt < 1024) { const float lam = a.in[19][gt]; ((float*)(ws + OFF_C8))[gt] = -8.f * (lam > 0.f ? log1pf(expf(-lam)) : (log1pf(expf(lam)) - lam)); }
}

__device__ __forceinline__ void sub_geom(int s, int& row0, int& ntok, int& pidx0) {
    if (s < NS_P) { const int b = s / NSUBP, j = s - b * NSUBP; row0 = b * LP + 16 * j; ntok = 16; pidx0 = 16 * j; }
    else { const int b = s - NS_P; row0 = TP + 8 * b; ntok = 8; pidx0 = 2064; }
}

__device__ __forceinline__ void t_load(const bf16_t* PROJ, int it, int lane, unsigned (&qa)[8], unsigned (&qb)[8], unsigned (&ka)[8], unsigned (&kb)[8], unsigned (&va)[8], unsigned (&vb)[8]) {
    const int c2 = lane & 31, th = lane >> 5, ca = 2 * c2, cb = ca + 64;
    const int s = it >> 3, h = it & 7; int row0, ntok, pidx0; sub_geom(s, row0, ntok, pidx0);
    const bool ret = h < 4; const int hh = h & 3;
    const int qc = (ret ? 0 : 2048) + 128 * hh, kc = (ret ? 512 : 2560) + 128 * hh, vc = (ret ? 1024 : 3072) + 128 * hh;
    const bool act = 8 * th < ntok;
#pragma unroll
    for (int ii = 0; ii < 8; ++ii) { qa[ii] = qb[ii] = ka[ii] = kb[ii] = va[ii] = vb[ii] = 0u;
        if (act) { const bf16_t* p = PROJ + (size_t)(row0 + 8 * th + ii) * 4096;
            qa[ii] = *(const unsigned*)(p + qc + ca); qb[ii] = *(const unsigned*)(p + qc + cb);
            ka[ii] = *(const unsigned*)(p + kc + ca); kb[ii] = *(const unsigned*)(p + kc + cb);
            va[ii] = *(const unsigned*)(p + vc + ca); vb[ii] = *(const unsigned*)(p + vc + cb); } }
}
__device__ __forceinline__ void phase_T(const Args& a, int gw, int NGW, int lane) {
    unsigned char* ws = a.ws;
    bf16_t* PROJ = (bf16_t*)(ws + OFF_BIG); bf16_t* KTT = (bf16_t*)(ws + OFF_XB); float* G = (float*)(ws + OFF_G);
    const float* ROPE = (const float*)(ws + OFF_ROPE); const float* LBV = (const float*)(ws + OFF_LBV);
    const int c2 = lane & 31, th = lane >> 5, ca = 2 * c2, cb = ca + 64;
    unsigned qa[8], qb[8], ka[8], kb[8], va[8], vb[8], qan[8], qbn[8], kan[8], kbn[8], van[8], vbn[8];
    if (gw < NS * 8) t_load(PROJ, gw, lane, qa, qb, ka, kb, va, vb);
    for (int it = gw; it < NS * 8; it += NGW) {
        if (it + NGW < NS * 8) t_load(PROJ, it + NGW, lane, qan, qbn, kan, kbn, van, vbn);
        const int s = it >> 3, h = it & 7; int row0, ntok, pidx0; sub_geom(s, row0, ntok, pidx0);
        const bool ret = h < 4; const int hh = h & 3;
        const int qc = (ret ? 0 : 2048) + 128 * hh, kc = (ret ? 512 : 2560) + 128 * hh, vc = (ret ? 1024 : 3072) + 128 * hh;
        const bool act = 8 * th < ntok;
        unsigned kta[8], ktb[8];
        float g0, g1, g2, g3;
        if (ret) {
            const float lf = log1pf(-exp2f(-5.f - (float)hh));
            g0 = g1 = g2 = g3 = __expf(lf * (float)ntok);
#pragma unroll
            for (int ii = 0; ii < 8; ++ii) {
                kta[ii] = 0u; ktb[ii] = 0u;
                if (act) {
                    const int i = 8 * th + ii; const f32x4 cs = *(const f32x4*)(ROPE + ((size_t)(pidx0 + i) * 64 + ca) * 2);
                    const float eq = __expf(lf * (float)(i + 1)), ek = __expf(-lf * (float)(i + 1)) * 0.08838834764831845f;
                    const float q1l = bflo(qa[ii]), q1h = bfhi(qa[ii]), q2l = bflo(qb[ii]), q2h = bfhi(qb[ii]);
                    const float k1l = bflo(ka[ii]), k1h = bfhi(ka[ii]), k2l = bflo(kb[ii]), k2h = bfhi(kb[ii]);
                    const unsigned qoa = cvt_pk((q1l * cs[0] - q2l * cs[1]) * eq, (q1h * cs[2] - q2h * cs[3]) * eq);
                    const unsigned qob = cvt_pk((q1l * cs[1] + q2l * cs[0]) * eq, (q1h * cs[3] + q2h * cs[2]) * eq);
                    kta[ii] = cvt_pk((k1l * cs[0] - k2l * cs[1]) * ek, (k1h * cs[2] - k2h * cs[3]) * ek);
                    ktb[ii] = cvt_pk((k1l * cs[1] + k2l * cs[0]) * ek, (k1h * cs[3] + k2h * cs[2]) * ek);
                    bf16_t* p = PROJ + (size_t)(row0 + i) * 4096;
                    *(unsigned*)(p + qc + ca) = qoa; *(unsigned*)(p + qc + cb) = qob; *(unsigned*)(p + kc + ca) = kta[ii]; *(unsigned*)(p + kc + cb) = ktb[ii];
                }
            }
        } else {
            const f32x2 lba = *(const f32x2*)(LBV + 128 * hh + ca), lbb = *(const f32x2*)(LBV + 128 * hh + cb);
            float lfv[8][4], kv[8][4]; float t0 = 0.f, t1 = 0.f, t2 = 0.f, t3 = 0.f;
#pragma unroll
            for (int ii = 0; ii < 8; ++ii) {
                const float f0 = lba.x + (1.f - lba.x) * sigmoidf_(bflo(ka[ii])), f1 = lba.y + (1.f - lba.y) * sigmoidf_(bfhi(ka[ii]));
                const float f2 = lbb.x + (1.f - lbb.x) * sigmoidf_(bflo(kb[ii])), f3 = lbb.y + (1.f - lbb.y) * sigmoidf_(bfhi(kb[ii]));
                lfv[ii][0] = act ? __logf(f0) : 0.f; lfv[ii][1] = act ? __logf(f1) : 0.f; lfv[ii][2] = act ? __logf(f2) : 0.f; lfv[ii][3] = act ? __logf(f3) : 0.f;
                kv[ii][0] = 1.f - f0; kv[ii][1] = 1.f - f1; kv[ii][2] = 1.f - f2; kv[ii][3] = 1.f - f3;
                t0 += lfv[ii][0]; t1 += lfv[ii][1]; t2 += lfv[ii][2]; t3 += lfv[ii][3];
            }
            const float o0 = __shfl_xor(t0, 32), o1 = __shfl_xor(t1, 32), o2 = __shfl_xor(t2, 32), o3 = __shfl_xor(t3, 32);
            float r0 = th ? o0 : 0.f, r1 = th ? o1 : 0.f, r2 = th ? o2 : 0.f, r3 = th ? o3 : 0.f;
            g0 = __expf(t0 + o0); g1 = __expf(t1 + o1); g2 = __expf(t2 + o2); g3 = __expf(t3 + o3);
#pragma unroll
            for (int ii = 0; ii < 8; ++ii) {
                kta[ii] = 0u; ktb[ii] = 0u;
                r0 += lfv[ii][0]; r1 += lfv[ii][1]; r2 += lfv[ii][2]; r3 += lfv[ii][3];
                if (act) {
                    const float e0 = __expf(r0), e1 = __expf(r1), e2 = __expf(r2), e3 = __expf(r3);
                    const unsigned qoa = cvt_pk(bflo(qa[ii]) * e0, bfhi(qa[ii]) * e1), qob = cvt_pk(bflo(qb[ii]) * e2, bfhi(qb[ii]) * e3);
                    kta[ii] = cvt_pk(kv[ii][0] * __builtin_amdgcn_rcpf(e0), kv[ii][1] * __builtin_amdgcn_rcpf(e1));
                    ktb[ii] = cvt_pk(kv[ii][2] * __builtin_amdgcn_rcpf(e2), kv[ii][3] * __builtin_amdgcn_rcpf(e3));
                    bf16_t* p = PROJ + (size_t)(row0 + 8 * th + ii) * 4096;
                    *(unsigned*)(p + qc + ca) = qoa; *(unsigned*)(p + qc + cb) = qob; *(unsigned*)(p + kc + ca) = kta[ii]; *(unsigned*)(p + kc + cb) = ktb[ii];
                }
            }
        }
        u32x4 kA0, kA1, kB0, kB1, vA0, vA1, vB0, vB1;
#pragma unroll
        for (int w = 0; w < 4; ++w) {
            kA0[w] = (kta[2 * w] & 0xffffu) | (kta[2 * w + 1] << 16); kA1[w] = (kta[2 * w] >> 16) | (kta[2 * w + 1] & 0xffff0000u);
            kB0[w] = (ktb[2 * w] & 0xffffu) | (ktb[2 * w + 1] << 16); kB1[w] = (ktb[2 * w] >> 16) | (ktb[2 * w + 1] & 0xffff0000u);
            vA0[w] = (va[2 * w] & 0xffffu) | (va[2 * w + 1] << 16); vA1[w] = (va[2 * w] >> 16) | (va[2 * w + 1] & 0xffff0000u);
            vB0[w] = (vb[2 * w] & 0xffffu) | (vb[2 * w + 1] << 16); vB1[w] = (vb[2 * w] >> 16) | (vb[2 * w + 1] & 0xffff0000u);
        }
        bf16_t* kt = KTT + (size_t)(s * 8 + h) * 2048 + 8 * th;
        *(u32x4*)(kt + ca * 16) = kA0; *(u32x4*)(kt + (ca + 1) * 16) = kA1; *(u32x4*)(kt + cb * 16) = kB0; *(u32x4*)(kt + (cb + 1) * 16) = kB1;
        if (act) {
            int lin;
            lin = ca * ntok + 8 * th;       *(u32x4*)(PROJ + (size_t)(row0 + (lin >> 7)) * 4096 + vc + (lin & 127)) = vA0;
            lin = (ca + 1) * ntok + 8 * th; *(u32x4*)(PROJ + (size_t)(row0 + (lin >> 7)) * 4096 + vc + (lin & 127)) = vA1;
            lin = cb * ntok + 8 * th;       *(u32x4*)(PROJ + (size_t)(row0 + (lin >> 7)) * 4096 + vc + (lin & 127)) = vB0;
            lin = (cb + 1) * ntok + 8 * th; *(u32x4*)(PROJ + (size_t)(row0 + (lin >> 7)) * 4096 + vc + (lin & 127)) = vB1;
        }
        if (th == 0) { float* gp = G + (size_t)(s * 8 + h) * 128; *(f32x2*)(gp + ca) = (f32x2){g0, g1}; *(f32x2*)(gp + cb) = (f32x2){g2, g3}; }
#pragma unroll
        for (int ii = 0; ii < 8; ++ii) { qa[ii] = qan[ii]; qb[ii] = qbn[ii]; ka[ii] = kan[ii]; kb[ii] = kbn[ii]; va[ii] = van[ii]; vb[ii] = vbn[ii]; }
    }
}

struct GlaOff { int v[2]; int kq; int ost[2][4]; int kt[8]; int g; int qc, kc; };
template <int NTOK>
__device__ __forceinline__ void gla_offsets(GlaOff& o, int h, int sl, int lane) {
    const int c = lane & 15, q4 = lane >> 4; const bool ret = h < 4; const int hh = h & 3;
    o.qc = (ret ? 0 : 2048) + 128 * hh; o.kc = (ret ? 512 : 2560) + 128 * hh; const int vc = (ret ? 1024 : 3072) + 128 * hh;
#pragma unroll
    for (int n = 0; n < 2; ++n) { const int lin = (32 * sl + 16 * n + c) * NTOK + 4 * q4; o.v[n] = (lin >> 7) * 4096 + vc + (lin & 127);
#pragma unroll
        for (int r = 0; r < 4; ++r) { const int l2 = 32 * sl * NTOK + (4 * q4 + r) * 32 + 16 * n + c; o.ost[n][r] = (l2 >> 7) * 4096 + vc + (l2 & 127); } }
    o.kq = c * 4096 + 8 * q4;
#pragma unroll
    for (int t = 0; t < 8; ++t) o.kt[t] = (32 * (t >> 1) + 8 * (c >> 2) + 4 * (t & 1) + (c & 3)) * 16 + 4 * q4;
    o.g = 8 * q4;
}
template <int NTOK>
__device__ __forceinline__ void gla_load_qkv(const bf16_t* pr, const GlaOff& o, int lane, bf16x4 (&vf)[2], bf16x8 (&kf)[4], bf16x8 (&qf)[4]) {
    const int c = lane & 15, q4 = lane >> 4;
#pragma unroll
    for (int n = 0; n < 2; ++n) { vf[n] = (bf16x4){0, 0, 0, 0}; if (NTOK == 16 || 4 * q4 < NTOK) vf[n] = *(const bf16x4*)(pr + o.v[n]); }
#pragma unroll
    for (int kk = 0; kk < 4; ++kk) { kf[kk] = (bf16x8){0, 0, 0, 0, 0, 0, 0, 0}; qf[kk] = kf[kk];
        if (NTOK == 16 || c < NTOK) { kf[kk] = *(const bf16x8*)(pr + o.kq + o.kc + 32 * kk); qf[kk] = *(const bf16x8*)(pr + o.kq + o.qc + 32 * kk); } }
}
template <int NTOK>
__device__ __forceinline__ void gla_step_state(const bf16_t* pr, const bf16_t* kt, const float* g, const GlaOff& o, int lane, f32x4 (&S)[8][2], f32x4 (&P)[8]) {
    const int q4 = lane >> 4;
    bf16x4 vf[2], kaf[8]; f32x4 gvf[8];
#pragma unroll
    for (int n = 0; n < 2; ++n) { vf[n] = (bf16x4){0, 0, 0, 0}; if (NTOK == 16 || 4 * q4 < NTOK) vf[n] = *(const bf16x4*)(pr + o.v[n]); }
#pragma unroll
    for (int t = 0; t < 8; ++t) { kaf[t] = *(const bf16x4*)(kt + o.kt[t]); gvf[t] = *(const f32x4*)(g + o.g + 32 * (t >> 1) + 4 * (t & 1)); }
#pragma unroll
    for (int t = 0; t < 8; ++t)
#pragma unroll
        for (int n = 0; n < 2; ++n) S[t][n] = mfma16(kaf[t], vf[n], S[t][n]);
#pragma unroll
    for (int t = 0; t < 8; ++t) { S[t][0] = S[t][0] * gvf[t]; S[t][1] = S[t][1] * gvf[t]; P[t] = P[t] * gvf[t]; }
}
template <int NTOK>
__device__ __forceinline__ void gla_step_emit(bf16_t* pr, const bf16_t* kt, const float* g, const GlaOff& o, int lane, f32x4 (&S)[8][2], bf16x4 (&vf)[2], bf16x8 (&kf)[4], bf16x8 (&qf)[4], const bf16_t* prn) {
    const int c = lane & 15, q4 = lane >> 4;
    bf16x4 kaf[8]; f32x4 gvf[8];
#pragma unroll
    for (int t = 0; t < 8; ++t) kaf[t] = *(const bf16x4*)(kt + o.kt[t]);
    f32x4 at = (f32x4){0.f, 0.f, 0.f, 0.f};
#pragma unroll
    for (int kk = 0; kk < 4; ++kk) at = mfma32(kf[kk], qf[kk], at);
#pragma unroll
    for (int r = 0; r < 4; ++r) if (4 * q4 + r > c) at[r] = 0.f;
    const bf16x4 pf = pack4(at);
    f32x4 ov[2];
#pragma unroll
    for (int n = 0; n < 2; ++n) { ov[n] = mfma16(pf, vf[n], (f32x4){0.f, 0.f, 0.f, 0.f});
#pragma unroll
        for (int kk = 0; kk < 4; ++kk) ov[n] = mfma32(qf[kk], pack8(S[2 * kk][n], S[2 * kk + 1][n]), ov[n]); }
#pragma unroll
    for (int t = 0; t < 8; ++t) gvf[t] = *(const f32x4*)(g + o.g + 32 * (t >> 1) + 4 * (t & 1));
#pragma unroll
    for (int n = 0; n < 2; ++n)
#pragma unroll
        for (int r = 0; r < 4; ++r) if (NTOK == 16 || 4 * q4 + r < NTOK) pr[o.ost[n][r]] = (bf16_t)(cvt_pk(ov[n][r], 0.f) & 0xffffu);
    bf16x4 vfc[2] = {vf[0], vf[1]};
    if (prn) gla_load_qkv<NTOK>(prn, o, lane, vf, kf, qf);
#pragma unroll
    for (int t = 0; t < 8; ++t)
#pragma unroll
        for (int n = 0; n < 2; ++n) S[t][n] = mfma16(kaf[t], vfc[n], S[t][n]);
#pragma unroll
    for (int t = 0; t < 8; ++t) { S[t][0] = S[t][0] * gvf[t]; S[t][1] = S[t][1] * gvf[t]; }
}
__device__ __forceinline__ void state_load(const float* p, int sl, f32x4 (&S)[8][2], int lane) {
    const int c = lane & 15, q4 = lane >> 4;
#pragma unroll
    for (int t = 0; t < 8; ++t)
#pragma unroll
        for (int n = 0; n < 2; ++n)
#pragma unroll
            for (int r = 0; r < 4; ++r) S[t][n][r] = p[(32 * (t >> 1) + 8 * q4 + 4 * (t & 1) + r) * 128 + 32 * sl + 16 * n + c];
}
__device__ __forceinline__ void state_store(float* p, int sl, const f32x4 (&S)[8][2], int lane) {
    const int c = lane & 15, q4 = lane >> 4;
#pragma unroll
    for (int t = 0; t < 8; ++t)
#pragma unroll
        for (int n = 0; n < 2; ++n)
#pragma unroll
            for (int r = 0; r < 4; ++r) p[(32 * (t >> 1) + 8 * q4 + 4 * (t & 1) + r) * 128 + 32 * sl + 16 * n + c] = S[t][n][r];
}
__device__ __forceinline__ void phase_A(const Args& a, int gw, int NGW, int lane) {
    unsigned char* ws = a.ws; const bf16_t* PROJ = (const bf16_t*)(ws + OFF_BIG); const bf16_t* KTT = (const bf16_t*)(ws + OFF_XB); const float* G = (const float*)(ws + OFF_G); float* U = (float*)(ws + OFF_U);
    float* GSP = (float*)(ws + OFF_GS);
    for (int it = gw; it < 64 * 8 * 4; it += NGW) {
        const int sl = it & 3, g = it >> 2, k = g & 7, bh = g >> 3, b = bh >> 3, h = bh & 7;
        const int j0 = k == 0 ? 0 : 16 * (k - 1) + 1, s0 = b * NSUBP + j0, ns = k == 0 ? 1 : 16;
        GlaOff o; gla_offsets<16>(o, h, sl, lane);
        const bf16_t* pr = PROJ + (size_t)(b * LP + 16 * j0) * 4096; const bf16_t* kt = KTT + (size_t)(s0 * 8 + h) * 2048; const float* gp = G + (size_t)(s0 * 8 + h) * 128;
        f32x4 S[8][2], P[8];
#pragma unroll
        for (int t = 0; t < 8; ++t) { S[t][0] = (f32x4){0.f, 0.f, 0.f, 0.f}; S[t][1] = S[t][0]; P[t] = (f32x4){1.f, 1.f, 1.f, 1.f}; }
        for (int j = 0; j < ns; ++j) { gla_step_state<16>(pr, kt, gp, o, lane, S, P); pr += 16 * 4096; kt += 8 * 2048; gp += 8 * 128; }
        state_store(U + (size_t)(bh * 8 + k) * 16384, sl, S, lane);
        if (sl == 0 && (lane & 15) == 0) { const int q4 = lane >> 4;
#pragma unroll
            for (int t = 0; t < 8; ++t) *(f32x4*)(GSP + (size_t)(bh * 8 + k) * 128 + 32 * (t >> 1) + 8 * q4 + 4 * (t & 1)) = P[t]; }
    }
}
__device__ __forceinline__ void phase_B(const Args& a, int gt, int NGT) {
    unsigned char* ws = a.ws; const float* GSP = (const float*)(ws + OFF_GS); float* U = (float*)(ws + OFF_U);
    for (int idx = gt; idx < 64 * 16384; idx += NGT) {
        const int bh = idx >> 14, e = idx & 16383, dk = e >> 7;
        float uv[8], gv[8];
#pragma unroll
        for (int k = 0; k < 8; ++k) { uv[k] = U[(size_t)(bh * 8 + k) * 16384 + e]; gv[k] = GSP[(size_t)(bh * 8 + k) * 128 + dk]; }
        float Sv = 0.f;
#pragma unroll
        for (int k = 0; k < 8; ++k) { Sv = gv[k] * Sv + uv[k]; U[(size_t)(bh * 8 + k) * 16384 + e] = Sv; }
    }
}
__device__ __forceinline__ void phase_C(const Args& a, int gw, int NGW, int lane) {
    unsigned char* ws = a.ws; bf16_t* PROJ = (bf16_t*)(ws + OFF_BIG); const bf16_t* KTT = (const bf16_t*)(ws + OFF_XB); const float* G = (const float*)(ws + OFF_G); const float* U = (const float*)(ws + OFF_U);
    const int nit = (2304 + 4096 - gw + NGW - 1) / NGW;
    for (int ii = 0; ii < nit; ++ii) {
        const int it = gw + ((gw & 1) ? (nit - 1 - ii) : ii) * NGW;
        const int sl = it & 3; f32x4 S[8][2]; bf16x4 vf[2]; bf16x8 kf[4], qf[4];
        if (it < 2304) {
            int bh, k; if (it < 2048) { const int g = it >> 2; bh = g >> 3; k = (g & 7) + 1; } else { bh = (it - 2048) >> 2; k = 0; }
            const int b = bh >> 3, h = bh & 7;
            if (k == 0) {
#pragma unroll
                for (int t = 0; t < 8; ++t) { S[t][0] = (f32x4){0.f, 0.f, 0.f, 0.f}; S[t][1] = S[t][0]; }
            } else state_load(U + (size_t)(bh * 8 + (k - 1)) * 16384, sl, S, lane);
            const int j0 = k == 0 ? 0 : 16 * (k - 1) + 1, s0 = b * NSUBP + j0, ns = k == 0 ? 1 : 16;
            GlaOff o; gla_offsets<16>(o, h, sl, lane);
            bf16_t* pr = PROJ + (size_t)(b * LP + 16 * j0) * 4096; const bf16_t* kt = KTT + (size_t)(s0 * 8 + h) * 2048; const float* gp = G + (size_t)(s0 * 8 + h) * 128;
            gla_load_qkv<16>(pr, o, lane, vf, kf, qf);
            for (int j = 0; j < ns; ++j) { gla_step_emit<16>(pr, kt, gp, o, lane, S, vf, kf, qf, j + 1 < ns ? pr + 16 * 4096 : nullptr); pr += 16 * 4096; kt += 8 * 2048; gp += 8 * 128; }
            if (k == 8) state_store(a.out + (h < 4 ? O_RETP : O_HGP) + (size_t)(b * 4 + (h & 3)) * 16384, sl, S, lane);
        } else {
            const int g = (it - 2304) >> 2, b = g >> 3, h = g & 7, s = NS_P + b;
            state_load(a.in[h < 4 ? 2 : 3] + (size_t)(b * 4 + (h & 3)) * 16384, sl, S, lane);
            GlaOff o; gla_offsets<8>(o, h, sl, lane);
            bf16_t* pr = PROJ + (size_t)(TP + 8 * b) * 4096;
            gla_load_qkv<8>(pr, o, lane, vf, kf, qf);
            gla_step_emit<8>(pr, KTT + (size_t)(s * 8 + h) * 2048, G + (size_t)(s * 8 + h) * 128, o, lane, S, vf, kf, qf, nullptr);
            state_store(a.out + (h < 4 ? O_RETS : O_HGS) + (size_t)(b * 4 + (h & 3)) * 16384, sl, S, lane);
        }
    }
}
__device__ __forceinline__ void d_load(const bf16_t* PROJ, int it, int lane, u32x4 (&xo)[4], u32x4 (&gx)[4]) {
    const int i = lane & 15, sl = lane >> 4;
    const int s = it >> 3, h = it & 7; int row0, ntok, pidx0; sub_geom(s, row0, ntok, pidx0);
    const bool ret = h < 4; const int hh = h & 3;
    const int vc = (ret ? 1024 : 3072) + 128 * hh, gc = (ret ? 1536 : 3584) + 128 * hh + 32 * sl;
    const int lin0 = 32 * sl * ntok + 32 * i;
    const bf16_t* op = PROJ + (size_t)(row0 + (lin0 >> 7)) * 4096 + vc + (lin0 & 127);
    const bf16_t* gp = PROJ + (size_t)(row0 + i) * 4096 + gc;
#pragma unroll
    for (int w = 0; w < 4; ++w) { xo[w] = (u32x4){0u, 0u, 0u, 0u}; gx[w] = xo[w]; if (i < ntok) { xo[w] = *(const u32x4*)(op + 8 * w); gx[w] = *(const u32x4*)(gp + 8 * w); } }
}
__device__ __forceinline__ void phase_D(const Args& a, int gw, int NGW, int lane) {
    unsigned char* ws = a.ws; const bf16_t* PROJ = (const bf16_t*)(ws + OFF_BIG); bf16_t* MIX = (bf16_t*)(ws + OFF_XB);
    const int i = lane & 15, sl = lane >> 4;
    f32x4 nwv[8];
#pragma unroll
    for (int w = 0; w < 8; ++w) nwv[w] = *(const f32x4*)(a.in[11] + 32 * sl + 4 * w);
    u32x4 xo[4], gx4[4], xon[4], gxn[4];
    if (gw < NS * 8) d_load(PROJ, gw, lane, xo, gx4);
    for (int it = gw; it < NS * 8; it += NGW) {
        if (it + NGW < NS * 8) d_load(PROJ, it + NGW, lane, xon, gxn);
        const int s = it >> 3, h = it & 7; int row0, ntok, pidx0; sub_geom(s, row0, ntok, pidx0);
        const bool ret = h < 4;
        const bool valid = i < ntok;
        float o[32];
#pragma unroll
        for (int w = 0; w < 4; ++w)
#pragma unroll
            for (int e = 0; e < 4; ++e) { o[8 * w + 2 * e] = bflo(xo[w][e]); o[8 * w + 2 * e + 1] = bfhi(xo[w][e]); }
        float sum = 0.f;
#pragma unroll
        for (int e = 0; e < 32; ++e) sum += o[e];
        sum += __shfl_xor(sum, 16); sum += __shfl_xor(sum, 32);
        const float mu = ret ? sum * (1.f / 128.f) : 0.f;
        float sq = 0.f;
#pragma unroll
        for (int e = 0; e < 32; ++e) { const float d = o[e] - mu; sq += d * d; }
        sq += __shfl_xor(sq, 16); sq += __shfl_xor(sq, 32);
        const float rstd = rsqrtf(sq * (1.f / 128.f) + LN_EPS);
        if (valid) {
            bf16_t* mp = MIX + (size_t)(row0 + i) * DM + 128 * h + 32 * sl;
#pragma unroll
            for (int w = 0; w < 4; ++w) { const u32x4 gx = gx4[w]; float r[8];
#pragma unroll
                for (int e = 0; e < 4; ++e) { const float g0 = bflo(gx[e]), g1 = bfhi(gx[e]);
                    float v0 = (o[8 * w + 2 * e] - mu) * rstd, v1 = (o[8 * w + 2 * e + 1] - mu) * rstd;
                    if (!ret) { v0 *= nwv[2 * w + (e >> 1)][2 * (e & 1)]; v1 *= nwv[2 * w + (e >> 1)][2 * (e & 1) + 1]; }
                    r[2 * e] = v0 * g0 * sigmoidf_(g0); r[2 * e + 1] = v1 * g1 * sigmoidf_(g1); }
                u32x4 ov; ov.x = cvt_pk(r[0], r[1]); ov.y = cvt_pk(r[2], r[3]); ov.z = cvt_pk(r[4], r[5]); ov.w = cvt_pk(r[6], r[7]);
                *(u32x4*)(mp + 8 * w) = ov; }
        }
#pragma unroll
        for (int w = 0; w < 4; ++w) { xo[w] = xon[w]; gx4[w] = gxn[w]; }
    }
}

template <bool FINAL, bool FROMX0 = false>
__device__ __forceinline__ void phase_LN(const Args& a, const float* gam, const float* bet, const bf16_t* PART, int nsplit, int gw, int NGW, int lane) {
    unsigned char* ws = a.ws; bf16_t* XR = (bf16_t*)(ws + OFF_X32);
    f32x4 gv[4], bv[4];
#pragma unroll
    for (int j = 0; j < 4; ++j) { gv[j] = ((const f32x4*)gam)[lane + 64 * j]; bv[j] = ((const f32x4*)bet)[lane + 64 * j]; }
    for (int row0 = gw; row0 < T; row0 += 4 * NGW) {
        f32x4 v[4][4];
#pragma unroll
        for (int q = 0; q < 4; ++q) { const int row = row0 + q * NGW;
            if (row < T) { const u32x2* xr = (const u32x2*)(XR + (size_t)row * DM) + lane;
#pragma unroll
                for (int j = 0; j < 4; ++j) { const u32x2 w = xr[64 * j]; v[q][j] = (f32x4){bflo(w.x), bfhi(w.x), bflo(w.y), bfhi(w.y)}; }
                if (FROMX0 && row >= 16384) { const f32x4* x0 = (const f32x4*)xsrc_row(a, row) + lane;
#pragma unroll
                    for (int j = 0; j < 4; ++j) v[q][j] = x0[64 * j]; }
                if (row >= 16384 && nsplit > 0) {
#pragma unroll
                    for (int j = 0; j < 4; ++j) v[q][j] = v[q][j] * ALPHA;
                    for (int s = 0; s < nsplit; ++s) { const u32x2* pr = (const u32x2*)(PART + ((size_t)s * 1152 + (row - 16384)) * DM) + lane;
#pragma unroll
                        for (int j = 0; j < 4; ++j) { const u32x2 w = pr[64 * j]; v[q][j] += (f32x4){bflo(w.x), bfhi(w.x), bflo(w.y), bfhi(w.y)}; } } } } }
#pragma unroll
        for (int q = 0; q < 4; ++q) { const int row = row0 + q * NGW;
            if (row < T) {
                float s = 0.f;
#pragma unroll
                for (int j = 0; j < 4; ++j) s += (v[q][j][0] + v[q][j][1]) + (v[q][j][2] + v[q][j][3]);
                const float mean = wave_sum(s) * (1.f / DM); float s2 = 0.f;
#pragma unroll
                for (int j = 0; j < 4; ++j) { v[q][j] = v[q][j] - mean; s2 += (v[q][j][0] * v[q][j][0] + v[q][j][1] * v[q][j][1]) + (v[q][j][2] * v[q][j][2] + v[q][j][3] * v[q][j][3]); }
                const float rstd = rsqrtf(wave_sum(s2) * (1.f / DM) + LN_EPS);
#pragma unroll
                for (int j = 0; j < 4; ++j) v[q][j] = v[q][j] * rstd * gv[j] + bv[j];
                if (FINAL) {
                    float* op = nullptr;
                    if (row < TP) { const int b = row / LP, t = row - b * LP; if (t >= 16) op = a.out + O_YP + ((size_t)b * 2048 + (t - 16)) * DM; }
                    else op = a.out + O_YS + (size_t)(row - TP) * DM;
                    if (op) {
#pragma unroll
                        for (int j = 0; j < 4; ++j) ((f32x4*)op)[lane + 64 * j] = v[q][j]; }
                } else {
                    u32x2* ob = (u32x2*)(XR + (size_t)row * DM) + lane;
#pragma unroll
                    for (int j = 0; j < 4; ++j) { u32x2 w; w.x = cvt_pk(v[q][j][0], v[q][j][1]); w.y = cvt_pk(v[q][j][2], v[q][j][3]); ob[64 * j] = w; }
                }
            } }
    }
}

__device__ __forceinline__ void phase_F1(const Args& a, LAS unsigned char* lds, int wave, int lane) {
    unsigned char* ws = a.ws; const bf16_t* __restrict__ GR = (const bf16_t*)(ws + OFF_H); const bf16_t* __restrict__ WG = (const bf16_t*)(ws + OFF_WG);
    bf16_t* __restrict__ HL = (bf16_t*)(ws + OFF_HL); bf16_t* __restrict__ AC = (bf16_t*)(ws + OFF_XB); float* __restrict__ TA = (float*)(ws + OFF_TA); float* __restrict__ TH = (float*)(ws + OFF_TH);
    const float* C8 = (const float*)(ws + OFF_C8);
    const float* convw = a.in[13]; const float* convb = a.in[14]; const float* bga = a.in[16]; const float* bgx = a.in[18];
    const int c = lane & 15, q4 = lane >> 4;
    const int n = blockIdx.x & 7;
    { const u32x4* wsrc = (const u32x4*)(WG + (size_t)n * 2 * 16384);
      for (int e = threadIdx.x; e < 4096; e += 512) { const int r = e >> 4, cc = e & 15; *(LAS u32x4*)(lds + r * 272 + cc * 16) = wsrc[e]; } }
    LAS float* cst = (LAS float*)(lds + 69632);
    for (int e = threadIdx.x; e < 1024; e += 512) { const int k = e >> 7, ch = 128 * n + (e & 127);
        cst[e] = k == 0 ? bga[ch] : k == 1 ? bgx[ch] : k == 2 ? C8[ch] : k < 7 ? convw[(k - 3) * 1024 + ch] : convb[ch]; }
    __syncthreads();
    for (int tt = ((int)blockIdx.x >> 3) * 8 + wave; tt < NTILE; tt += (int)(gridDim.x >> 3) * 8) {
        int row, b, t, W; bool smp;
        if (tt < NT_P) { b = tt / NSUBP; const int j = tt - b * NSUBP; row = b * LP + 16 * j + c; t = 16 * j + c; W = 16; smp = false; }
        else { const int k = tt - NT_P; row = TP + 16 * k + c; b = 2 * k + (c >> 3); t = c & 7; W = 8; smp = true; }
        const int chb = 128 * n;
        bf16x8 bfr[4];
#pragma unroll
        for (int q = 0; q < 4; ++q) bfr[q] = (bf16x8){0, 0, 0, 0, 0, 0, 0, 0};
#pragma unroll 2
        for (int kk = 0; kk < 4; ++kk) {
            const int ch0 = chb + 32 * kk + 8 * q4;
            const int cl0 = 32 * kk + 8 * q4;
            f32x4 s0 = *(const LAS f32x4*)(cst + 7 * 128 + cl0), s1 = *(const LAS f32x4*)(cst + 7 * 128 + cl0 + 4);
#pragma unroll
            for (int d = 0; d < 4; ++d) {
                const f32x4 wa = *(const LAS f32x4*)(cst + (3 + 3 - d) * 128 + cl0), wb = *(const LAS f32x4*)(cst + (3 + 3 - d) * 128 + cl0 + 4);
                f32x4 xa = (f32x4){0.f, 0.f, 0.f, 0.f}, xb = xa;
                if (t - d >= 0) { const u32x4 x = *(const u32x4*)(GR + (size_t)(row - d) * 2048 + 1024 + ch0);
                    xa = (f32x4){bflo(x[0]), bfhi(x[0]), bflo(x[1]), bfhi(x[1])}; xb = (f32x4){bflo(x[2]), bfhi(x[2]), bflo(x[3]), bfhi(x[3])}; }
                else if (smp) { const float* sp = a.in[5] + ((size_t)b * 3 + (t - d + 3)) * 1024 + ch0; xa = *(const f32x4*)sp; xb = *(const f32x4*)(sp + 4); }
                s0 += wa * xa; s1 += wb * xb;
            }
            { const bf16x8 pv = pack8(s0, s1);
#pragma unroll
              for (int q = 0; q < 4; ++q) bfr[q] = (kk == q) ? pv : bfr[q]; }
        }
#pragma unroll 2
        for (int kk = 0; kk < 4; ++kk) {
            const int ch0 = chb + 32 * kk + 8 * q4;
            const int cl0 = 32 * kk + 8 * q4;
            const f32x4 ba0 = *(const LAS f32x4*)(cst + cl0), ba1 = *(const LAS f32x4*)(cst + cl0 + 4), bx0 = *(const LAS f32x4*)(cst + 128 + cl0), bx1 = *(const LAS f32x4*)(cst + 128 + cl0 + 4);
            const f32x4 c80 = *(const LAS f32x4*)(cst + 256 + cl0), c81 = *(const LAS f32x4*)(cst + 256 + cl0 + 4);
            f32x4 h00 = (f32x4){0.f, 0.f, 0.f, 0.f}, h01 = h00;
            if (smp && t == 0) { h00 = *(const f32x4*)(a.in[4] + (size_t)b * 1024 + ch0); h01 = *(const f32x4*)(a.in[4] + (size_t)b * 1024 + ch0 + 4); }
            f32x4 ra[2], ia[2];
#pragma unroll
            for (int hf = 0; hf < 2; ++hf) {
                const int oc = 32 * kk + 8 * (c >> 2) + 4 * hf + (c & 3);
                ra[hf] = (f32x4){0.f, 0.f, 0.f, 0.f}; ia[hf] = ra[hf];
#pragma unroll
                for (int k2 = 0; k2 < 4; ++k2) {
                    const bf16x8 wa = *(const LAS bf16x8*)(lds + (0 * 128 + oc) * 272 + (32 * k2 + 8 * q4) * 2);
                    const bf16x8 wx = *(const LAS bf16x8*)(lds + (1 * 128 + oc) * 272 + (32 * k2 + 8 * q4) * 2);
                    ra[hf] = mfma32(wa, bfr[k2], ra[hf]); ia[hf] = mfma32(wx, bfr[k2], ia[hf]);
                }
            }
            float Av[8], Bv[8], xcv[8];
            { const u32x4 x0 = __builtin_bit_cast(u32x4, bfr[0]), x1 = __builtin_bit_cast(u32x4, bfr[1]), x2 = __builtin_bit_cast(u32x4, bfr[2]), x3 = __builtin_bit_cast(u32x4, bfr[3]);
#pragma unroll
              for (int e = 0; e < 4; ++e) { const unsigned w = kk == 0 ? x0[e] : kk == 1 ? x1[e] : kk == 2 ? x2[e] : x3[e]; xcv[2 * e] = bflo(w); xcv[2 * e + 1] = bfhi(w); } }
#pragma unroll
            for (int jp = 0; jp < 8; ++jp) {
                const int hf = jp >> 2, r = jp & 3;
                const float rr = sigmoidf_(ra[hf][r] + (hf ? ba1[r] : ba0[r])), ii = sigmoidf_(ia[hf][r] + (hf ? bx1[r] : bx0[r]));
                const float la = rr * (hf ? c81[r] : c80[r]); const float av = __expf(la);
                float bv = __builtin_amdgcn_sqrtf(fmaxf(1.f - av * av, 0.f)) * (ii * xcv[jp]);
                bv += av * (hf ? h01[r] : h00[r]);
                Av[jp] = av; Bv[jp] = bv;
            }
#define F1_SCAN_STEP(D, CTRL) { const bool take = (c & (W - 1)) >= (D); \
                _Pragma("unroll") for (int jp = 0; jp < 8; ++jp) { \
                    const float ap = __int_as_float(__builtin_amdgcn_update_dpp(0, __float_as_int(Av[jp]), CTRL, 0xf, 0xf, false)); \
                    const float bp = __int_as_float(__builtin_amdgcn_update_dpp(0, __float_as_int(Bv[jp]), CTRL, 0xf, 0xf, false)); \
                    if (take) { Bv[jp] = Av[jp] * bp + Bv[jp]; Av[jp] = Av[jp] * ap; } } }
            F1_SCAN_STEP(1, 0x111) F1_SCAN_STEP(2, 0x112) F1_SCAN_STEP(4, 0x114)
            if (W == 16) F1_SCAN_STEP(8, 0x118)
#undef F1_SCAN_STEP
            u32x4 hw, aw;
#pragma unroll
            for (int e = 0; e < 4; ++e) { hw[e] = cvt_pk(Bv[2 * e], Bv[2 * e + 1]); aw[e] = cvt_pk(Av[2 * e], Av[2 * e + 1]); }
            *(u32x4*)(HL + (size_t)row * 1024 + ch0) = hw; *(u32x4*)(AC + (size_t)row * 1024 + ch0) = aw;
            if (!smp && c == 15) {
                float* ta = TA + (size_t)tt * 1024 + ch0; float* thp = TH + (size_t)tt * 1024 + ch0;
                *(f32x4*)ta = (f32x4){Av[0], Av[1], Av[2], Av[3]}; *(f32x4*)(ta + 4) = (f32x4){Av[4], Av[5], Av[6], Av[7]};
                *(f32x4*)thp = (f32x4){Bv[0], Bv[1], Bv[2], Bv[3]}; *(f32x4*)(thp + 4) = (f32x4){Bv[4], Bv[5], Bv[6], Bv[7]};
            }
        }
    }
}
__device__ __forceinline__ void phase_F2(const Args& a, LAS unsigned char* lds, int wave, int lane) {
    unsigned char* ws = a.ws; const float* __restrict__ TA = (const float*)(ws + OFF_TA); const float* __restrict__ TH = (const float*)(ws + OFF_TH); float* __restrict__ CARRY = (float*)(ws + OFF_CARRY);
    LAS float* sA = (LAS float*)lds; LAS float* sH = sA + 512;
    for (int blk = blockIdx.x; blk < NB * 16; blk += gridDim.x) {
        const int b = blk >> 4, ch = (blk & 15) * 64 + lane;
        const int j0 = wave * 17, j1 = j0 + 17 < NSUBP ? j0 + 17 : NSUBP;
        float av[17], hv[17];
#pragma unroll
        for (int j = 0; j < 17; ++j) { av[j] = 1.f; hv[j] = 0.f; if (j0 + j < j1) { const size_t o = (size_t)(b * NSUBP + j0 + j) * 1024 + ch; av[j] = TA[o]; hv[j] = TH[o]; } }
        float As = 1.f, Hs = 0.f;
#pragma unroll
        for (int j = 0; j < 17; ++j) { Hs = av[j] * Hs + hv[j]; As = As * av[j]; }
        sA[wave * 64 + lane] = As; sH[wave * 64 + lane] = Hs;
        __syncthreads();
        float carry = 0.f;
        for (int w = 0; w < wave; ++w) carry = sA[w * 64 + lane] * carry + sH[w * 64 + lane];
#pragma unroll
        for (int j = 0; j < 17; ++j) if (j0 + j < j1) { CARRY[(size_t)(b * NSUBP + j0 + j) * 1024 + ch] = carry; carry = av[j] * carry + hv[j]; }
        if (wave == 7) a.out[O_HP + (size_t)b * 1024 + ch] = carry;
        __syncthreads();
    }
}
__device__ __forceinline__ void phase_F3(const Args& a, int gw, int NGW, int lane) {
    unsigned char* ws = a.ws; const bf16_t* GR = (const bf16_t*)(ws + OFF_H); const bf16_t* HL = (const bf16_t*)(ws + OFF_HL); bf16_t* AC = (bf16_t*)(ws + OFF_XB); const float* CARRY = (const float*)(ws + OFF_CARRY);
    for (int row = gw; row < T; row += NGW) {
        int b, t; const bool smp = row >= TP;
        if (!smp) { b = row / LP; t = row - b * LP; } else { b = (row - TP) >> 3; t = (row - TP) & 7; }
        const float* cp = smp ? nullptr : CARRY + (size_t)(b * NSUBP + (t >> 4)) * 1024;
        u32x4 hl2[2], ac2[2], gt2[2]; f32x4 c02[2], c12[2];
#pragma unroll
        for (int half = 0; half < 2; ++half) {
            const int ch = 512 * half + 8 * lane;
            hl2[half] = *(const u32x4*)(HL + (size_t)row * 1024 + ch); ac2[half] = *(const u32x4*)(AC + (size_t)row * 1024 + ch);
            gt2[half] = *(const u32x4*)(GR + (size_t)row * 2048 + ch);
            c02[half] = (f32x4){0.f, 0.f, 0.f, 0.f}; c12[half] = c02[half]; if (!smp) { c02[half] = *(const f32x4*)(cp + ch); c12[half] = *(const f32x4*)(cp + ch + 4); }
        }
#pragma unroll
        for (int half = 0; half < 2; ++half) {
            const int ch = 512 * half + 8 * lane;
            const u32x4 hl = hl2[half], ac = ac2[half], gt = gt2[half]; const f32x4 c0 = c02[half], c1 = c12[half];
            float hv[8];
#pragma unroll
            for (int e = 0; e < 4; ++e) { const float cl = e < 2 ? c0[2 * e] : c1[2 * e - 4], chh = e < 2 ? c0[2 * e + 1] : c1[2 * e - 3];
                hv[2 * e] = bflo(hl[e]) + bflo(ac[e]) * cl; hv[2 * e + 1] = bfhi(hl[e]) + bfhi(ac[e]) * chh; }
            u32x4 y;
#pragma unroll
            for (int e = 0; e < 4; ++e) y[e] = cvt_pk(gelu_tanh(bflo(gt[e])) * hv[2 * e], gelu_tanh(bfhi(gt[e])) * hv[2 * e + 1]);
            *(u32x4*)(AC + (size_t)row * 1024 + ch) = y;
            if (smp && t == 7) { float* o = a.out + O_HS + (size_t)b * 1024 + ch; *(f32x4*)o = (f32x4){hv[0], hv[1], hv[2], hv[3]}; *(f32x4*)(o + 4) = (f32x4){hv[4], hv[5], hv[6], hv[7]}; }
            const int L = smp ? 8 : LP;
            if (t >= L - 3) { const u32x4 rn = *(const u32x4*)(GR + (size_t)row * 2048 + 1024 + ch);
                float* o = a.out + (smp ? O_CBS : O_CBP) + ((size_t)b * 3 + (t - (L - 3))) * 1024 + ch;
                *(f32x4*)o = (f32x4){bflo(rn[0]), bfhi(rn[0]), bflo(rn[1]), bfhi(rn[1])}; *(f32x4*)(o + 4) = (f32x4){bflo(rn[2]), bfhi(rn[2]), bflo(rn[3]), bfhi(rn[3])}; }
        }
    }
}

constexpr size_t OFF_BAR = 16 * KiB;
#define XB_TMO      128
#define XB_XCNT(j)  (256  + 64 * (j))
#define XB_XSUB(j)  (1280 + 64 * (j))
#define XB_XGEN(j)  (2304 + 64 * (j))
#define XB_TOP      3328
#define XB_TOPGEN   3392
#define XCD_BAR_WORDS 3456
#define XB_SPIN_CAP (1u << 18)
__device__ __forceinline__ unsigned xb_ld(unsigned* p)              { return __hip_atomic_load(p, __ATOMIC_RELAXED, __HIP_MEMORY_SCOPE_AGENT); }
__device__ __forceinline__ unsigned xb_add(unsigned* p, unsigned v) { return __hip_atomic_fetch_add(p, v, __ATOMIC_RELAXED, __HIP_MEMORY_SCOPE_AGENT); }
__device__ __forceinline__ unsigned xb_xcc_id() { return (unsigned)__builtin_amdgcn_s_getreg((3 << 11) | 20) & 0xFu; }
#define XB_SPIN(cond, bar) do { unsigned _sp = 0; while (cond) { __builtin_amdgcn_s_sleep(1); \
    if ((++_sp & 255u) == 0u) { if (xb_ld(&(bar)[XB_TMO])) break; if (_sp > XB_SPIN_CAP) { atomicAdd(&(bar)[XB_TMO], 1u); break; } } } } while (0)
struct XcdBarrier { unsigned* bar; unsigned x; volatile LAS unsigned* st; };
__device__ __forceinline__ XcdBarrier xcd_barrier_post(unsigned* bar, volatile LAS unsigned* st) {
    XcdBarrier b; b.bar = bar; b.x = xb_xcc_id(); b.st = st;
    if (threadIdx.x == 0) (void)xb_add(&bar[XB_XCNT(b.x)], 1u);
    return b;
}
__device__ __forceinline__ void xcd_barrier_complete(unsigned* bar, unsigned x, unsigned& nloc, unsigned& nx) {
    const unsigned G = gridDim.x * gridDim.y * gridDim.z;
    unsigned sum, cnt, mine, sp = 0u;
    for (;;) {
        sum = 0u; cnt = 0u; mine = 0u;
#pragma unroll
        for (unsigned j = 0; j < 16; ++j) { const unsigned c = xb_ld(&bar[XB_XCNT(j)]); sum += c; cnt += (c > 0u) ? 1u : 0u; mine = (j == x) ? c : mine; }
        if (sum == G) break;
        __builtin_amdgcn_s_sleep(1);
        if ((++sp & 255u) == 0u) { if (xb_ld(&bar[XB_TMO])) break; if (sp > XB_SPIN_CAP) { atomicAdd(&bar[XB_TMO], 1u); break; } }
    }
    nloc = mine > 0u ? mine : 1u; nx = cnt > 0u ? cnt : 1u;
}
__device__ __forceinline__ void xcd_barrier(const XcdBarrier& b) {
    asm volatile("s_waitcnt vmcnt(0) lgkmcnt(0)" ::: "memory");
    __syncthreads();
    if (threadIdx.x == 0) {
        unsigned* bar = b.bar;
        __builtin_amdgcn_s_waitcnt(0);
        unsigned nloc = b.st[0], nx = b.st[1];
        if (nloc == 0u) { xcd_barrier_complete(bar, b.x, nloc, nx); b.st[0] = nloc; b.st[1] = nx; }
        const unsigned old = xb_add(&bar[XB_XSUB(b.x)], 1u);
        const unsigned gen = old / nloc;
        if (old + 1u == (gen + 1u) * nloc) {
            __builtin_amdgcn_fence(__ATOMIC_RELEASE, "agent");
            asm volatile("s_waitcnt vmcnt(0)" ::: "memory");
            const unsigned og = xb_add(&bar[XB_TOP], 1u);
            const unsigned tg = og / nx;
            if (og + 1u == (tg + 1u) * nx) xb_add(&bar[XB_TOPGEN], 1u);
            else XB_SPIN(xb_ld(&bar[XB_TOPGEN]) == tg, bar);
            __builtin_amdgcn_fence(__ATOMIC_ACQUIRE, "agent");
            xb_add(&bar[XB_XGEN(b.x)], 1u);
            asm volatile("s_waitcnt vmcnt(0)" ::: "memory");
        } else {
            XB_SPIN(xb_ld(&bar[XB_XGEN(b.x)]) == gen, bar);
            __builtin_amdgcn_fence(__ATOMIC_ACQUIRE, "agent");
            asm volatile("s_waitcnt vmcnt(0)" ::: "memory");
        }
    }
    __syncthreads();
}

__global__ void __launch_bounds__(512) fwd_megakernel(Args a) {
    extern __shared__ __attribute__((aligned(16))) unsigned char lds_raw[];
    cg::grid_group grid = cg::this_grid();
    LAS unsigned char* lds = (LAS unsigned char*)lds_raw;
#define FRESH() int tid = threadIdx.x; asm volatile("" : "+v"(tid)); const int lane = tid & 63, wave = __builtin_amdgcn_readfirstlane(tid >> 6); \
    const int gw = blockIdx.x * 8 + wave, NGW = G * 8, gt = blockIdx.x * 512 + tid, NGT = G * 512; (void)gw; (void)NGW; (void)gt; (void)NGT; (void)lane;
    const int G = gridDim.x;
    unsigned char* ws = a.ws;
    bf16_t* XB = (bf16_t*)(ws + OFF_XB); bf16_t* XR = (bf16_t*)(ws + OFF_X32);
    bf16_t* PROJ = (bf16_t*)(ws + OFF_BIG); bf16_t* HB = (bf16_t*)(ws + OFF_H);
    pg8::StaticOrder S;
    { volatile LAS unsigned* st0 = (volatile LAS unsigned*)(lds + 131072 + 64); if (threadIdx.x < 2) st0[threadIdx.x] = 0u; }
    __syncthreads();
    const XcdBarrier xbar = xcd_barrier_post((unsigned*)(ws + OFF_BAR), (volatile LAS unsigned*)(lds + 131072 + 64));
#define GS() xcd_barrier(xbar)
    grid.sync();
    unsigned long long tA = 0, tB = 0;
#define STAMP(k) do { if ((k) == PROBE_A) tA = __builtin_amdgcn_s_memrealtime(); if ((k) == PROBE_B) tB = __builtin_amdgcn_s_memrealtime(); } while (0)
    STAMP(0);

    { FRESH() phase_p0(a, lds, gw, NGW, wave, lane); }
    GS(); STAMP(1);
    { S.init(MP / 256, 4096 / 256, G, (int)blockIdx.x, 16, false); pg8::EpiBf16 E{PROJ, 4096};
      pg8::gemm_phase<pg8::EpiBf16, 0>(lds, XB, (const bf16_t*)(ws + OFF_W_INAB), 1024, S, E); }
    if (G == 256 && blockIdx.x >= 80) { FRESH() convert_weights(a, lds, 1, ((int)blockIdx.x - 80) * 8 + wave, 176 * 8, wave, lane); }
    else if (G != 256) { FRESH() convert_weights(a, lds, 1, gw, NGW, wave, lane); }
    GS(); STAMP(2);
    { FRESH() phase_T(a, gw, NGW, lane); }
    GS(); STAMP(3);
    { FRESH() phase_A(a, gw, NGW, lane); }
    GS(); STAMP(4);
    { FRESH() phase_B(a, gt, NGT); }
    GS(); STAMP(5);
    { FRESH() phase_C(a, gw, NGW, lane); }
    GS(); STAMP(6);
    { FRESH() phase_D(a, gw, NGW, lane); }
    GS(); STAMP(7);
    { S.init(MP / 256, 1024 / 256, G, (int)blockIdx.x, 16, true); pg8::EpiRes<0, true> E{XR, a, HB};
      pg8::gemm_phase<pg8::EpiRes<0, true>, 0, true>(lds, XB, (const bf16_t*)(ws + OFF_W_OUTAB), 1024, S, E); }
    GS(); STAMP(8);
    { FRESH() phase_LN<false, true>(a, a.in[21], a.in[22], HB, 4, gw, NGW, lane); }
    GS(); STAMP(9);
#define FFN_PHASES(layer, sid, EXTRA) \
    { S.init(71, DFF / 128, G, (int)blockIdx.x, 16, false); \
      pg8::EpiFFN E{HB, a.in[26] + (size_t)(layer) * 3 * DFF, a.in[27] + (size_t)(layer) * DFF, a.in[6] + (size_t)(layer) * SBAT * 2 * DFF, \
                    a.out + O_FBP + (size_t)(layer) * NB * 2 * DFF, a.out + O_FBS + (size_t)(layer) * SBAT * 2 * DFF}; \
      pg8::gemm_phase<pg8::EpiFFN, 1>(lds, XR - 2 * 1024, (const bf16_t*)(ws + ((layer) ? OFF_W_UP1 : OFF_W_UP0)), 1024, S, E); } \
    EXTRA \
    GS(); STAMP(sid); \
    { S.init(MP / 256, 1024 / 256, G, (int)blockIdx.x, 44, true); pg8::EpiRes<1, true> E{XR, a, (bf16_t*)(ws + OFF_PART)}; \
      pg8::gemm_phase<pg8::EpiRes<1, true>, 0, true>(lds, HB, (const bf16_t*)(ws + ((layer) ? OFF_W_DN1 : OFF_W_DN0)), DFF, S, E); } \
    GS(); STAMP(sid + 1);
#define FFN0_EXTRA if (G == 256 && blockIdx.x >= 26) { FRESH() convert_weights(a, lds, 2, ((int)blockIdx.x - 26) * 8 + wave, 230 * 8, wave, lane); } else if (G != 256) { FRESH() convert_weights(a, lds, 2, gw, NGW, wave, lane); }
    FFN_PHASES(0, 10, FFN0_EXTRA)
    { FRESH() phase_LN<false>(a, a.in[23], a.in[24], (const bf16_t*)(ws + OFF_PART), 11, gw, NGW, lane); }
    GS(); STAMP(12);
    { S.init(MP / 256, 2048 / 256, G, (int)blockIdx.x, 16, false); pg8::EpiBf16 E{HB, 2048};
      pg8::gemm_phase<pg8::EpiBf16, 0>(lds, XR, (const bf16_t*)(ws + OFF_W_INC), 1024, S, E); }
    GS(); STAMP(13);
    { FRESH() phase_F1(a, lds, wave, lane); }
    GS(); STAMP(14);
    { FRESH() phase_F2(a, lds, wave, lane); }
    GS(); STAMP(15);
    { FRESH() phase_F3(a, gw, NGW, lane); }
    GS(); STAMP(16);
    { S.init(MP / 256, 1024 / 256, G, (int)blockIdx.x, 16, true); pg8::EpiRes<1, true> E{XR, a, HB};
      pg8::gemm_phase<pg8::EpiRes<1, true>, 0, true>(lds, XB, (const bf16_t*)(ws + OFF_W_OUTC), 1024, S, E); }
    GS(); STAMP(17);
    { FRESH() phase_LN<false>(a, a.in[21] + 1024, a.in[22] + 1024, HB, 4, gw, NGW, lane); }
    GS(); STAMP(18);
    FFN_PHASES(1, 19, )
    { FRESH() phase_LN<true>(a, a.in[23] + 1024, a.in[24] + 1024, (const bf16_t*)(ws + OFF_PART), 11, gw, NGW, lane); }
#if PROBE_A >= 0
    GS(); STAMP(21);
    if (blockIdx.x == 0 && threadIdx.x == 0) a.out[O_YS] += (float)(tB - tA) * 1e-5f;
#endif
#undef FFN_PHASES
}

extern "C" void kernel_launch(void* const* d_in, const int* in_sizes, int n_in, void* d_out, int out_size, void* d_ws, size_t ws_size, hipStream_t stream) {
    static int grid = 0;
    if (grid == 0) {
        if (n_in != 29 || ws_size < WS_END) { fprintf(stderr, "kernel_launch: unexpected n_in %d / ws %zu\n", n_in, ws_size); grid = -1; return; }
        int dev = 0, cus = 0, per_cu = 0;
        hipGetDevice(&dev); hipDeviceGetAttribute(&cus, hipDeviceAttributeMultiprocessorCount, dev);
        if (hipFuncSetAttribute((const void*)fwd_megakernel, hipFuncAttributeMaxDynamicSharedMemorySize, LDS_BYTES) != hipSuccess) { fprintf(stderr, "kernel_launch: hipFuncSetAttribute failed\n"); grid = -1; return; }
        if (hipOccupancyMaxActiveBlocksPerMultiprocessor(&per_cu, (const void*)fwd_megakernel, 512, LDS_BYTES) != hipSuccess || per_cu < 1) { fprintf(stderr, "kernel_launch: occupancy query says %d\n", per_cu); per_cu = 1; }
        (void)hipGetLastError();
        grid = cus * 1;
    }
    if (grid < 0) return;
    (void)hipMemsetAsync((char*)d_ws + OFF_BAR, 0, 16384, stream);
    Args a{};
    for (int i = 0; i < 29; ++i) a.in[i] = (const float*)d_in[i];
    a.out = (float*)d_out; a.ws = (unsigned char*)d_ws;
    void* args[] = {&a};
    hipError_t e = hipLaunchCooperativeKernel((const void*)fwd_megakernel, dim3(grid), dim3(512), args, LDS_BYTES, stream);
    if (e != hipSuccess) fprintf(stderr, "cooperative launch failed: %s (grid %d)\n", hipGetErrorString(e), grid);
}
```

```cpp
#include <hip/hip_runtime.h>
#include <hip/hip_cooperative_groups.h>
#include <cstdio>
#include <cstdint>
namespace cg = cooperative_groups;
#ifndef PROBE_A
#define PROBE_A -1
#define PROBE_B -1
#endif

#define LAS __attribute__((address_space(3)))
typedef unsigned short bf16_t;
typedef short bf16x8 __attribute__((ext_vector_type(8)));
typedef short bf16x4 __attribute__((ext_vector_type(4)));
typedef float f32x4 __attribute__((ext_vector_type(4)));
typedef float f32x2 __attribute__((ext_vector_type(2)));
typedef unsigned u32x4 __attribute__((ext_vector_type(4)));
typedef unsigned u32x2 __attribute__((ext_vector_type(2)));

constexpr int DM = 1024, LP = 2064, NB = 8, TP = NB * LP, SBAT = 128, TS = SBAT * 8, T = TP + TS, MP = 17664;
constexpr int DFF = 2816;
constexpr int NSUBP = 129, NS_P = NB * NSUBP, NS = NS_P + SBAT;
constexpr int NT_P = NB * NSUBP, NT_S = TS / 16, NTILE = NT_P + NT_S;
constexpr float LN_EPS = 1e-5f;
constexpr float ALPHA = 1.41421356237f;

constexpr size_t O_YP = 0, O_YS = 16777216, O_RETP = 17825792, O_RETS = 18350080, O_HGP = 26738688, O_HGS = 27262976, O_HP = 35651584, O_HS = 35659776,
                 O_CBP = 35790848, O_CBS = 35815424, O_FBP = 36208640, O_FBS = 36298752;

constexpr size_t KiB = 1024, MiB = 1024 * 1024;
constexpr size_t OFF_LBV = 0;
constexpr size_t OFF_C8 = 4 * KiB;
constexpr size_t OFF_W_INC = 1 * MiB;
constexpr size_t OFF_WG = 5 * MiB;
constexpr size_t OFF_W_OUTC = 5 * MiB + 512 * KiB;
constexpr size_t OFF_W_UP1 = 7 * MiB + 512 * KiB;
constexpr size_t OFF_W_DN1 = 18 * MiB + 512 * KiB;
constexpr size_t OFF_XB = 24 * MiB + 4096;
constexpr size_t OFF_BIG = 60 * MiB + 512 * KiB;
constexpr size_t OFF_X32 = OFF_BIG;
constexpr size_t OFF_H = 129 * MiB + 512 * KiB;
constexpr size_t OFF_HL = 198 * MiB + 512 * KiB;
constexpr size_t OFF_G = 198 * MiB + 512 * KiB;
constexpr size_t OFF_GS = 203 * MiB + 256 * KiB;
constexpr size_t OFF_U = 204 * MiB;
constexpr size_t OFF_ROPE = 221 * MiB;
constexpr size_t OFF_TA = 233 * MiB, OFF_TH = 238 * MiB, OFF_CARRY = 243 * MiB;
constexpr size_t OFF_W_INAB = 229 * MiB + 512 * KiB;
constexpr size_t OFF_W_OUTAB = 237 * MiB + 512 * KiB;
constexpr size_t OFF_W_UP0 = 239 * MiB + 512 * KiB;
constexpr size_t OFF_W_DN0 = 250 * MiB + 512 * KiB;
constexpr size_t OFF_PART = 224 * MiB + 512 * KiB;
constexpr size_t WS_END = 256 * MiB;
static_assert(OFF_PART + (size_t)11 * 1152 * 1024 * 2 <= OFF_W_DN0, "part");
static_assert(OFF_XB - 4096 + 36 * MiB + 512 * KiB <= OFF_BIG, "xb");
static_assert((size_t)NS * 8 * 128 * 16 * 2 <= OFF_BIG - OFF_XB, "ktt");
static_assert(OFF_H + (size_t)MP * DFF * 2 <= OFF_W_INAB, "h");
static_assert(OFF_G + (size_t)NS * 8 * 128 * 4 <= OFF_GS, "g");
static_assert(OFF_U + 32 * MiB <= OFF_W_OUTAB, "u");
static_assert(OFF_ROPE + 2072 * 64 * 2 * 4 <= OFF_W_INAB, "rope");
static_assert(OFF_HL + (size_t)T * 1024 * 2 <= OFF_TA, "hl");
static_assert(OFF_CARRY + (size_t)NTILE * 1024 * 4 <= WS_END, "carry");

constexpr int LDS_BYTES = 147456;

typedef __bf16 bf16x2_t __attribute__((ext_vector_type(2)));
__device__ __forceinline__ unsigned cvt_pk(float lo, float hi) { f32x2 v = {lo, hi}; bf16x2_t b = __builtin_convertvector(v, bf16x2_t); return __builtin_bit_cast(unsigned, b); }
__device__ __forceinline__ float bflo(unsigned w) { return __uint_as_float(w << 16); }
__device__ __forceinline__ float bfhi(unsigned w) { return __uint_as_float(w & 0xffff0000u); }
__device__ __forceinline__ float sigmoidf_(float x) { return __builtin_amdgcn_rcpf(1.f + __expf(-x)); }
__device__ __forceinline__ float gelu_tanh(float x) { const float t = x * x; const float e = __builtin_amdgcn_exp2f(x * __builtin_fmaf(t, -0.1029432407f, -2.3022081985f)); return x * __builtin_amdgcn_rcpf(1.f + e); }
__device__ __forceinline__ float wave_sum(float v) {
#pragma unroll
    for (int o = 1; o < 64; o <<= 1) v += __shfl_xor(v, o);
    return v;
}
__device__ __forceinline__ float ror1(float v) { return __int_as_float(__builtin_amdgcn_update_dpp(0, __float_as_int(v), 0x121, 0xf, 0xf, false)); }
__device__ __forceinline__ float ror2(float v) { return __int_as_float(__builtin_amdgcn_update_dpp(0, __float_as_int(v), 0x122, 0xf, 0xf, false)); }
__device__ __forceinline__ f32x4 mfma32(bf16x8 a, bf16x8 b, f32x4 c) { return __builtin_amdgcn_mfma_f32_16x16x32_bf16(a, b, c, 0, 0, 0); }
__device__ __forceinline__ f32x4 mfma16(bf16x4 a, bf16x4 b, f32x4 c) { const bf16x8 a8 = (bf16x8){a[0], a[1], a[2], a[3], 0, 0, 0, 0}, b8 = (bf16x8){b[0], b[1], b[2], b[3], 0, 0, 0, 0}; return __builtin_amdgcn_mfma_f32_16x16x32_bf16(a8, b8, c, 0, 0, 0); }
__device__ __forceinline__ bf16x4 pack4(f32x4 v) { u32x2 w; w.x = cvt_pk(v[0], v[1]); w.y = cvt_pk(v[2], v[3]); return __builtin_bit_cast(bf16x4, w); }
__device__ __forceinline__ bf16x8 pack8(f32x4 a, f32x4 b) { u32x4 w; w.x = cvt_pk(a[0], a[1]); w.y = cvt_pk(a[2], a[3]); w.z = cvt_pk(b[0], b[1]); w.w = cvt_pk(b[2], b[3]); return __builtin_bit_cast(bf16x8, w); }

struct Args { const float* in[29]; float* out; unsigned char* ws; };

__device__ __forceinline__ const float* xsrc_row(const Args& a, int row) {
    if (row < TP) { const int b = row / LP, t = row - b * LP; return t < 16 ? a.in[7] + (size_t)t * DM : a.in[0] + ((size_t)b * 2048 + (t - 16)) * DM; }
    return a.in[1] + (size_t)(row - TP) * DM;
}

namespace pg8 {
constexpr int BM = 256, BK = 64, HALF = 128, HTB = HALF * BK * 2, STAGE_BYTES = 8 * HTB, NXCD = 8, WGM = 8;
__device__ __forceinline__ int lds_byte(int r, int c) { const int st = (r >> 4) * 2 + (c >> 5), rr = r & 15, cc = c & 31, ob = rr * 64 + cc * 2; return st * 1024 + (ob ^ (((ob >> 9) & 1) << 5)); }
__device__ __forceinline__ void stage_rc(int b, int& R, int& C) { const int st = b / 1024, sb = b % 1024, swz = sb ^ (((sb >> 9) & 1) << 5); R = (st >> 1) * 16 + swz / 64; C = (st & 1) * 32 + (swz % 64) / 2; }
__device__ __forceinline__ int perm32(int rho) { const int n = rho >> 4, i = rho & 15; return 8 * (i >> 2) + 4 * n + (i & 3); }
struct Unit { int pm, pn, k0, nt, split; };
struct StaticOrder {
    int nM, nN, nwg, G, c, ntf, nfull, nsub, nsplit;
    __device__ __forceinline__ void init(int nM_, int nN_, int G_, int c_, int ntf_, bool SPLIT) { nM = nM_; nN = nN_; nwg = nM * nN; G = G_; c = c_; ntf = ntf_;
        nfull = nwg; nsub = 0; nsplit = 1;
        if (SPLIT && G == 256 && nN == 4 && nM > 64) { nsplit = ntf / 4; nfull = 256; nsub = (nM - 64) * 4 * nsplit; nM = 64; nwg = 256; } }
    __device__ __forceinline__ bool next(int i, Unit& u) const {
        const int L = i * G + c;
        const bool sub = L >= nfull; const int s = L - nfull;
        if (sub && s >= nsub) return false;
        int wgid = sub ? 0 : L;
        { const int q = nwg / NXCD, r = nwg % NXCD, xcd = wgid % NXCD, off = wgid / NXCD; wgid = (xcd < r ? xcd * (q + 1) : r * (q + 1) + (xcd - r) * q) + off; }
        const int nig = WGM * nN, gid = wgid / nig, fm = gid * WGM, gsz = (nM - fm) < WGM ? (nM - fm) : WGM;
        const int pm_f = fm + ((wgid % nig) % gsz), pn_f = (wgid % nig) / gsz;
        const int tl = s / nsplit, ks = s - tl * nsplit;
        u.pm = sub ? 64 + (tl >> 2) : pm_f; u.pn = sub ? (tl & 3) : pn_f; u.k0 = sub ? ks * 4 : 0; u.nt = sub ? 4 : ntf; u.split = sub ? 1 : 0;
        return true;
    }
};

template <class Epi, int AMODE, bool SPLIT = false>
__device__ __forceinline__ void gemm_phase(LAS unsigned char* lds, const bf16_t* Abase, const bf16_t* Btbase, const int K, const StaticOrder& S, const Epi& E) {
    int tid = threadIdx.x; asm volatile("" : "+v"(tid));
    const int wid = __builtin_amdgcn_readfirstlane(tid >> 6), lane = tid & 63, wr = wid >> 2, wc = wid & 3, fr = lane & 15, fq = lane >> 4;
    unsigned voffA[2], voffB[2];
#pragma unroll
    for (int i = 0; i < 2; ++i) { int R, C; stage_rc(tid * 16 + i * 8192, R, C); const int Rb = Epi::PERM ? ((R & ~31) + perm32(R & 31)) : R;
        const int Ra = AMODE ? (R < 64 ? R : R - 2) : R;
        voffA[i] = (unsigned)(Ra * K + C) * 2u; voffB[i] = (unsigned)(Rb * K + C) * 2u; }
    const size_t kstep = (size_t)(BK * 2);
    const size_t hstepB = (size_t)HALF * K * 2, tstepB = 2 * hstepB;
    const size_t hstepA = (size_t)(AMODE ? 124 : 128) * K * 2, tstepA = 2 * hstepA;
    const unsigned ldsw = (unsigned)wid * 1024u;
    const int aoff = lds_byte(wr * 64 + fr, fq * 8), boff = lds_byte(wc * 32 + fr, fq * 8);
#define PG8_SA(b, h) (((b) * 2 + (h)) * HTB)
#define PG8_SB(b, h) ((4 + (b) * 2 + (h)) * HTB)
#define PG8_STAGE(bufoff, gbase, voff) do { _Pragma("unroll") for (int _i = 0; _i < 2; ++_i) \
        __builtin_amdgcn_global_load_lds((const unsigned*)((const char*)(gbase) + (voff)[_i]), (LAS unsigned*)(lds + (bufoff) + ldsw + _i * 8192), 16, 0, 0); } while (0)
#define PG8_LDA(dst, b, h) do { _Pragma("unroll") for (int m = 0; m < 4; ++m) _Pragma("unroll") for (int k = 0; k < 2; ++k) dst[m][k] = *(const LAS bf16x8*)(lds + PG8_SA(b, h) + aoff + m * 2048 + k * 1024); } while (0)
#define PG8_LDB(dst, b, h) do { _Pragma("unroll") for (int n = 0; n < 2; ++n) _Pragma("unroll") for (int k = 0; k < 2; ++k) dst[n][k] = *(const LAS bf16x8*)(lds + PG8_SB(b, h) + boff + n * 2048 + k * 1024); } while (0)
#define PG8_MMA(ai, bj, At, Bt) do { __builtin_amdgcn_s_setprio(1); _Pragma("unroll") for (int m = 0; m < 4; ++m) _Pragma("unroll") for (int n = 0; n < 2; ++n) _Pragma("unroll") for (int k = 0; k < 2; ++k) \
        acc[ai][bj][m][n] = __builtin_amdgcn_mfma_f32_16x16x32_bf16(Bt[n][k], At[m][k], acc[ai][bj][m][n], 0, 0, 0); __builtin_amdgcn_s_setprio(0); } while (0)
#define PG8_WAIT_V(n) asm volatile("s_waitcnt vmcnt(" #n ")" ::: "memory")
#define PG8_WAIT_L(n) asm volatile("s_waitcnt lgkmcnt(" #n ")" ::: "memory")
#define PG8_BAR __builtin_amdgcn_s_barrier()
#define PG8_SCHED __builtin_amdgcn_sched_barrier(0)
    Unit cur, nxt; int ui = 0;
    if (!S.next(0, cur)) return;
    f32x4 acc[2][2][4][2];
#pragma unroll
    for (int a = 0; a < 2; ++a)
#pragma unroll
        for (int b = 0; b < 2; ++b)
#pragma unroll
            for (int m = 0; m < 4; ++m)
#pragma unroll
                for (int n = 0; n < 2; ++n) acc[a][b][m][n] = (f32x4){0.f, 0.f, 0.f, 0.f};
    bf16x8 At[4][2], B0[2][2], B1[2][2];
    const char* cA = (const char*)Abase + (size_t)cur.pm * tstepA + (SPLIT ? (size_t)cur.k0 * kstep : 0); const char* cB = (const char*)Btbase + (size_t)cur.pn * tstepB + (SPLIT ? (size_t)cur.k0 * kstep : 0);
    PG8_STAGE(PG8_SB(0, 0), cB, voffB); PG8_STAGE(PG8_SA(0, 0), cA, voffA); PG8_STAGE(PG8_SB(0, 1), cB + hstepB, voffB); PG8_STAGE(PG8_SA(0, 1), cA + hstepA, voffA);
    if (wr == 1) PG8_BAR;
    PG8_WAIT_V(4); PG8_BAR;
    PG8_STAGE(PG8_SB(1, 0), cB + kstep, voffB); PG8_STAGE(PG8_SA(1, 0), cA + kstep, voffA); PG8_STAGE(PG8_SB(1, 1), cB + hstepB + kstep, voffB);
    PG8_WAIT_V(6); PG8_BAR;
    for (;;) {
        const bool has_next = S.next(ui + 1, nxt);
        const char* nA = has_next ? (const char*)Abase + (size_t)nxt.pm * tstepA + (SPLIT ? (size_t)nxt.k0 * kstep : 0) : cA; const char* nB = has_next ? (const char*)Btbase + (size_t)nxt.pn * tstepB + (SPLIT ? (size_t)nxt.k0 * kstep : 0) : cB;
        const int nt = SPLIT ? cur.nt : K / BK;
        for (int t = 0; t < nt; t += 2) {
            const bool last = (t == nt - 2);
            const char* a1 = cA + (size_t)(t + 1) * kstep;
            const char* a2 = last ? nA : cA + (size_t)(t + 2) * kstep; const char* b2 = last ? nB : cB + (size_t)(t + 2) * kstep;
            const char* a3 = a2 + kstep; const char* b3 = b2 + kstep;
            PG8_LDB(B0, 0, 0); PG8_SCHED; PG8_LDA(At, 0, 0); PG8_STAGE(PG8_SA(1, 1), a1 + hstepA, voffA);
            PG8_WAIT_L(8); PG8_BAR; PG8_WAIT_L(0); PG8_MMA(0, 0, At, B0); PG8_BAR; PG8_SCHED;
            PG8_LDB(B1, 0, 1); PG8_STAGE(PG8_SB(0, 0), b2, voffB);
            PG8_BAR; PG8_WAIT_L(0); PG8_MMA(0, 1, At, B1); PG8_BAR;
            PG8_LDA(At, 0, 1); PG8_STAGE(PG8_SA(0, 0), a2, voffA);
            PG8_BAR; PG8_WAIT_L(0); PG8_MMA(1, 0, At, B0); PG8_BAR; PG8_SCHED;
            PG8_STAGE(PG8_SB(0, 1), b2 + hstepB, voffB);
            PG8_WAIT_V(6); PG8_BAR; PG8_MMA(1, 1, At, B1); PG8_BAR;
            PG8_LDB(B0, 1, 0); PG8_SCHED; PG8_LDA(At, 1, 0); PG8_STAGE(PG8_SA(0, 1), a2 + hstepA, voffA);
            PG8_WAIT_L(8); PG8_BAR; PG8_WAIT_L(0); PG8_MMA(0, 0, At, B0); PG8_BAR; PG8_SCHED;
            PG8_LDB(B1, 1, 1); PG8_STAGE(PG8_SB(1, 0), b3, voffB);
            PG8_BAR; PG8_WAIT_L(0); PG8_MMA(0, 1, At, B1); PG8_BAR;
            PG8_LDA(At, 1, 1); PG8_STAGE(PG8_SA(1, 0), a3, voffA);
            PG8_BAR; PG8_WAIT_L(0); PG8_MMA(1, 0, At, B0); PG8_BAR; PG8_SCHED;
            PG8_STAGE(PG8_SB(1, 1), b3 + hstepB, voffB);
            PG8_WAIT_V(6); PG8_BAR; PG8_MMA(1, 1, At, B1); PG8_BAR;
        }
        E(acc, cur, wr, wc, fr, fq);
        if (!has_next) break;
#pragma unroll
        for (int a = 0; a < 2; ++a)
#pragma unroll
            for (int b = 0; b < 2; ++b)
#pragma unroll
                for (int m = 0; m < 4; ++m)
#pragma unroll
                    for (int n = 0; n < 2; ++n) acc[a][b][m][n] = (f32x4){0.f, 0.f, 0.f, 0.f};
        cur = nxt; cA = nA; cB = nB; ++ui;
    }
    PG8_WAIT_V(0);
    if (wr == 0) PG8_BAR;
    PG8_BAR;
#undef PG8_SA
#undef PG8_SB
#undef PG8_STAGE
#undef PG8_LDA
#undef PG8_LDB
#undef PG8_MMA
#undef PG8_WAIT_V
#undef PG8_WAIT_L
#undef PG8_BAR
#undef PG8_SCHED
}

struct EpiBf16 {
    static constexpr bool PERM = true;
    bf16_t* O; int ldc;
    __device__ __forceinline__ void operator()(const f32x4 (&acc)[2][2][4][2], const Unit& u, int wr, int wc, int fr, int fq) const {
        const int row0 = u.pm * BM + wr * 64 + fr, col0 = u.pn * BM + wc * 32 + 8 * fq;
#pragma unroll
        for (int ai = 0; ai < 2; ++ai)
#pragma unroll
            for (int m = 0; m < 4; ++m) { bf16_t* rowp = O + (size_t)(row0 + ai * HALF + m * 16) * ldc + col0;
#pragma unroll
                for (int bj = 0; bj < 2; ++bj) { const f32x4 v0 = acc[ai][bj][m][0], v1 = acc[ai][bj][m][1];
                    u32x4 w; w.x = cvt_pk(v0[0], v0[1]); w.y = cvt_pk(v0[2], v0[3]); w.z = cvt_pk(v1[0], v1[1]); w.w = cvt_pk(v1[2], v1[3]);
                    *(u32x4*)(rowp + bj * HALF) = w; } }
    }
};
template <int MODE, bool SPLIT> struct EpiRes {
    static constexpr bool PERM = false;
    bf16_t* Y; Args a; bf16_t* PART;
    __device__ __forceinline__ void operator()(const f32x4 (&acc)[2][2][4][2], const Unit& u, int wr, int wc, int fr, int fq) const {
        const int row0 = u.pm * BM + wr * 64 + fr, col0 = u.pn * BM + wc * 32 + 4 * fq;
#pragma unroll
        for (int ai = 0; ai < 2; ++ai)
#pragma unroll
            for (int m = 0; m < 4; ++m) { const int row = row0 + ai * HALF + m * 16;
                if (row < T) { bf16_t* yp = Y + (size_t)row * DM + col0;
                    if (SPLIT && u.split) { bf16_t* pp = PART + ((size_t)(u.k0 >> 2) * 1152 + (row - 16384)) * DM + col0;
#pragma unroll
                        for (int bj = 0; bj < 2; ++bj)
#pragma unroll
                            for (int n = 0; n < 2; ++n) { const f32x4 v = acc[ai][bj][m][n]; u32x2 w; w.x = cvt_pk(v[0], v[1]); w.y = cvt_pk(v[2], v[3]); *(u32x2*)(pp + bj * HALF + n * 16) = w; }
                    } else if (MODE == 0) { const float* rp = xsrc_row(a, row) + col0;
#pragma unroll
                        for (int bj = 0; bj < 2; ++bj)
#pragma unroll
                            for (int n = 0; n < 2; ++n) { const f32x4 v = *(const f32x4*)(rp + bj * HALF + n * 16) * ALPHA + acc[ai][bj][m][n];
                                u32x2 w; w.x = cvt_pk(v[0], v[1]); w.y = cvt_pk(v[2], v[3]); *(u32x2*)(yp + bj * HALF + n * 16) = w; }
                    } else {
#pragma unroll
                        for (int bj = 0; bj < 2; ++bj)
#pragma unroll
                            for (int n = 0; n < 2; ++n) { const u32x2 r = *(const u32x2*)(yp + bj * HALF + n * 16);
                                const f32x4 v = (f32x4){bflo(r.x), bfhi(r.x), bflo(r.y), bfhi(r.y)} * ALPHA + acc[ai][bj][m][n];
                                u32x2 w; w.x = cvt_pk(v[0], v[1]); w.y = cvt_pk(v[2], v[3]); *(u32x2*)(yp + bj * HALF + n * 16) = w; }
                    } } }
    }
};
struct EpiFFN {
    static constexpr bool PERM = true;
    bf16_t* H; const float* cw; const float* cbias; const float* sbuf; float* out_p; float* out_s;
    __device__ __forceinline__ void operator()(const f32x4 (&acc)[2][2][4][2], const Unit& u, int wr, int wc, int fr, int fq) const {
        const int colb = u.pn * 128 + wc * 32 + 8 * fq;
        f32x4 w0[2], w1[2], w2[2], cbv[2];
#pragma unroll
        for (int n = 0; n < 2; ++n) { w0[n] = *(const f32x4*)(cw + colb + 4 * n); w1[n] = *(const f32x4*)(cw + DFF + colb + 4 * n); w2[n] = *(const f32x4*)(cw + 2 * DFF + colb + 4 * n); cbv[n] = *(const f32x4*)(cbias + colb + 4 * n); }
#pragma unroll
        for (int ai = 0; ai < 2; ++ai) {
            const int base = u.pm * 248 + ai * 124 + wr * 62 - 2;
#pragma unroll
            for (int m = 0; m < 4; ++m) {
                const int rb = 16 * m + fr, gr = base + rb;
                f32x4 cur[2], p1[2], p2[2];
#pragma unroll
                for (int n = 0; n < 2; ++n) { cur[n] = acc[ai][0][m][n];
#pragma unroll
                    for (int j = 0; j < 4; ++j) {
                        float b1 = 0.f, b2 = 0.f;
                        if (m > 0) { b1 = ror1(acc[ai][0][m > 0 ? m - 1 : 0][n][j]); b2 = ror2(acc[ai][0][m > 0 ? m - 1 : 0][n][j]); }
                        p1[n][j] = __int_as_float(__builtin_amdgcn_update_dpp(__float_as_int(b1), __float_as_int(cur[n][j]), 0x111, 0xf, 0xf, false));
                        p2[n][j] = __int_as_float(__builtin_amdgcn_update_dpp(__float_as_int(b2), __float_as_int(cur[n][j]), 0x112, 0xf, 0xf, false)); } }
                if (rb >= 2 && gr < T) {
                    const bool smp = gr >= TP; int b, t;
                    if (!smp) { b = gr / LP; t = gr - b * LP; } else { b = (gr - TP) >> 3; t = (gr - TP) & 7; }
                    if (t < 2) {
#pragma unroll
                        for (int n = 0; n < 2; ++n) { f32x4 q0 = (f32x4){0.f, 0.f, 0.f, 0.f}, q1 = q0;
                            if (smp) { q0 = *(const f32x4*)(sbuf + ((size_t)b * 2 + 0) * DFF + colb + 4 * n); q1 = *(const f32x4*)(sbuf + ((size_t)b * 2 + 1) * DFF + colb + 4 * n); }
                            if (t == 0) { p2[n] = q0; p1[n] = q1; } else { p2[n] = q1; } }
                    }
                    f32x4 hv[2];
#pragma unroll
                    for (int n = 0; n < 2; ++n) { const f32x4 y = cbv[n] + w0[n] * p2[n] + w1[n] * p1[n] + w2[n] * cur[n]; const f32x4 v = acc[ai][1][m][n];
#pragma unroll
                        for (int j = 0; j < 4; ++j) hv[n][j] = gelu_tanh(y[j]) * v[j]; }
                    u32x4 w; w.x = cvt_pk(hv[0][0], hv[0][1]); w.y = cvt_pk(hv[0][2], hv[0][3]); w.z = cvt_pk(hv[1][0], hv[1][1]); w.w = cvt_pk(hv[1][2], hv[1][3]);
                    *(u32x4*)(H + (size_t)gr * DFF + colb) = w;
                    const int L = smp ? 8 : LP;
                    if (t >= L - 2) { float* o = (smp ? out_s : out_p) + ((size_t)b * 2 + (t - (L - 2))) * DFF + colb; *(f32x4*)o = cur[0]; *(f32x4*)(o + 4) = cur[1]; }
                }
            }
        }
    }
};
}

__device__ __forceinline__ void p0_transpose_item(const float* W, int K, int N, bf16_t* WT, bool upmap, LAS float* scr, int item, int lane) {
    const int nblk = N / 32, kb = item / nblk, nb = item % nblk, k0 = 64 * kb, n0 = 32 * nb;
#pragma unroll 8
    for (int i = 0; i < 32; ++i) { const int kk = 2 * i + (lane >> 5); scr[kk * 33 + (lane & 31)] = W[(size_t)(k0 + kk) * N + n0 + (lane & 31)]; }
    asm volatile("s_waitcnt lgkmcnt(0)" ::: "memory");
    int r0 = n0;
    if (upmap) { r0 = n0 < DFF ? (n0 / 128) * 256 + (n0 % 128) : ((n0 - DFF) / 128) * 256 + 128 + ((n0 - DFF) % 128); }
    const int c = lane & 7;
#pragma unroll
    for (int j = 0; j < 4; ++j) { const int n = (lane >> 3) + 8 * j; const LAS float* s = scr + (8 * c) * 33 + n;
        u32x4 o; o.x = cvt_pk(s[0 * 33], s[1 * 33]); o.y = cvt_pk(s[2 * 33], s[3 * 33]); o.z = cvt_pk(s[4 * 33], s[5 * 33]); o.w = cvt_pk(s[6 * 33], s[7 * 33]);
        *(u32x4*)(WT + (size_t)(r0 + n) * K + k0 + 8 * c) = o; }
    asm volatile("s_waitcnt lgkmcnt(0)" ::: "memory");
}

__device__ __forceinline__ void convert_weights(const Args& a, LAS unsigned char* lds, int set, int widx, int nw, int wave, int lane) {
    unsigned char* ws = a.ws;
    LAS float* scr = (LAS float*)(lds + wave * 16384);
    constexpr int I0 = 16 * 128, I1 = 16 * 32, I2 = 16 * 64, I3 = 16 * 8, I4 = 16 * 32, I5 = 16 * 176, I6 = 44 * 32;
    if (set == 0) {
        for (int r = widx; r < I0; r += nw) p0_transpose_item(a.in[8], 1024, 4096, (bf16_t*)(ws + OFF_W_INAB), false, scr, r, lane);
    } else if (set == 1) {
        for (int it = widx; it < I1 + I5 + I6; it += nw) { int r = it;
            if (r < I1) { p0_transpose_item(a.in[9], 1024, 1024, (bf16_t*)(ws + OFF_W_OUTAB), false, scr, r, lane); continue; } r -= I1;
            if (r < I5) { p0_transpose_item(a.in[25], 1024, 5632, (bf16_t*)(ws + OFF_W_UP0), true, scr, r, lane); continue; } r -= I5;
            p0_transpose_item(a.in[28], 2816, 1024, (bf16_t*)(ws + OFF_W_DN0), false, scr, r, lane); }
    } else {
        for (int it = widx; it < I2 + I3 + I4 + I5 + I6; it += nw) { int r = it;
            if (r < I2) { p0_transpose_item(a.in[12], 1024, 2048, (bf16_t*)(ws + OFF_W_INC), false, scr, r, lane); continue; } r -= I2;
            if (r < I3) { const int mat = r >> 3, sub = r & 7, n = mat >> 1, gate = mat & 1;
                p0_transpose_item(a.in[gate ? 17 : 15] + (size_t)n * 16384, 128, 128, (bf16_t*)(ws + OFF_WG) + (size_t)(n * 2 + gate) * 16384, false, scr, sub, lane); continue; } r -= I3;
            if (r < I4) { p0_transpose_item(a.in[20], 1024, 1024, (bf16_t*)(ws + OFF_W_OUTC), false, scr, r, lane); continue; } r -= I4;
            if (r < I5) { p0_transpose_item(a.in[25] + (size_t)1024 * 5632, 1024, 5632, (bf16_t*)(ws + OFF_W_UP1), true, scr, r, lane); continue; } r -= I5;
            p0_transpose_item(a.in[28] + (size_t)2816 * 1024, 2816, 1024, (bf16_t*)(ws + OFF_W_DN1), false, scr, r, lane); }
    }
}
__device__ __forceinline__ void phase_p0(const Args& a, LAS unsigned char* lds, int gw, int NGW, int wave, int lane) {
    unsigned char* ws = a.ws;
    convert_weights(a, lds, 0, gw, NGW, wave, lane);
    bf16_t* XB = (bf16_t*)(ws + OFF_XB);
    for (int row0 = gw; row0 < T; row0 += 4 * NGW) {
        f32x4 v[4][4];
#pragma unroll
        for (int q = 0; q < 4; ++q) { const int row = row0 + q * NGW; if (row < T) { const f32x4* xr = (const f32x4*)xsrc_row(a, row) + lane;
#pragma unroll
            for (int j = 0; j < 4; ++j) v[q][j] = xr[64 * j]; } }
#pragma unroll
        for (int q = 0; q < 4; ++q) { const int row = row0 + q * NGW; if (row < T) { u32x2* o = (u32x2*)(XB + (size_t)row * DM) + lane;
#pragma unroll
            for (int j = 0; j < 4; ++j) { u32x2 w; w.x = cvt_pk(v[q][j][0], v[q][j][1]); w.y = cvt_pk(v[q][j][2], v[q][j][3]); o[64 * j] = w; } } }
    }
    const int gt = gw * 64 + lane, NGT = NGW * 64;
    float* ROPE = (float*)(ws + OFF_ROPE);
    for (int e = gt; e < 2072 * 64; e += NGT) {
        const int pi = e >> 6, i = e & 63; const int pos = pi < 2064 ? pi : 16384 + (pi - 2064);
        const float inv = (float)exp(-(double)i * (9.210340371976184 / 64.0));
        const float ang = (float)pos * inv;
        double rev = (double)ang * 0.15915494309189535; rev -= rint(rev);
        const float r = (float)(rev * 6.283185307179586);
        ROPE[2 * e] = cosf(r); ROPE[2 * e + 1] = sinf(r);
    }
    if (gt < 512) { const float* lg = a.in[10]; const float l0 = lg[gt], l1 = lg[512 + gt], l2 = lg[1024 + gt]; const float mx = fmaxf(l0, fmaxf(l1, l2));
        const float e0 = expf(l0 - mx), e1 = expf(l1 - mx), e2 = expf(l2 - mx); ((float*)(ws + OFF_LBV))[gt] = e0 / (e0 + e1 + e2); }
    if (gt < 1024) { const float lam = a.in[19][gt]; ((float*)(ws + OFF_C8))[gt] = -8.f * (lam > 0.f ? log1pf(expf(-lam)) : (log1pf(expf(lam)) - lam)); }
}

__device__ __forceinline__ void sub_geom(int s, int& row0, int& ntok, int& pidx0) {
    if (s < NS_P) { const int b = s / NSUBP, j = s - b * NSUBP; row0 = b * LP + 16 * j; ntok = 16; pidx0 = 16 * j; }
    else { const int b = s - NS_P; row0 = TP + 8 * b; ntok = 8; pidx0 = 2064; }
}

__device__ __forceinline__ void t_load(const bf16_t* PROJ, int it, int rot, int lane, unsigned (&qa)[8], unsigned (&qb)[8], unsigned (&ka)[8], unsigned (&kb)[8], unsigned (&va)[8], unsigned (&vb)[8]) {
    const int c2 = lane & 31, th = lane >> 5, ca = 2 * c2, cb = ca + 64;
    const int s = it >> 3, h = (it + rot) & 7; int row0, ntok, pidx0; sub_geom(s, row0, ntok, pidx0);
    const bool ret = h < 4; const int hh = h & 3;
    const int qc = (ret ? 0 : 2048) + 128 * hh, kc = (ret ? 512 : 2560) + 128 * hh, vc = (ret ? 1024 : 3072) + 128 * hh;
    const bool act = 8 * th < ntok;
#pragma unroll
    for (int ii = 0; ii < 8; ++ii) { qa[ii] = qb[ii] = ka[ii] = kb[ii] = va[ii] = vb[ii] = 0u;
        if (act) { const bf16_t* p = PROJ + (size_t)(row0 + 8 * th + ii) * 4096;
            qa[ii] = *(const unsigned*)(p + qc + ca); qb[ii] = *(const unsigned*)(p + qc + cb);
            ka[ii] = *(const unsigned*)(p + kc + ca); kb[ii] = *(const unsigned*)(p + kc + cb);
            va[ii] = *(const unsigned*)(p + vc + ca); vb[ii] = *(const unsigned*)(p + vc + cb); } }
}
__device__ __forceinline__ void phase_T(const Args& a, int gw, int NGW, int lane) {
    unsigned char* ws = a.ws;
    bf16_t* PROJ = (bf16_t*)(ws + OFF_BIG); bf16_t* KTT = (bf16_t*)(ws + OFF_XB); float* G = (float*)(ws + OFF_G);
    const float* ROPE = (const float*)(ws + OFF_ROPE); const float* LBV = (const float*)(ws + OFF_LBV);
    const int c2 = lane & 31, th = lane >> 5, ca = 2 * c2, cb = ca + 64;
    unsigned qa[8], qb[8], ka[8], kb[8], va[8], vb[8], qan[8], qbn[8], kan[8], kbn[8], van[8], vbn[8];
    if (gw < NS * 8) t_load(PROJ, gw, 0, lane, qa, qb, ka, kb, va, vb);
    int rot = 0;
    for (int it = gw; it < NS * 8; it += NGW) {
        if (it + NGW < NS * 8) t_load(PROJ, it + NGW, rot + 4, lane, qan, qbn, kan, kbn, van, vbn);
        const int s = it >> 3, h = (it + rot) & 7; int row0, ntok, pidx0; sub_geom(s, row0, ntok, pidx0);
        const bool ret = h < 4; const int hh = h & 3;
        const int qc = (ret ? 0 : 2048) + 128 * hh, kc = (ret ? 512 : 2560) + 128 * hh, vc = (ret ? 1024 : 3072) + 128 * hh;
        const bool act = 8 * th < ntok;
        unsigned kta[8], ktb[8];
        float g0, g1, g2, g3;
        if (ret) {
            const float lf = log1pf(-exp2f(-5.f - (float)hh));
            g0 = g1 = g2 = g3 = __expf(lf * (float)ntok);
#pragma unroll
            for (int ii = 0; ii < 8; ++ii) {
                kta[ii] = 0u; ktb[ii] = 0u;
                if (act) {
                    const int i = 8 * th + ii; const f32x4 cs = *(const f32x4*)(ROPE + ((size_t)(pidx0 + i) * 64 + ca) * 2);
                    const float eq = __expf(lf * (float)(i + 1)), ek = __expf(-lf * (float)(i + 1)) * 0.08838834764831845f;
                    const float q1l = bflo(qa[ii]), q1h = bfhi(qa[ii]), q2l = bflo(qb[ii]), q2h = bfhi(qb[ii]);
                    const float k1l = bflo(ka[ii]), k1h = bfhi(ka[ii]), k2l = bflo(kb[ii]), k2h = bfhi(kb[ii]);
                    const unsigned qoa = cvt_pk((q1l * cs[0] - q2l * cs[1]) * eq, (q1h * cs[2] - q2h * cs[3]) * eq);
                    const unsigned qob = cvt_pk((q1l * cs[1] + q2l * cs[0]) * eq, (q1h * cs[3] + q2h * cs[2]) * eq);
                    kta[ii] = cvt_pk((k1l * cs[0] - k2l * cs[1]) * ek, (k1h * cs[2] - k2h * cs[3]) * ek);
                    ktb[ii] = cvt_pk((k1l * cs[1] + k2l * cs[0]) * ek, (k1h * cs[3] + k2h * cs[2]) * ek);
                    bf16_t* p = PROJ + (size_t)(row0 + i) * 4096;
                    *(unsigned*)(p + qc + ca) = qoa; *(unsigned*)(p + qc + cb) = qob; *(unsigned*)(p + kc + ca) = kta[ii]; *(unsigned*)(p + kc + cb) = ktb[ii];
                }
            }
        } else {
            const f32x2 lba = *(const f32x2*)(LBV + 128 * hh + ca), lbb = *(const f32x2*)(LBV + 128 * hh + cb);
            float lfv[8][4], kv[8][4]; float t0 = 0.f, t1 = 0.f, t2 = 0.f, t3 = 0.f;
#pragma unroll
            for (int ii = 0; ii < 8; ++ii) {
                const float f0 = lba.x + (1.f - lba.x) * sigmoidf_(bflo(ka[ii])), f1 = lba.y + (1.f - lba.y) * sigmoidf_(bfhi(ka[ii]));
                const float f2 = lbb.x + (1.f - lbb.x) * sigmoidf_(bflo(kb[ii])), f3 = lbb.y + (1.f - lbb.y) * sigmoidf_(bfhi(kb[ii]));
                lfv[ii][0] = act ? __logf(f0) : 0.f; lfv[ii][1] = act ? __logf(f1) : 0.f; lfv[ii][2] = act ? __logf(f2) : 0.f; lfv[ii][3] = act ? __logf(f3) : 0.f;
                kv[ii][0] = 1.f - f0; kv[ii][1] = 1.f - f1; kv[ii][2] = 1.f - f2; kv[ii][3] = 1.f - f3;
                t0 += lfv[ii][0]; t1 += lfv[ii][1]; t2 += lfv[ii][2]; t3 += lfv[ii][3];
            }
            const float o0 = __shfl_xor(t0, 32), o1 = __shfl_xor(t1, 32), o2 = __shfl_xor(t2, 32), o3 = __shfl_xor(t3, 32);
            float r0 = th ? o0 : 0.f, r1 = th ? o1 : 0.f, r2 = th ? o2 : 0.f, r3 = th ? o3 : 0.f;
            g0 = __expf(t0 + o0); g1 = __expf(t1 + o1); g2 = __expf(t2 + o2); g3 = __expf(t3 + o3);
#pragma unroll
            for (int ii = 0; ii < 8; ++ii) {
                kta[ii] = 0u; ktb[ii] = 0u;
                r0 += lfv[ii][0]; r1 += lfv[ii][1]; r2 += lfv[ii][2]; r3 += lfv[ii][3];
                if (act) {
                    const float e0 = __expf(r0), e1 = __expf(r1), e2 = __expf(r2), e3 = __expf(r3);
                    const unsigned qoa = cvt_pk(bflo(qa[ii]) * e0, bfhi(qa[ii]) * e1), qob = cvt_pk(bflo(qb[ii]) * e2, bfhi(qb[ii]) * e3);
                    kta[ii] = cvt_pk(kv[ii][0] * __builtin_amdgcn_rcpf(e0), kv[ii][1] * __builtin_amdgcn_rcpf(e1));
                    ktb[ii] = cvt_pk(kv[ii][2] * __builtin_amdgcn_rcpf(e2), kv[ii][3] * __builtin_amdgcn_rcpf(e3));
                    bf16_t* p = PROJ + (size_t)(row0 + 8 * th + ii) * 4096;
                    *(unsigned*)(p + qc + ca) = qoa; *(unsigned*)(p + qc + cb) = qob; *(unsigned*)(p + kc + ca) = kta[ii]; *(unsigned*)(p + kc + cb) = ktb[ii];
                }
            }
        }
        u32x4 kA0, kA1, kB0, kB1, vA0, vA1, vB0, vB1;
#pragma unroll
        for (int w = 0; w < 4; ++w) {
            kA0[w] = (kta[2 * w] & 0xffffu) | (kta[2 * w + 1] << 16); kA1[w] = (kta[2 * w] >> 16) | (kta[2 * w + 1] & 0xffff0000u);
            kB0[w] = (ktb[2 * w] & 0xffffu) | (ktb[2 * w + 1] << 16); kB1[w] = (ktb[2 * w] >> 16) | (ktb[2 * w + 1] & 0xffff0000u);
            vA0[w] = (va[2 * w] & 0xffffu) | (va[2 * w + 1] << 16); vA1[w] = (va[2 * w] >> 16) | (va[2 * w + 1] & 0xffff0000u);
            vB0[w] = (vb[2 * w] & 0xffffu) | (vb[2 * w + 1] << 16); vB1[w] = (vb[2 * w] >> 16) | (vb[2 * w + 1] & 0xffff0000u);
        }
        bf16_t* kt = KTT + (size_t)(s * 8 + h) * 2048 + 8 * th;
        *(u32x4*)(kt + ca * 16) = kA0; *(u32x4*)(kt + (ca + 1) * 16) = kA1; *(u32x4*)(kt + cb * 16) = kB0; *(u32x4*)(kt + (cb + 1) * 16) = kB1;
        if (act) {
            int lin;
            lin = ca * ntok + 8 * th;       *(u32x4*)(PROJ + (size_t)(row0 + (lin >> 7)) * 4096 + vc + (lin & 127)) = vA0;
            lin = (ca + 1) * ntok + 8 * th; *(u32x4*)(PROJ + (size_t)(row0 + (lin >> 7)) * 4096 + vc + (lin & 127)) = vA1;
            lin = cb * ntok + 8 * th;       *(u32x4*)(PROJ + (size_t)(row0 + (lin >> 7)) * 4096 + vc + (lin & 127)) = vB0;
            lin = (cb + 1) * ntok + 8 * th; *(u32x4*)(PROJ + (size_t)(row0 + (lin >> 7)) * 4096 + vc + (lin & 127)) = vB1;
        }
        if (th == 0) { float* gp = G + (size_t)(s * 8 + h) * 128; *(f32x2*)(gp + ca) = (f32x2){g0, g1}; *(f32x2*)(gp + cb) = (f32x2){g2, g3}; }
#pragma unroll
        for (int ii = 0; ii < 8; ++ii) { qa[ii] = qan[ii]; qb[ii] = qbn[ii]; ka[ii] = kan[ii]; kb[ii] = kbn[ii]; va[ii] = van[ii]; vb[ii] = vbn[ii]; }
        rot += 4;
    }
}

struct GlaOff { int v[2]; int kq; int ost[2][4]; int kt[8]; int g; int qc, kc; };
template <int NTOK>
__device__ __forceinline__ void gla_offsets(GlaOff& o, int h, int sl, int lane) {
    const int c = lane & 15, q4 = lane >> 4; const bool ret = h < 4; const int hh = h & 3;
    o.qc = (ret ? 0 : 2048) + 128 * hh; o.kc = (ret ? 512 : 2560) + 128 * hh; const int vc = (ret ? 1024 : 3072) + 128 * hh;
#pragma unroll
    for (int n = 0; n < 2; ++n) { const int lin = (32 * sl + 16 * n + c) * NTOK + 4 * q4; o.v[n] = (lin >> 7) * 4096 + vc + (lin & 127);
#pragma unroll
        for (int r = 0; r < 4; ++r) { const int l2 = 32 * sl * NTOK + (4 * q4 + r) * 32 + 16 * n + c; o.ost[n][r] = (l2 >> 7) * 4096 + vc + (l2 & 127); } }
    o.kq = c * 4096 + 8 * q4;
#pragma unroll
    for (int t = 0; t < 8; ++t) o.kt[t] = (32 * (t >> 1) + 8 * (c >> 2) + 4 * (t & 1) + (c & 3)) * 16 + 4 * q4;
    o.g = 8 * q4;
}
template <int NTOK>
__device__ __forceinline__ void gla_load_qkv(const bf16_t* pr, const GlaOff& o, int lane, bf16x4 (&vf)[2], bf16x8 (&kf)[4], bf16x8 (&qf)[4]) {
    const int c = lane & 15, q4 = lane >> 4;
#pragma unroll
    for (int n = 0; n < 2; ++n) { vf[n] = (bf16x4){0, 0, 0, 0}; if (NTOK == 16 || 4 * q4 < NTOK) vf[n] = *(const bf16x4*)(pr + o.v[n]); }
#pragma unroll
    for (int kk = 0; kk < 4; ++kk) { kf[kk] = (bf16x8){0, 0, 0, 0, 0, 0, 0, 0}; qf[kk] = kf[kk];
        if (NTOK == 16 || c < NTOK) { kf[kk] = *(const bf16x8*)(pr + o.kq + o.kc + 32 * kk); qf[kk] = *(const bf16x8*)(pr + o.kq + o.qc + 32 * kk); } }
}
template <int NTOK>
__device__ __forceinline__ void gla_step_state(const bf16_t* pr, const bf16_t* kt, const float* g, const GlaOff& o, int lane, f32x4 (&S)[8][2], f32x4 (&P)[8]) {
    const int q4 = lane >> 4;
    bf16x4 vf[2], kaf[8]; f32x4 gvf[8];
#pragma unroll
    for (int n = 0; n < 2; ++n) { vf[n] = (bf16x4){0, 0, 0, 0}; if (NTOK == 16 || 4 * q4 < NTOK) vf[n] = *(const bf16x4*)(pr + o.v[n]); }
#pragma unroll
    for (int t = 0; t < 8; ++t) { kaf[t] = *(const bf16x4*)(kt + o.kt[t]); gvf[t] = *(const f32x4*)(g + o.g + 32 * (t >> 1) + 4 * (t & 1)); }
#pragma unroll
    for (int t = 0; t < 8; ++t)
#pragma unroll
        for (int n = 0; n < 2; ++n) S[t][n] = mfma16(kaf[t], vf[n], S[t][n]);
#pragma unroll
    for (int t = 0; t < 8; ++t) { S[t][0] = S[t][0] * gvf[t]; S[t][1] = S[t][1] * gvf[t]; P[t] = P[t] * gvf[t]; }
}
template <int NTOK>
__device__ __forceinline__ void gla_step_emit(bf16_t* pr, const bf16_t* kt, const float* g, const GlaOff& o, int lane, f32x4 (&S)[8][2], bf16x4 (&vf)[2], bf16x8 (&kf)[4], bf16x8 (&qf)[4], const bf16_t* prn) {
    const int c = lane & 15, q4 = lane >> 4;
    bf16x4 kaf[8]; f32x4 gvf[8];
#pragma unroll
    for (int t = 0; t < 8; ++t) kaf[t] = *(const bf16x4*)(kt + o.kt[t]);
    f32x4 at = (f32x4){0.f, 0.f, 0.f, 0.f};
#pragma unroll
    for (int kk = 0; kk < 4; ++kk) at = mfma32(kf[kk], qf[kk], at);
#pragma unroll
    for (int r = 0; r < 4; ++r) if (4 * q4 + r > c) at[r] = 0.f;
    const bf16x4 pf = pack4(at);
    f32x4 ov[2];
#pragma unroll
    for (int n = 0; n < 2; ++n) { ov[n] = mfma16(pf, vf[n], (f32x4){0.f, 0.f, 0.f, 0.f});
#pragma unroll
        for (int kk = 0; kk < 4; ++kk) ov[n] = mfma32(qf[kk], pack8(S[2 * kk][n], S[2 * kk + 1][n]), ov[n]); }
#pragma unroll
    for (int t = 0; t < 8; ++t) gvf[t] = *(const f32x4*)(g + o.g + 32 * (t >> 1) + 4 * (t & 1));
#pragma unroll
    for (int n = 0; n < 2; ++n)
#pragma unroll
        for (int r = 0; r < 4; ++r) if (NTOK == 16 || 4 * q4 + r < NTOK) pr[o.ost[n][r]] = (bf16_t)(cvt_pk(ov[n][r], 0.f) & 0xffffu);
    bf16x4 vfc[2] = {vf[0], vf[1]};
    if (prn) gla_load_qkv<NTOK>(prn, o, lane, vf, kf, qf);
#pragma unroll
    for (int t = 0; t < 8; ++t)
#pragma unroll
        for (int n = 0; n < 2; ++n) S[t][n] = mfma16(kaf[t], vfc[n], S[t][n]);
#pragma unroll
    for (int t = 0; t < 8; ++t) { S[t][0] = S[t][0] * gvf[t]; S[t][1] = S[t][1] * gvf[t]; }
}
__device__ __forceinline__ void state_load(const float* p, int sl, f32x4 (&S)[8][2], int lane) {
    const int c = lane & 15, q4 = lane >> 4;
#pragma unroll
    for (int t = 0; t < 8; ++t)
#pragma unroll
        for (int n = 0; n < 2; ++n)
#pragma unroll
            for (int r = 0; r < 4; ++r) S[t][n][r] = p[(32 * (t >> 1) + 8 * q4 + 4 * (t & 1) + r) * 128 + 32 * sl + 16 * n + c];
}
__device__ __forceinline__ void state_store(float* p, int sl, const f32x4 (&S)[8][2], int lane) {
    const int c = lane & 15, q4 = lane >> 4;
#pragma unroll
    for (int t = 0; t < 8; ++t)
#pragma unroll
        for (int n = 0; n < 2; ++n)
#pragma unroll
            for (int r = 0; r < 4; ++r) p[(32 * (t >> 1) + 8 * q4 + 4 * (t & 1) + r) * 128 + 32 * sl + 16 * n + c] = S[t][n][r];
}
__device__ __forceinline__ void phase_A(const Args& a, int gw, int NGW, int lane) {
    unsigned char* ws = a.ws; const bf16_t* PROJ = (const bf16_t*)(ws + OFF_BIG); const bf16_t* KTT = (const bf16_t*)(ws + OFF_XB); const float* G = (const float*)(ws + OFF_G); float* U = (float*)(ws + OFF_U);
    float* GSP = (float*)(ws + OFF_GS);
    for (int it = gw; it < 64 * 8 * 4; it += NGW) {
        const int sl = it & 3, g = it >> 2, k = g & 7, bh = g >> 3, b = bh >> 3, h = bh & 7;
        const int j0 = k == 0 ? 0 : 16 * (k - 1) + 1, s0 = b * NSUBP + j0, ns = k == 0 ? 1 : 16;
        GlaOff o; gla_offsets<16>(o, h, sl, lane);
        const bf16_t* pr = PROJ + (size_t)(b * LP + 16 * j0) * 4096; const bf16_t* kt = KTT + (size_t)(s0 * 8 + h) * 2048; const float* gp = G + (size_t)(s0 * 8 + h) * 128;
        f32x4 S[8][2], P[8];
#pragma unroll
        for (int t = 0; t < 8; ++t) { S[t][0] = (f32x4){0.f, 0.f, 0.f, 0.f}; S[t][1] = S[t][0]; P[t] = (f32x4){1.f, 1.f, 1.f, 1.f}; }
        for (int j = 0; j < ns; ++j) { gla_step_state<16>(pr, kt, gp, o, lane, S, P); pr += 16 * 4096; kt += 8 * 2048; gp += 8 * 128; }
        state_store(U + (size_t)(bh * 8 + k) * 16384, sl, S, lane);
        if (sl == 0 && (lane & 15) == 0) { const int q4 = lane >> 4;
#pragma unroll
            for (int t = 0; t < 8; ++t) *(f32x4*)(GSP + (size_t)(bh * 8 + k) * 128 + 32 * (t >> 1) + 8 * q4 + 4 * (t & 1)) = P[t]; }
    }
}
__device__ __forceinline__ void phase_B(const Args& a, int gt, int NGT) {
    unsigned char* ws = a.ws; const float* GSP = (const float*)(ws + OFF_GS); float* U = (float*)(ws + OFF_U);
    for (int idx = gt; idx < 64 * 16384; idx += NGT) {
        const int bh = idx >> 14, e = idx & 16383, dk = e >> 7;
        float uv[8], gv[8];
#pragma unroll
        for (int k = 0; k < 8; ++k) { uv[k] = U[(size_t)(bh * 8 + k) * 16384 + e]; gv[k] = GSP[(size_t)(bh * 8 + k) * 128 + dk]; }
        float Sv = 0.f;
#pragma unroll
        for (int k = 0; k < 8; ++k) { Sv = gv[k] * Sv + uv[k]; U[(size_t)(bh * 8 + k) * 16384 + e] = Sv; }
    }
}
__device__ __forceinline__ void phase_C(const Args& a, int gw, int NGW, int lane) {
    unsigned char* ws = a.ws; bf16_t* PROJ = (bf16_t*)(ws + OFF_BIG); const bf16_t* KTT = (const bf16_t*)(ws + OFF_XB); const float* G = (const float*)(ws + OFF_G); const float* U = (const float*)(ws + OFF_U);
    const int nit = (2304 + 4096 - gw + NGW - 1) / NGW;
    for (int ii = 0; ii < nit; ++ii) {
        const int it = gw + ((gw & 1) ? (nit - 1 - ii) : ii) * NGW;
        const int sl = it & 3; f32x4 S[8][2]; bf16x4 vf[2]; bf16x8 kf[4], qf[4];
        if (it < 2304) {
            int bh, k; if (it < 2048) { const int g = it >> 2; bh = g >> 3; k = (g & 7) + 1; } else { bh = (it - 2048) >> 2; k = 0; }
            const int b = bh >> 3, h = bh & 7;
            if (k == 0) {
#pragma unroll
                for (int t = 0; t < 8; ++t) { S[t][0] = (f32x4){0.f, 0.f, 0.f, 0.f}; S[t][1] = S[t][0]; }
            } else state_load(U + (size_t)(bh * 8 + (k - 1)) * 16384, sl, S, lane);
            const int j0 = k == 0 ? 0 : 16 * (k - 1) + 1, s0 = b * NSUBP + j0, ns = k == 0 ? 1 : 16;
            GlaOff o; gla_offsets<16>(o, h, sl, lane);
            bf16_t* pr = PROJ + (size_t)(b * LP + 16 * j0) * 4096; const bf16_t* kt = KTT + (size_t)(s0 * 8 + h) * 2048; const float* gp = G + (size_t)(s0 * 8 + h) * 128;
            gla_load_qkv<16>(pr, o, lane, vf, kf, qf);
            for (int j = 0; j < ns; ++j) { gla_step_emit<16>(pr, kt, gp, o, lane, S, vf, kf, qf, j + 1 < ns ? pr + 16 * 4096 : nullptr); pr += 16 * 4096; kt += 8 * 2048; gp += 8 * 128; }
            if (k == 8) state_store(a.out + (h < 4 ? O_RETP : O_HGP) + (size_t)(b * 4 + (h & 3)) * 16384, sl, S, lane);
        } else {
            const int g = (it - 2304) >> 2, b = g >> 3, h = g & 7, s = NS_P + b;
            state_load(a.in[h < 4 ? 2 : 3] + (size_t)(b * 4 + (h & 3)) * 16384, sl, S, lane);
            GlaOff o; gla_offsets<8>(o, h, sl, lane);
            bf16_t* pr = PROJ + (size_t)(TP + 8 * b) * 4096;
            gla_load_qkv<8>(pr, o, lane, vf, kf, qf);
            gla_step_emit<8>(pr, KTT + (size_t)(s * 8 + h) * 2048, G + (size_t)(s * 8 + h) * 128, o, lane, S, vf, kf, qf, nullptr);
            state_store(a.out + (h < 4 ? O_RETS : O_HGS) + (size_t)(b * 4 + (h & 3)) * 16384, sl, S, lane);
        }
    }
}
__device__ __forceinline__ void d_load(const bf16_t* PROJ, int it, int lane, u32x4 (&xo)[4], u32x4 (&gx)[4]) {
    const int i = lane & 15, sl = lane >> 4;
    const int s = it >> 3, h = it & 7; int row0, ntok, pidx0; sub_geom(s, row0, ntok, pidx0);
    const bool ret = h < 4; const int hh = h & 3;
    const int vc = (ret ? 1024 : 3072) + 128 * hh, gc = (ret ? 1536 : 3584) + 128 * hh + 32 * sl;
    const int lin0 = 32 * sl * ntok + 32 * i;
    const bf16_t* op = PROJ + (size_t)(row0 + (lin0 >> 7)) * 4096 + vc + (lin0 & 127);
    const bf16_t* gp = PROJ + (size_t)(row0 + i) * 4096 + gc;
#pragma unroll
    for (int w = 0; w < 4; ++w) { xo[w] = (u32x4){0u, 0u, 0u, 0u}; gx[w] = xo[w]; if (i < ntok) { xo[w] = *(const u32x4*)(op + 8 * w); gx[w] = *(const u32x4*)(gp + 8 * w); } }
}
__device__ __forceinline__ void phase_D(const Args& a, int gw, int NGW, int lane) {
    unsigned char* ws = a.ws; const bf16_t* PROJ = (const bf16_t*)(ws + OFF_BIG); bf16_t* MIX = (bf16_t*)(ws + OFF_XB);
    const int i = lane & 15, sl = lane >> 4;
    f32x4 nwv[8];
#pragma unroll
    for (int w = 0; w < 8; ++w) nwv[w] = *(const f32x4*)(a.in[11] + 32 * sl + 4 * w);
    u32x4 xo[4], gx4[4], xon[4], gxn[4];
    if (gw < NS * 8) d_load(PROJ, gw, lane, xo, gx4);
    for (int it = gw; it < NS * 8; it += NGW) {
        if (it + NGW < NS * 8) d_load(PROJ, it + NGW, lane, xon, gxn);
        const int s = it >> 3, h = it & 7; int row0, ntok, pidx0; sub_geom(s, row0, ntok, pidx0);
        const bool ret = h < 4;
        const bool valid = i < ntok;
        float o[32];
#pragma unroll
        for (int w = 0; w < 4; ++w)
#pragma unroll
            for (int e = 0; e < 4; ++e) { o[8 * w + 2 * e] = bflo(xo[w][e]); o[8 * w + 2 * e + 1] = bfhi(xo[w][e]); }
        float sum = 0.f;
#pragma unroll
        for (int e = 0; e < 32; ++e) sum += o[e];
        sum += __shfl_xor(sum, 16); sum += __shfl_xor(sum, 32);
        const float mu = ret ? sum * (1.f / 128.f) : 0.f;
        float sq = 0.f;
#pragma unroll
        for (int e = 0; e < 32; ++e) { const float d = o[e] - mu; sq += d * d; }
        sq += __shfl_xor(sq, 16); sq += __shfl_xor(sq, 32);
        const float rstd = rsqrtf(sq * (1.f / 128.f) + LN_EPS);
        if (valid) {
            bf16_t* mp = MIX + (size_t)(row0 + i) * DM + 128 * h + 32 * sl;
#pragma unroll
            for (int w = 0; w < 4; ++w) { const u32x4 gx = gx4[w]; float r[8];
#pragma unroll
                for (int e = 0; e < 4; ++e) { const float g0 = bflo(gx[e]), g1 = bfhi(gx[e]);
                    float v0 = (o[8 * w + 2 * e] - mu) * rstd, v1 = (o[8 * w + 2 * e + 1] - mu) * rstd;
                    if (!ret) { v0 *= nwv[2 * w + (e >> 1)][2 * (e & 1)]; v1 *= nwv[2 * w + (e >> 1)][2 * (e & 1) + 1]; }
                    r[2 * e] = v0 * g0 * sigmoidf_(g0); r[2 * e + 1] = v1 * g1 * sigmoidf_(g1); }
                u32x4 ov; ov.x = cvt_pk(r[0], r[1]); ov.y = cvt_pk(r[2], r[3]); ov.z = cvt_pk(r[4], r[5]); ov.w = cvt_pk(r[6], r[7]);
                *(u32x4*)(mp + 8 * w) = ov; }
        }
#pragma unroll
        for (int w = 0; w < 4; ++w) { xo[w] = xon[w]; gx4[w] = gxn[w]; }
    }
}

template <bool FINAL, bool FROMX0 = false>
__device__ __forceinline__ void phase_LN(const Args& a, const float* gam, const float* bet, const bf16_t* PART, int nsplit, int gw, int NGW, int lane) {
    unsigned char* ws = a.ws; bf16_t* XR = (bf16_t*)(ws + OFF_X32);
    f32x4 gv[4], bv[4];
#pragma unroll
    for (int j = 0; j < 4; ++j) { gv[j] = ((const f32x4*)gam)[lane + 64 * j]; bv[j] = ((const f32x4*)bet)[lane + 64 * j]; }
    for (int row0 = gw; row0 < T; row0 += 4 * NGW) {
        f32x4 v[4][4];
#pragma unroll
        for (int q = 0; q < 4; ++q) { const int row = row0 + q * NGW;
            if (row < T) { const u32x2* xr = (const u32x2*)(XR + (size_t)row * DM) + lane;
#pragma unroll
                for (int j = 0; j < 4; ++j) { const u32x2 w = xr[64 * j]; v[q][j] = (f32x4){bflo(w.x), bfhi(w.x), bflo(w.y), bfhi(w.y)}; }
                if (FROMX0 && row >= 16384) { const f32x4* x0 = (const f32x4*)xsrc_row(a, row) + lane;
#pragma unroll
                    for (int j = 0; j < 4; ++j) v[q][j] = x0[64 * j]; }
                if (row >= 16384 && nsplit > 0) {
#pragma unroll
                    for (int j = 0; j < 4; ++j) v[q][j] = v[q][j] * ALPHA;
                    for (int s = 0; s < nsplit; ++s) { const u32x2* pr = (const u32x2*)(PART + ((size_t)s * 1152 + (row - 16384)) * DM) + lane;
#pragma unroll
                        for (int j = 0; j < 4; ++j) { const u32x2 w = pr[64 * j]; v[q][j] += (f32x4){bflo(w.x), bfhi(w.x), bflo(w.y), bfhi(w.y)}; } } } } }
#pragma unroll
        for (int q = 0; q < 4; ++q) { const int row = row0 + q * NGW;
            if (row < T) {
                float s = 0.f;
#pragma unroll
                for (int j = 0; j < 4; ++j) s += (v[q][j][0] + v[q][j][1]) + (v[q][j][2] + v[q][j][3]);
                const float mean = wave_sum(s) * (1.f / DM); float s2 = 0.f;
#pragma unroll
                for (int j = 0; j < 4; ++j) { v[q][j] = v[q][j] - mean; s2 += (v[q][j][0] * v[q][j][0] + v[q][j][1] * v[q][j][1]) + (v[q][j][2] * v[q][j][2] + v[q][j][3] * v[q][j][3]); }
                const float rstd = rsqrtf(wave_sum(s2) * (1.f / DM) + LN_EPS);
#pragma unroll
                for (int j = 0; j < 4; ++j) v[q][j] = v[q][j] * rstd * gv[j] + bv[j];
                if (FINAL) {
                    float* op = nullptr;
                    if (row < TP) { const int b = row / LP, t = row - b * LP; if (t >= 16) op = a.out + O_YP + ((size_t)b * 2048 + (t - 16)) * DM; }
                    else op = a.out + O_YS + (size_t)(row - TP) * DM;
                    if (op) {
#pragma unroll
                        for (int j = 0; j < 4; ++j) ((f32x4*)op)[lane + 64 * j] = v[q][j]; }
                } else {
                    u32x2* ob = (u32x2*)(XR + (size_t)row * DM) + lane;
#pragma unroll
                    for (int j = 0; j < 4; ++j) { u32x2 w; w.x = cvt_pk(v[q][j][0], v[q][j][1]); w.y = cvt_pk(v[q][j][2], v[q][j][3]); ob[64 * j] = w; }
                }
            } }
    }
}

__device__ __forceinline__ void phase_F1(const Args& a, LAS unsigned char* lds, int wave, int lane) {
    unsigned char* ws = a.ws; const bf16_t* __restrict__ GR = (const bf16_t*)(ws + OFF_H); const bf16_t* __restrict__ WG = (const bf16_t*)(ws + OFF_WG);
    bf16_t* __restrict__ HL = (bf16_t*)(ws + OFF_HL); bf16_t* __restrict__ AC = (bf16_t*)(ws + OFF_XB); float* __restrict__ TA = (float*)(ws + OFF_TA); float* __restrict__ TH = (float*)(ws + OFF_TH);
    const float* C8 = (const float*)(ws + OFF_C8);
    const float* convw = a.in[13]; const float* convb = a.in[14]; const float* bga = a.in[16]; const float* bgx = a.in[18];
    const int c = lane & 15, q4 = lane >> 4;
    const int n = blockIdx.x & 7;
    { const u32x4* wsrc = (const u32x4*)(WG + (size_t)n * 2 * 16384);
      for (int e = threadIdx.x; e < 4096; e += 512) { const int r = e >> 4, cc = e & 15; *(LAS u32x4*)(lds + r * 272 + cc * 16) = wsrc[e]; } }
    LAS float* cst = (LAS float*)(lds + 69632);
    for (int e = threadIdx.x; e < 1024; e += 512) { const int k = e >> 7, ch = 128 * n + (e & 127);
        cst[e] = k == 0 ? bga[ch] : k == 1 ? bgx[ch] : k == 2 ? C8[ch] : k < 7 ? convw[(k - 3) * 1024 + ch] : convb[ch]; }
    __syncthreads();
    for (int tt = ((int)blockIdx.x >> 3) * 8 + wave; tt < NTILE; tt += (int)(gridDim.x >> 3) * 8) {
        int row, b, t, W; bool smp;
        if (tt < NT_P) { b = tt / NSUBP; const int j = tt - b * NSUBP; row = b * LP + 16 * j + c; t = 16 * j + c; W = 16; smp = false; }
        else { const int k = tt - NT_P; row = TP + 16 * k + c; b = 2 * k + (c >> 3); t = c & 7; W = 8; smp = true; }
        const int chb = 128 * n;
        bf16x8 bfr[4];
#pragma unroll
        for (int q = 0; q < 4; ++q) bfr[q] = (bf16x8){0, 0, 0, 0, 0, 0, 0, 0};
#pragma unroll 2
        for (int kk = 0; kk < 4; ++kk) {
            const int ch0 = chb + 32 * kk + 8 * q4;
            const int cl0 = 32 * kk + 8 * q4;
            f32x4 s0 = *(const LAS f32x4*)(cst + 7 * 128 + cl0), s1 = *(const LAS f32x4*)(cst + 7 * 128 + cl0 + 4);
#pragma unroll
            for (int d = 0; d < 4; ++d) {
                const f32x4 wa = *(const LAS f32x4*)(cst + (3 + 3 - d) * 128 + cl0), wb = *(const LAS f32x4*)(cst + (3 + 3 - d) * 128 + cl0 + 4);
                f32x4 xa = (f32x4){0.f, 0.f, 0.f, 0.f}, xb = xa;
                if (t - d >= 0) { const u32x4 x = *(const u32x4*)(GR + (size_t)(row - d) * 2048 + 1024 + ch0);
                    xa = (f32x4){bflo(x[0]), bfhi(x[0]), bflo(x[1]), bfhi(x[1])}; xb = (f32x4){bflo(x[2]), bfhi(x[2]), bflo(x[3]), bfhi(x[3])}; }
                else if (smp) { const float* sp = a.in[5] + ((size_t)b * 3 + (t - d + 3)) * 1024 + ch0; xa = *(const f32x4*)sp; xb = *(const f32x4*)(sp + 4); }
                s0 += wa * xa; s1 += wb * xb;
            }
            { const bf16x8 pv = pack8(s0, s1);
#pragma unroll
              for (int q = 0; q < 4; ++q) bfr[q] = (kk == q) ? pv : bfr[q]; }
        }
#pragma unroll 2
        for (int kk = 0; kk < 4; ++kk) {
            const int ch0 = chb + 32 * kk + 8 * q4;
            const int cl0 = 32 * kk + 8 * q4;
            const f32x4 ba0 = *(const LAS f32x4*)(cst + cl0), ba1 = *(const LAS f32x4*)(cst + cl0 + 4), bx0 = *(const LAS f32x4*)(cst + 128 + cl0), bx1 = *(const LAS f32x4*)(cst + 128 + cl0 + 4);
            const f32x4 c80 = *(const LAS f32x4*)(cst + 256 + cl0), c81 = *(const LAS f32x4*)(cst + 256 + cl0 + 4);
            f32x4 h00 = (f32x4){0.f, 0.f, 0.f, 0.f}, h01 = h00;
            if (smp && t == 0) { h00 = *(const f32x4*)(a.in[4] + (size_t)b * 1024 + ch0); h01 = *(const f32x4*)(a.in[4] + (size_t)b * 1024 + ch0 + 4); }
            f32x4 ra[2], ia[2];
#pragma unroll
            for (int hf = 0; hf < 2; ++hf) {
                const int oc = 32 * kk + 8 * (c >> 2) + 4 * hf + (c & 3);
                ra[hf] = (f32x4){0.f, 0.f, 0.f, 0.f}; ia[hf] = ra[hf];
#pragma unroll
                for (int k2 = 0; k2 < 4; ++k2) {
                    const bf16x8 wa = *(const LAS bf16x8*)(lds + (0 * 128 + oc) * 272 + (32 * k2 + 8 * q4) * 2);
                    const bf16x8 wx = *(const LAS bf16x8*)(lds + (1 * 128 + oc) * 272 + (32 * k2 + 8 * q4) * 2);
                    ra[hf] = mfma32(wa, bfr[k2], ra[hf]); ia[hf] = mfma32(wx, bfr[k2], ia[hf]);
                }
            }
            float Av[8], Bv[8], xcv[8];
            { const u32x4 x0 = __builtin_bit_cast(u32x4, bfr[0]), x1 = __builtin_bit_cast(u32x4, bfr[1]), x2 = __builtin_bit_cast(u32x4, bfr[2]), x3 = __builtin_bit_cast(u32x4, bfr[3]);
#pragma unroll
              for (int e = 0; e < 4; ++e) { const unsigned w = kk == 0 ? x0[e] : kk == 1 ? x1[e] : kk == 2 ? x2[e] : x3[e]; xcv[2 * e] = bflo(w); xcv[2 * e + 1] = bfhi(w); } }
#pragma unroll
            for (int jp = 0; jp < 8; ++jp) {
                const int hf = jp >> 2, r = jp & 3;
                const float rr = sigmoidf_(ra[hf][r] + (hf ? ba1[r] : ba0[r])), ii = sigmoidf_(ia[hf][r] + (hf ? bx1[r] : bx0[r]));
                const float la = rr * (hf ? c81[r] : c80[r]); const float av = __expf(la);
                float bv = __builtin_amdgcn_sqrtf(fmaxf(1.f - av * av, 0.f)) * (ii * xcv[jp]);
                bv += av * (hf ? h01[r] : h00[r]);
                Av[jp] = av; Bv[jp] = bv;
            }
#define F1_SCAN_STEP(D, CTRL) { const bool take = (c & (W - 1)) >= (D); \
                _Pragma("unroll") for (int jp = 0; jp < 8; ++jp) { \
                    const float ap = __int_as_float(__builtin_amdgcn_update_dpp(0, __float_as_int(Av[jp]), CTRL, 0xf, 0xf, false)); \
                    const float bp = __int_as_float(__builtin_amdgcn_update_dpp(0, __float_as_int(Bv[jp]), CTRL, 0xf, 0xf, false)); \
                    if (take) { Bv[jp] = Av[jp] * bp + Bv[jp]; Av[jp] = Av[jp] * ap; } } }
            F1_SCAN_STEP(1, 0x111) F1_SCAN_STEP(2, 0x112) F1_SCAN_STEP(4, 0x114)
            if (W == 16) F1_SCAN_STEP(8, 0x118)
#undef F1_SCAN_STEP
            u32x4 hw, aw;
#pragma unroll
            for (int e = 0; e < 4; ++e) { hw[e] = cvt_pk(Bv[2 * e], Bv[2 * e + 1]); aw[e] = cvt_pk(Av[2 * e], Av[2 * e + 1]); }
            *(u32x4*)(HL + (size_t)row * 1024 + ch0) = hw; *(u32x4*)(AC + (size_t)row * 1024 + ch0) = aw;
            if (!smp && c == 15) {
                float* ta = TA + (size_t)tt * 1024 + ch0; float* thp = TH + (size_t)tt * 1024 + ch0;
                *(f32x4*)ta = (f32x4){Av[0], Av[1], Av[2], Av[3]}; *(f32x4*)(ta + 4) = (f32x4){Av[4], Av[5], Av[6], Av[7]};
                *(f32x4*)thp = (f32x4){Bv[0], Bv[1], Bv[2], Bv[3]}; *(f32x4*)(thp + 4) = (f32x4){Bv[4], Bv[5], Bv[6], Bv[7]};
            }
        }
    }
}
__device__ __forceinline__ void phase_F2(const Args& a, LAS unsigned char* lds, int wave, int lane) {
    unsigned char* ws = a.ws; const float* __restrict__ TA = (const float*)(ws + OFF_TA); const float* __restrict__ TH = (const float*)(ws + OFF_TH); float* __restrict__ CARRY = (float*)(ws + OFF_CARRY);
    LAS float* sA = (LAS float*)lds; LAS float* sH = sA + 512;
    for (int blk = blockIdx.x; blk < NB * 16; blk += gridDim.x) {
        const int b = blk >> 4, ch = (blk & 15) * 64 + lane;
        const int j0 = wave * 17, j1 = j0 + 17 < NSUBP ? j0 + 17 : NSUBP;
        float av[17], hv[17];
#pragma unroll
        for (int j = 0; j < 17; ++j) { av[j] = 1.f; hv[j] = 0.f; if (j0 + j < j1) { const size_t o = (size_t)(b * NSUBP + j0 + j) * 1024 + ch; av[j] = TA[o]; hv[j] = TH[o]; } }
        float As = 1.f, Hs = 0.f;
#pragma unroll
        for (int j = 0; j < 17; ++j) { Hs = av[j] * Hs + hv[j]; As = As * av[j]; }
        sA[wave * 64 + lane] = As; sH[wave * 64 + lane] = Hs;
        __syncthreads();
        float carry = 0.f;
        for (int w = 0; w < wave; ++w) carry = sA[w * 64 + lane] * carry + sH[w * 64 + lane];
#pragma unroll
        for (int j = 0; j < 17; ++j) if (j0 + j < j1) { CARRY[(size_t)(b * NSUBP + j0 + j) * 1024 + ch] = carry; carry = av[j] * carry + hv[j]; }
        if (wave == 7) a.out[O_HP + (size_t)b * 1024 + ch] = carry;
        __syncthreads();
    }
}
__device__ __forceinline__ void phase_F3(const Args& a, int gw, int NGW, int lane) {
    unsigned char* ws = a.ws; const bf16_t* GR = (const bf16_t*)(ws + OFF_H); const bf16_t* HL = (const bf16_t*)(ws + OFF_HL); bf16_t* AC = (bf16_t*)(ws + OFF_XB); const float* CARRY = (const float*)(ws + OFF_CARRY);
    for (int row = gw; row < T; row += NGW) {
        int b, t; const bool smp = row >= TP;
        if (!smp) { b = row / LP; t = row - b * LP; } else { b = (row - TP) >> 3; t = (row - TP) & 7; }
        const float* cp = smp ? nullptr : CARRY + (size_t)(b * NSUBP + (t >> 4)) * 1024;
        u32x4 hl2[2], ac2[2], gt2[2]; f32x4 c02[2], c12[2];
#pragma unroll
        for (int half = 0; half < 2; ++half) {
            const int ch = 512 * half + 8 * lane;
            hl2[half] = *(const u32x4*)(HL + (size_t)row * 1024 + ch); ac2[half] = *(const u32x4*)(AC + (size_t)row * 1024 + ch);
            gt2[half] = *(const u32x4*)(GR + (size_t)row * 2048 + ch);
            c02[half] = (f32x4){0.f, 0.f, 0.f, 0.f}; c12[half] = c02[half]; if (!smp) { c02[half] = *(const f32x4*)(cp + ch); c12[half] = *(const f32x4*)(cp + ch + 4); }
        }
#pragma unroll
        for (int half = 0; half < 2; ++half) {
            const int ch = 512 * half + 8 * lane;
            const u32x4 hl = hl2[half], ac = ac2[half], gt = gt2[half]; const f32x4 c0 = c02[half], c1 = c12[half];
            float hv[8];
#pragma unroll
            for (int e = 0; e < 4; ++e) { const float cl = e < 2 ? c0[2 * e] : c1[2 * e - 4], chh = e < 2 ? c0[2 * e + 1] : c1[2 * e - 3];
                hv[2 * e] = bflo(hl[e]) + bflo(ac[e]) * cl; hv[2 * e + 1] = bfhi(hl[e]) + bfhi(ac[e]) * chh; }
            u32x4 y;
#pragma unroll
            for (int e = 0; e < 4; ++e) y[e] = cvt_pk(gelu_tanh(bflo(gt[e])) * hv[2 * e], gelu_tanh(bfhi(gt[e])) * hv[2 * e + 1]);
            *(u32x4*)(AC + (size_t)row * 1024 + ch) = y;
            if (smp && t == 7) { float* o = a.out + O_HS + (size_t)b * 1024 + ch; *(f32x4*)o = (f32x4){hv[0], hv[1], hv[2], hv[3]}; *(f32x4*)(o + 4) = (f32x4){hv[4], hv[5], hv[6], hv[7]}; }
            const int L = smp ? 8 : LP;
            if (t >= L - 3) { const u32x4 rn = *(const u32x4*)(GR + (size_t)row * 2048 + 1024 + ch);
                float* o = a.out + (smp ? O_CBS : O_CBP) + ((size_t)b * 3 + (t - (L - 3))) * 1024 + ch;
                *(f32x4*)o = (f32x4){bflo(rn[0]), bfhi(rn[0]), bflo(rn[1]), bfhi(rn[1])}; *(f32x4*)(o + 4) = (f32x4){bflo(rn[2]), bfhi(rn[2]), bflo(rn[3]), bfhi(rn[3])}; }
        }
    }
}

constexpr size_t OFF_BAR = 16 * KiB;
#define XB_TMO      128
#define XB_XCNT(j)  (256  + 64 * (j))
#define XB_XSUB(j)  (1280 + 64 * (j))
#define XB_XGEN(j)  (2304 + 64 * (j))
#define XB_TOP      3328
#define XB_TOPGEN   3392
#define XCD_BAR_WORDS 3456
#define XB_SPIN_CAP (1u << 18)
__device__ __forceinline__ unsigned xb_ld(unsigned* p)              { return __hip_atomic_load(p, __ATOMIC_RELAXED, __HIP_MEMORY_SCOPE_AGENT); }
__device__ __forceinline__ unsigned xb_add(unsigned* p, unsigned v) { return __hip_atomic_fetch_add(p, v, __ATOMIC_RELAXED, __HIP_MEMORY_SCOPE_AGENT); }
__device__ __forceinline__ unsigned xb_xcc_id() { return (unsigned)__builtin_amdgcn_s_getreg((3 << 11) | 20) & 0xFu; }
#define XB_SPIN(cond, bar) do { unsigned _sp = 0; while (cond) { __builtin_amdgcn_s_sleep(1); \
    if ((++_sp & 255u) == 0u) { if (xb_ld(&(bar)[XB_TMO])) break; if (_sp > XB_SPIN_CAP) { atomicAdd(&(bar)[XB_TMO], 1u); break; } } } } while (0)
struct XcdBarrier { unsigned* bar; unsigned x; volatile LAS unsigned* st; };
__device__ __forceinline__ XcdBarrier xcd_barrier_post(unsigned* bar, volatile LAS unsigned* st) {
    XcdBarrier b; b.bar = bar; b.x = xb_xcc_id(); b.st = st;
    if (threadIdx.x == 0) (void)xb_add(&bar[XB_XCNT(b.x)], 1u);
    return b;
}
__device__ __forceinline__ void xcd_barrier_complete(unsigned* bar, unsigned x, unsigned& nloc, unsigned& nx) {
    const unsigned G = gridDim.x * gridDim.y * gridDim.z;
    unsigned sum, cnt, mine, sp = 0u;
    for (;;) {
        sum = 0u; cnt = 0u; mine = 0u;
#pragma unroll
        for (unsigned j = 0; j < 16; ++j) { const unsigned c = xb_ld(&bar[XB_XCNT(j)]); sum += c; cnt += (c > 0u) ? 1u : 0u; mine = (j == x) ? c : mine; }
        if (sum == G) break;
        __builtin_amdgcn_s_sleep(1);
        if ((++sp & 255u) == 0u) { if (xb_ld(&bar[XB_TMO])) break; if (sp > XB_SPIN_CAP) { atomicAdd(&bar[XB_TMO], 1u); break; } }
    }
    nloc = mine > 0u ? mine : 1u; nx = cnt > 0u ? cnt : 1u;
}
__device__ __forceinline__ void xcd_barrier(const XcdBarrier& b) {
    asm volatile("s_waitcnt vmcnt(0) lgkmcnt(0)" ::: "memory");
    __syncthreads();
    if (threadIdx.x == 0) {
        unsigned* bar = b.bar;
        __builtin_amdgcn_s_waitcnt(0);
        unsigned nloc = b.st[0], nx = b.st[1];
        if (nloc == 0u) { xcd_barrier_complete(bar, b.x, nloc, nx); b.st[0] = nloc; b.st[1] = nx; }
        const unsigned old = xb_add(&bar[XB_XSUB(b.x)], 1u);
        const unsigned gen = old / nloc;
        if (old + 1u == (gen + 1u) * nloc) {
            __builtin_amdgcn_fence(__ATOMIC_RELEASE, "agent");
            asm volatile("s_waitcnt vmcnt(0)" ::: "memory");
            const unsigned og = xb_add(&bar[XB_TOP], 1u);
            const unsigned tg = og / nx;
            if (og + 1u == (tg + 1u) * nx) xb_add(&bar[XB_TOPGEN], 1u);
            else XB_SPIN(xb_ld(&bar[XB_TOPGEN]) == tg, bar);
            __builtin_amdgcn_fence(__ATOMIC_ACQUIRE, "agent");
            xb_add(&bar[XB_XGEN(b.x)], 1u);
            asm volatile("s_waitcnt vmcnt(0)" ::: "memory");
        } else {
            XB_SPIN(xb_ld(&bar[XB_XGEN(b.x)]) == gen, bar);
            __builtin_amdgcn_fence(__ATOMIC_ACQUIRE, "agent");
            asm volatile("s_waitcnt vmcnt(0)" ::: "memory");
        }
    }
    __syncthreads();
}

__global__ void __launch_bounds__(512) fwd_megakernel(Args a) {
    extern __shared__ __attribute__((aligned(16))) unsigned char lds_raw[];
    cg::grid_group grid = cg::this_grid();
    LAS unsigned char* lds = (LAS unsigned char*)lds_raw;
#define FRESH() int tid = threadIdx.x; asm volatile("" : "+v"(tid)); const int lane = tid & 63, wave = __builtin_amdgcn_readfirstlane(tid >> 6); \
    const int gw = blockIdx.x * 8 + wave, NGW = G * 8, gt = blockIdx.x * 512 + tid, NGT = G * 512; (void)gw; (void)NGW; (void)gt; (void)NGT; (void)lane;
    const int G = gridDim.x;
    unsigned char* ws = a.ws;
    bf16_t* XB = (bf16_t*)(ws + OFF_XB); bf16_t* XR = (bf16_t*)(ws + OFF_X32);
    bf16_t* PROJ = (bf16_t*)(ws + OFF_BIG); bf16_t* HB = (bf16_t*)(ws + OFF_H);
    pg8::StaticOrder S;
    { volatile LAS unsigned* st0 = (volatile LAS unsigned*)(lds + 131072 + 64); if (threadIdx.x < 2) st0[threadIdx.x] = 0u; }
    __syncthreads();
    const XcdBarrier xbar = xcd_barrier_post((unsigned*)(ws + OFF_BAR), (volatile LAS unsigned*)(lds + 131072 + 64));
#define GS() xcd_barrier(xbar)
    unsigned long long tA = 0, tB = 0;
#define STAMP(k) do { if ((k) == PROBE_A) tA = __builtin_amdgcn_s_memrealtime(); if ((k) == PROBE_B) tB = __builtin_amdgcn_s_memrealtime(); } while (0)
    STAMP(0);

    { FRESH() phase_p0(a, lds, gw, NGW, wave, lane); }
    grid.sync(); STAMP(1);
    { S.init(MP / 256, 4096 / 256, G, (int)blockIdx.x, 16, false); pg8::EpiBf16 E{PROJ, 4096};
      pg8::gemm_phase<pg8::EpiBf16, 0>(lds, XB, (const bf16_t*)(ws + OFF_W_INAB), 1024, S, E); }
    if (G == 256 && blockIdx.x >= 80) { FRESH() convert_weights(a, lds, 1, ((int)blockIdx.x - 80) * 8 + wave, 176 * 8, wave, lane); }
    else if (G != 256) { FRESH() convert_weights(a, lds, 1, gw, NGW, wave, lane); }
    GS(); STAMP(2);
    { FRESH() phase_T(a, gw, NGW, lane); }
    GS(); STAMP(3);
    { FRESH() phase_A(a, gw, NGW, lane); }
    GS(); STAMP(4);
    { FRESH() phase_B(a, gt, NGT); }
    GS(); STAMP(5);
    { FRESH() phase_C(a, gw, NGW, lane); }
    GS(); STAMP(6);
    { FRESH() phase_D(a, gw, NGW, lane); }
    GS(); STAMP(7);
    { S.init(MP / 256, 1024 / 256, G, (int)blockIdx.x, 16, true); pg8::EpiRes<0, true> E{XR, a, HB};
      pg8::gemm_phase<pg8::EpiRes<0, true>, 0, true>(lds, XB, (const bf16_t*)(ws + OFF_W_OUTAB), 1024, S, E); }
    GS(); STAMP(8);
    { FRESH() phase_LN<false, true>(a, a.in[21], a.in[22], HB, 4, gw, NGW, lane); }
    GS(); STAMP(9);
#define FFN_PHASES(layer, sid, EXTRA) \
    { S.init(71, DFF / 128, G, (int)blockIdx.x, 16, false); \
      pg8::EpiFFN E{HB, a.in[26] + (size_t)(layer) * 3 * DFF, a.in[27] + (size_t)(layer) * DFF, a.in[6] + (size_t)(layer) * SBAT * 2 * DFF, \
                    a.out + O_FBP + (size_t)(layer) * NB * 2 * DFF, a.out + O_FBS + (size_t)(layer) * SBAT * 2 * DFF}; \
      pg8::gemm_phase<pg8::EpiFFN, 1>(lds, XR - 2 * 1024, (const bf16_t*)(ws + ((layer) ? OFF_W_UP1 : OFF_W_UP0)), 1024, S, E); } \
    EXTRA \
    GS(); STAMP(sid); \
    { S.init(MP / 256, 1024 / 256, G, (int)blockIdx.x, 44, true); pg8::EpiRes<1, true> E{XR, a, (bf16_t*)(ws + OFF_PART)}; \
      pg8::gemm_phase<pg8::EpiRes<1, true>, 0, true>(lds, HB, (const bf16_t*)(ws + ((layer) ? OFF_W_DN1 : OFF_W_DN0)), DFF, S, E); } \
    GS(); STAMP(sid + 1);
#define FFN0_EXTRA if (G == 256 && blockIdx.x >= 26) { FRESH() convert_weights(a, lds, 2, ((int)blockIdx.x - 26) * 8 + wave, 230 * 8, wave, lane); } else if (G != 256) { FRESH() convert_weights(a, lds, 2, gw, NGW, wave, lane); }
    FFN_PHASES(0, 10, FFN0_EXTRA)
    { FRESH() phase_LN<false>(a, a.in[23], a.in[24], (const bf16_t*)(ws + OFF_PART), 11, gw, NGW, lane); }
    GS(); STAMP(12);
    { S.init(MP / 256, 2048 / 256, G, (int)blockIdx.x, 16, false); pg8::EpiBf16 E{HB, 2048};
      pg8::gemm_phase<pg8::EpiBf16, 0>(lds, XR, (const bf16_t*)(ws + OFF_W_INC), 1024, S, E); }
    GS(); STAMP(13);
    { FRESH() phase_F1(a, lds, wave, lane); }
    GS(); STAMP(14);
    { FRESH() phase_F2(a, lds, wave, lane); }
    GS(); STAMP(15);
    { FRESH() phase_F3(a, gw, NGW, lane); }
    GS(); STAMP(16);
    { S.init(MP / 256, 1024 / 256, G, (int)blockIdx.x, 16, true); pg8::EpiRes<1, true> E{XR, a, HB};
      pg8::gemm_phase<pg8::EpiRes<1, true>, 0, true>(lds, XB, (const bf16_t*)(ws + OFF_W_OUTC), 1024, S, E); }
    GS(); STAMP(17);
    { FRESH() phase_LN<false>(a, a.in[21] + 1024, a.in[22] + 1024, HB, 4, gw, NGW, lane); }
    GS(); STAMP(18);
    FFN_PHASES(1, 19, )
    { FRESH() phase_LN<true>(a, a.in[23] + 1024, a.in[24] + 1024, (const bf16_t*)(ws + OFF_PART), 11, gw, NGW, lane); }
#if PROBE_A >= 0
    GS(); STAMP(21);
    if (blockIdx.x == 0 && threadIdx.x == 0) a.out[O_YS] += (float)(tB - tA) * 1e-5f;
#endif
#undef FFN_PHASES
}

extern "C" void kernel_launch(void* const* d_in, const int* in_sizes, int n_in, void* d_out, int out_size, void* d_ws, size_t ws_size, hipStream_t stream) {
    static int grid = 0;
    if (grid == 0) {
        if (n_in != 29 || ws_size < WS_END) { fprintf(stderr, "kernel_launch: unexpected n_in %d / ws %zu\n", n_in, ws_size); grid = -1; return; }
        int dev = 0, cus = 0, per_cu = 0;
        hipGetDevice(&dev); hipDeviceGetAttribute(&cus, hipDeviceAttributeMultiprocessorCount, dev);
        if (hipFuncSetAttribute((const void*)fwd_megakernel, hipFuncAttributeMaxDynamicSharedMemorySize, LDS_BYTES) != hipSuccess) { fprintf(stderr, "kernel_launch: hipFuncSetAttribute failed\n"); grid = -1; return; }
        if (hipOccupancyMaxActiveBlocksPerMultiprocessor(&per_cu, (const void*)fwd_megakernel, 512, LDS_BYTES) != hipSuccess || per_cu < 1) { fprintf(stderr, "kernel_launch: occupancy query says %d\n", per_cu); per_cu = 1; }
        (void)hipGetLastError();
        grid = cus * 1;
    }
    if (grid < 0) return;
    (void)hipMemsetAsync((char*)d_ws + OFF_BAR, 0, 16384, stream);
    Args a{};
    for (int i = 0; i < 29; ++i) a.in[i] = (const float*)d_in[i];
    a.out = (float*)d_out; a.ws = (unsigned char*)d_ws;
    void* args[] = {&a};
    hipError_t e = hipLaunchCooperativeKernel((const void*)fwd_megakernel, dim3(grid), dim3(512), args, LDS_BYTES, stream);
    if (e != hipSuccess) fprintf(stderr, "cooperative launch failed: %s (grid %d)\n", hipGetErrorString(e), grid);
}
```
